# Optimizing an MI355X kernel written in HIP

```python
import jax
import jax.numpy as jnp
from jax import lax
import numpy as np

D_MODEL = 1024
BATCH = 2
SEQ = 16384
DEPTH = 2

ROPE_THETA = 10000.0
NORM_EPS = 1e-6
NEG_INF = -1e30

RET_HEADS = 4
RET_DK = D_MODEL // (2 * RET_HEADS)
RET_DV = D_MODEL // (2 * RET_HEADS)
RET_CHUNK = 128
S5_WIDTH = D_MODEL // 2
S5_GROUP_CH = 16
S5_GROUPS = S5_WIDTH // S5_GROUP_CH
S5_STATE = 64
S5_STEP_MIN = 1e-3
S5_STEP_MAX = 1e-1
DIL_PATTERNS = ((128, 1), (512, 4), (2048, 16))
DIL_HEADS = 4
DIL_HEAD_DIM = D_MODEL // 16
MLSTM_HEADS = 4
MLSTM_DH = D_MODEL // 8
MLSTM_CHUNK = 128
N_EXPERTS = 16
EXPERT_FF = 2 * D_MODEL
CAPACITY_FACTOR = 2

EVEN_SPLITS = (RET_HEADS * RET_DK, RET_HEADS * RET_DK, RET_HEADS * RET_DV, RET_HEADS * RET_DV, S5_WIDTH)
EVEN_IN = sum(EVEN_SPLITS)
EVEN_OUT = RET_HEADS * RET_DV + S5_WIDTH
DIL_WIDTH = len(DIL_PATTERNS) * DIL_HEADS * DIL_HEAD_DIM
MLSTM_WIDTH = MLSTM_HEADS * MLSTM_DH
ODD_SPLITS = (DIL_WIDTH, DIL_WIDTH, DIL_WIDTH, MLSTM_WIDTH, MLSTM_WIDTH, MLSTM_WIDTH, MLSTM_WIDTH, 4 * MLSTM_HEADS)
ODD_IN = sum(ODD_SPLITS)
ODD_OUT = DIL_HEADS * DIL_HEAD_DIM + MLSTM_WIDTH
N_EVEN = (DEPTH + 1) // 2
N_ODD = DEPTH // 2

kernel_name = 'hybrid_retention_s5_dilated_mlstm_ecmoe'


def _split(z, sizes):
    offsets = np.cumsum(sizes)[:-1].tolist()
    return jnp.split(z, offsets, axis=-1)


def rmsnorm(x, g):
    xf = x.astype(jnp.float32)
    y = xf * lax.rsqrt(jnp.mean(xf * xf, axis=-1, keepdims=True) + NORM_EPS)
    return (y * g.astype(jnp.float32)).astype(x.dtype)


def head_norm(h):
    hf = h.astype(jnp.float32)
    mu = jnp.mean(hf, axis=-1, keepdims=True)
    var = jnp.mean(jnp.square(hf - mu), axis=-1, keepdims=True)
    return (hf - mu) * lax.rsqrt(var + NORM_EPS)


def rotary(x, positions):
    e = x.shape[-1]
    half = e // 2
    inv_freq = ROPE_THETA ** (-jnp.arange(half, dtype=jnp.float32) / half)
    ang = positions.astype(jnp.float32)[:, None] * inv_freq[None, :]
    cos = jnp.cos(ang)[:, None, :]
    sin = jnp.sin(ang)[:, None, :]
    x1 = x[..., :half].astype(jnp.float32)
    x2 = x[..., half:].astype(jnp.float32)
    return jnp.concatenate([x1 * cos - x2 * sin, x1 * sin + x2 * cos], axis=-1).astype(x.dtype)


def retention_direction(q, k, v, log_gamma, strict):
    b, h, l, dk = q.shape
    dv = v.shape[-1]
    c = RET_CHUNK
    n = l // c
    qc = q.reshape(b, h, n, c, dk)
    kc = k.reshape(b, h, n, c, dk)
    vc = v.reshape(b, h, n, c, dv)
    idx = jnp.arange(c)
    diff = idx[:, None] - idx[None, :]
    mask = (diff > 0) if strict else (diff >= 0)
    decay = jnp.where(mask, jnp.exp(jnp.where(mask, diff, 0).astype(jnp.float32)[None] * log_gamma[:, None, None]), 0.0)
    scores = jnp.einsum('bhnid,bhnjd->bhnij', qc, kc) * decay[None, :, None]
    o_intra = jnp.einsum('bhnij,bhnje->bhnie', scores, vc)
    k_w = jnp.exp((c - 1 - idx).astype(jnp.float32)[None, :] * log_gamma[:, None])
    chunk_kv = jnp.einsum('bhnjd,hj,bhnje->bhnde', kc, k_w, vc)
    chunk_decay = jnp.exp(c * log_gamma)[None, :, None, None]

    def step(state, kv_n):
        return chunk_decay * state + kv_n, state

    _, state_before = lax.scan(step, jnp.zeros((b, h, dk, dv), jnp.float32), jnp.moveaxis(chunk_kv, 2, 0))
    state_before = jnp.moveaxis(state_before, 0, 2)
    q_w = jnp.exp((idx + 1).astype(jnp.float32)[None, :] * log_gamma[:, None])
    o_cross = jnp.einsum('bhnid,hi,bhnde->bhnie', qc, q_w, state_before)
    return (o_intra + o_cross).reshape(b, h, l, dv)


def retention_mixer(q, k, v, g, positions):
    b, l, _ = q.shape
    qh = rotary(q.reshape(b, l, RET_HEADS, RET_DK), positions)
    kh = rotary(k.reshape(b, l, RET_HEADS, RET_DK), positions) * (RET_DK ** -0.5)
    vh = v.reshape(b, l, RET_HEADS, RET_DV)
    qh, kh, vh = (t.transpose(0, 2, 1, 3) for t in (qh, kh, vh))
    log_gamma = jnp.log1p(-(2.0 ** (-5.0 - jnp.arange(RET_HEADS, dtype=jnp.float32))))
    fwd = retention_direction(qh, kh, vh, log_gamma, False)
    bwd = jnp.flip(retention_direction(jnp.flip(qh, 2), jnp.flip(kh, 2), jnp.flip(vh, 2), log_gamma, True), 2)
    o = head_norm(fwd + bwd).transpose(0, 2, 1, 3).reshape(b, l, RET_HEADS * RET_DV)
    return (jax.nn.silu(g.astype(jnp.float32)) * o).astype(g.dtype)


def _linear_combine(left, right):
    a1, b1 = left
    a2, b2 = right
    return a1 * a2, a2 * b1 + b2


def s5_mixer(u, a_re, a_im, b_re, b_im, c_re, c_im, log_step, d_skip, glu_w, glu_b):
    b, l, w = u.shape
    uf = u.astype(jnp.float32)
    ug = uf.reshape(b, l, S5_GROUPS, S5_GROUP_CH).astype(jnp.complex64)
    y = d_skip.astype(jnp.float32) * uf
    for direction in range(2):
        lam = lax.complex(a_re[direction].astype(jnp.float32), a_im[direction].astype(jnp.float32))
        step = jnp.exp(log_step[direction].astype(jnp.float32))[:, None]
        a_bar = jnp.exp(lam * step)
        bmat = lax.complex(b_re[direction].astype(jnp.float32), b_im[direction].astype(jnp.float32))
        b_bar = ((a_bar - 1.0) / lam)[..., None] * bmat
        bu = jnp.einsum('gpc,blgc->blgp', b_bar, ug)
        a_seq = jnp.broadcast_to(a_bar, bu.shape)
        _, states = lax.associative_scan(_linear_combine, (a_seq, bu), axis=1, reverse=(direction == 1))
        cmat = lax.complex(c_re[direction].astype(jnp.float32), c_im[direction].astype(jnp.float32))
        y = y + jnp.real(jnp.einsum('gcp,blgp->blgc', cmat, states)).reshape(b, l, w)
    y = jax.nn.gelu(y)
    y = y * jax.nn.sigmoid(y @ glu_w.astype(jnp.float32) + glu_b.astype(jnp.float32))
    return y.astype(u.dtype)


def dilated_window_attention(q, k, v, dilation, half):
    b, l, h, e = q.shape
    blk = half
    unit = dilation * blk
    lp = -(-l // unit) * unit
    j = lp // dilation
    nb = j // blk

    def to_classes(t):
        t = jnp.pad(t, ((0, 0), (0, lp - l), (0, 0), (0, 0)))
        return t.reshape(b, j, dilation, h, e).transpose(0, 2, 3, 1, 4)

    def windows(t):
        t = jnp.pad(t, ((0, 0), (0, 0), (0, 0), (blk, blk), (0, 0))).reshape(b, dilation, h, nb + 2, blk, e)
        return jnp.concatenate([t[:, :, :, :-2], t[:, :, :, 1:-1], t[:, :, :, 2:]], axis=-2)

    qc = to_classes(q).reshape(b, dilation, h, nb, blk, e)
    kw = windows(to_classes(k))
    vw = windows(to_classes(v))
    valid = (jnp.arange(lp) < l).reshape(j, dilation).T
    valid = jnp.pad(valid, ((0, 0), (blk, blk))).reshape(dilation, nb + 2, blk)
    kvalid = jnp.concatenate([valid[:, :-2], valid[:, 1:-1], valid[:, 2:]], axis=-1)
    rel = jnp.arange(3 * blk)[None, :] - blk - jnp.arange(blk)[:, None]
    mask = (jnp.abs(rel) <= half)[None, None] & kvalid[:, :, None, :]
    s = jnp.einsum('brhnie,brhnte->brhnit', qc, kw).astype(jnp.float32) * (e ** -0.5)
    s = jnp.where(mask[None, :, None], s, NEG_INF)
    m = jnp.max(s, axis=-1, keepdims=True)
    p = jnp.exp(s - m)
    den = jnp.sum(p, axis=-1)
    o = jnp.einsum('brhnit,brhnte->brhnie', p, vw) / den[..., None]
    lse = m[..., 0] + jnp.log(den)
    o = o.reshape(b, dilation, h, j, e).transpose(0, 3, 1, 2, 4).reshape(b, lp, h, e)[:, :l]
    lse = lse.reshape(b, dilation, h, j).transpose(0, 3, 1, 2).reshape(b, lp, h)[:, :l]
    return o, lse


def dilated_mixer(q, k, v, positions):
    b, l, _ = q.shape
    n_heads = len(DIL_PATTERNS) * DIL_HEADS
    qh = rotary(q.reshape(b, l, n_heads, DIL_HEAD_DIM), positions)
    kh = rotary(k.reshape(b, l, n_heads, DIL_HEAD_DIM), positions)
    vh = v.reshape(b, l, n_heads, DIL_HEAD_DIM)
    outs, lses = [], []
    for gi, (window, dilation) in enumerate(DIL_PATTERNS):
        sl = slice(gi * DIL_HEADS, (gi + 1) * DIL_HEADS)
        o, lse = dilated_window_attention(qh[:, :, sl], kh[:, :, sl], vh[:, :, sl], dilation, window // (2 * dilation))
        outs.append(o)
        lses.append(lse)
    wts = jax.nn.softmax(jnp.stack(lses), axis=0)
    o = jnp.sum(wts[..., None] * jnp.stack(outs), axis=0)
    return o.reshape(b, l, DIL_HEADS * DIL_HEAD_DIM).astype(q.dtype)


def mlstm_direction(q, k, v, ig, lf):
    b, h, l, dk = q.shape
    dv = v.shape[-1]
    lc = MLSTM_CHUNK
    n = l // lc

    def chunks(t):
        return jnp.moveaxis(t.reshape((b, h, n, lc) + t.shape[3:]), 2, 0)

    causal = jnp.tril(jnp.ones((lc, lc), dtype=bool))

    def step(carry, inp):
        cmem, nvec, m = carry
        qn, kn, vn, ign, lfn = inp
        bcum = jnp.cumsum(lfn, axis=-1)
        log_d = jnp.where(causal, bcum[..., :, None] - bcum[..., None, :] + ign[..., None, :], -jnp.inf)
        log_inter = bcum + m[..., None]
        m_i = jnp.maximum(log_inter, jnp.max(log_d, axis=-1))
        s = jnp.einsum('bhid,bhjd->bhij', qn, kn) * jnp.exp(log_d - m_i[..., None])
        w_inter = jnp.exp(log_inter - m_i)
        num = jnp.einsum('bhij,bhje->bhie', s, vn) + w_inter[..., None] * jnp.einsum('bhid,bhde->bhie', qn, cmem)
        den_raw = jnp.sum(s, axis=-1) + w_inter * jnp.einsum('bhid,bhd->bhi', qn, nvec)
        hout = num / jnp.maximum(jnp.abs(den_raw), jnp.exp(-m_i))[..., None]
        b_last = bcum[..., -1]
        log_w = b_last[..., None] - bcum + ign
        m_new = jnp.maximum(b_last + m, jnp.max(log_w, axis=-1))
        w_old = jnp.exp(b_last + m - m_new)
        w_j = jnp.exp(log_w - m_new[..., None])
        c_new = w_old[..., None, None] * cmem + jnp.einsum('bhj,bhjd,bhje->bhde', w_j, kn, vn)
        n_new = w_old[..., None] * nvec + jnp.einsum('bhj,bhjd->bhd', w_j, kn)
        return (c_new, n_new, m_new), hout

    init = (jnp.zeros((b, h, dk, dv), jnp.float32), jnp.zeros((b, h, dk), jnp.float32), jnp.zeros((b, h), jnp.float32))
    _, hs = lax.scan(step, init, (chunks(q), chunks(k), chunks(v), chunks(ig), chunks(lf)))
    return jnp.moveaxis(hs, 0, 2).reshape(b, h, l, dv)


def mlstm_mixer(q, k, v, o, gates, i_bias, f_bias):
    b, l, _ = q.shape

    def to_heads(t):
        return t.reshape(b, l, MLSTM_HEADS, MLSTM_DH).transpose(0, 2, 1, 3)

    qh, kh, vh = to_heads(q), to_heads(k) * (MLSTM_DH ** -0.5), to_heads(v)
    g = gates.astype(jnp.float32).reshape(b, l, 4, MLSTM_HEADS).transpose(2, 0, 3, 1)
    ig = g[0:2] + i_bias.astype(jnp.float32)[:, None, :, None]
    lf = jax.nn.log_sigmoid(g[2:4] + f_bias.astype(jnp.float32)[:, None, :, None])
    h_f = mlstm_direction(qh, kh, vh, ig[0], lf[0])
    h_b = jnp.flip(mlstm_direction(jnp.flip(qh, 2), jnp.flip(kh, 2), jnp.flip(vh, 2), jnp.flip(ig[1], 2), jnp.flip(lf[1], 2)), 2)
    hn = head_norm(h_f + h_b).transpose(0, 2, 1, 3).reshape(b, l, MLSTM_WIDTH)
    return (jax.nn.sigmoid(o.astype(jnp.float32)) * hn).astype(q.dtype)


def even_mixer(h, w_in, w_out, a_re, a_im, b_re, b_im, c_re, c_im, log_step, d_skip, glu_w, glu_b, positions):
    q, k, v, g, u = _split(h @ w_in, EVEN_SPLITS)
    o_ret = retention_mixer(q, k, v, g, positions)
    o_s5 = s5_mixer(u, a_re, a_im, b_re, b_im, c_re, c_im, log_step, d_skip, glu_w, glu_b)
    return jnp.concatenate([o_ret, o_s5], axis=-1) @ w_out


def odd_mixer(h, w_in, w_out, i_bias, f_bias, positions):
    cq, ck, cv, mq, mk, mv, mo, mg = _split(h @ w_in, ODD_SPLITS)
    o_dil = dilated_mixer(cq, ck, cv, positions)
    o_ml = mlstm_mixer(mq, mk, mv, mo, mg, i_bias, f_bias)
    return jnp.concatenate([o_dil, o_ml], axis=-1) @ w_out


def expert_choice_moe(h, w_router, w1, w3, w2):
    b, t, d = h.shape
    cap = CAPACITY_FACTOR * t // N_EXPERTS
    aff = jax.nn.softmax(jnp.einsum('btd,de->bte', h, w_router).astype(jnp.float32), axis=-1)
    gate, tok = lax.top_k(jnp.swapaxes(aff, 1, 2), cap)
    flat = tok + (jnp.arange(b) * t)[:, None, None]
    xe = h.reshape(b * t, d)[flat]
    a = jnp.einsum('becd,edf->becf', xe, w1)
    g = jnp.einsum('becd,edf->becf', xe, w3)
    ye = jnp.einsum('becf,efd->becd', jax.nn.silu(a) * g, w2) * gate[..., None].astype(h.dtype)
    out = jnp.zeros((b * t, d), ye.dtype).at[flat.reshape(-1)].add(ye.reshape(-1, d))
    return out.reshape(b, t, d).astype(h.dtype)


def setup_inputs(seed: int = 0) -> dict:
    key = jax.random.key(seed)
    ks = jax.random.split(key, 24)

    def nrm(k, shape, scale):
        return jax.random.normal(k, shape, jnp.float32) * scale

    g_, p_, c_ = S5_GROUPS, S5_STATE, S5_GROUP_CH
    x = nrm(ks[0], (BATCH, SEQ, D_MODEL), 1.0)
    norm_mix_g = 1.0 + nrm(ks[1], (DEPTH, D_MODEL), 0.01)
    norm_ffn_g = 1.0 + nrm(ks[2], (DEPTH, D_MODEL), 0.01)
    final_g = 1.0 + nrm(ks[3], (D_MODEL,), 0.01)
    ev_w_in = nrm(ks[4], (N_EVEN, D_MODEL, EVEN_IN), D_MODEL ** -0.5)
    ev_w_out = nrm(ks[5], (N_EVEN, EVEN_OUT, D_MODEL), EVEN_OUT ** -0.5)
    s5_a_re = -0.5 + nrm(ks[6], (N_EVEN, 2, g_, p_), 0.01)
    s5_a_im = jnp.pi * jnp.arange(p_, dtype=jnp.float32) + nrm(ks[7], (N_EVEN, 2, g_, p_), 0.01)
    s5_b_re = nrm(ks[8], (N_EVEN, 2, g_, p_, c_), (2 * c_) ** -0.5)
    s5_b_im = nrm(ks[9], (N_EVEN, 2, g_, p_, c_), (2 * c_) ** -0.5)
    s5_c_re = nrm(ks[10], (N_EVEN, 2, g_, c_, p_), (2 * p_) ** -0.5)
    s5_c_im = nrm(ks[11], (N_EVEN, 2, g_, c_, p_), (2 * p_) ** -0.5)
    s5_log_step = np.log(S5_STEP_MIN) + jax.random.uniform(ks[12], (N_EVEN, 2, g_), jnp.float32) * (np.log(S5_STEP_MAX) - np.log(S5_STEP_MIN))
    s5_d = nrm(ks[13], (N_EVEN, S5_WIDTH), 1.0)
    s5_glu_w = nrm(ks[14], (N_EVEN, S5_WIDTH, S5_WIDTH), S5_WIDTH ** -0.5)
    s5_glu_b = nrm(ks[15], (N_EVEN, S5_WIDTH), 0.01)
    od_w_in = nrm(ks[16], (N_ODD, D_MODEL, ODD_IN), D_MODEL ** -0.5)
    od_w_out = nrm(ks[17], (N_ODD, ODD_OUT, D_MODEL), ODD_OUT ** -0.5)
    ml_i_bias = nrm(ks[18], (N_ODD, 2, MLSTM_HEADS), 0.1)
    ml_f_bias = jnp.linspace(3.0, 6.0, MLSTM_HEADS, dtype=jnp.float32) + nrm(ks[19], (N_ODD, 2, MLSTM_HEADS), 0.01)
    moe_router = nrm(ks[20], (DEPTH, D_MODEL, N_EXPERTS), D_MODEL ** -0.5)
    moe_w1 = nrm(ks[21], (DEPTH, N_EXPERTS, D_MODEL, EXPERT_FF), D_MODEL ** -0.5)
    moe_w3 = nrm(ks[22], (DEPTH, N_EXPERTS, D_MODEL, EXPERT_FF), D_MODEL ** -0.5)
    moe_w2 = nrm(ks[23], (DEPTH, N_EXPERTS, EXPERT_FF, D_MODEL), EXPERT_FF ** -0.5)
    return {'x': x, 'norm_mix_g': norm_mix_g, 'norm_ffn_g': norm_ffn_g, 'final_g': final_g,
            'ev_w_in': ev_w_in, 'ev_w_out': ev_w_out, 's5_a_re': s5_a_re, 's5_a_im': s5_a_im,
            's5_b_re': s5_b_re, 's5_b_im': s5_b_im, 's5_c_re': s5_c_re, 's5_c_im': s5_c_im,
            's5_log_step': s5_log_step, 's5_d': s5_d, 's5_glu_w': s5_glu_w, 's5_glu_b': s5_glu_b,
            'od_w_in': od_w_in, 'od_w_out': od_w_out, 'ml_i_bias': ml_i_bias, 'ml_f_bias': ml_f_bias,
            'moe_router': moe_router, 'moe_w1': moe_w1, 'moe_w3': moe_w3, 'moe_w2': moe_w2}


def reference(x, norm_mix_g, norm_ffn_g, final_g, ev_w_in, ev_w_out, s5_a_re, s5_a_im, s5_b_re, s5_b_im,
              s5_c_re, s5_c_im, s5_log_step, s5_d, s5_glu_w, s5_glu_b, od_w_in, od_w_out, ml_i_bias, ml_f_bias,
              moe_router, moe_w1, moe_w3, moe_w2):
    positions = jnp.arange(x.shape[1])
    for layer in range(DEPTH):
        h = rmsnorm(x, norm_mix_g[layer])
        if layer % 2 == 0:
            e = layer // 2
            mix = even_mixer(h, ev_w_in[e], ev_w_out[e], s5_a_re[e], s5_a_im[e], s5_b_re[e], s5_b_im[e],
                             s5_c_re[e], s5_c_im[e], s5_log_step[e], s5_d[e], s5_glu_w[e], s5_glu_b[e], positions)
        else:
            o = layer // 2
            mix = odd_mixer(h, od_w_in[o], od_w_out[o], ml_i_bias[o], ml_f_bias[o], positions)
        x = x + mix
        x = x + expert_choice_moe(rmsnorm(x, norm_ffn_g[layer]), moe_router[layer], moe_w1[layer], moe_w3[layer], moe_w2[layer])
    return rmsnorm(x, final_g)
```

```cpp
#include <hip/hip_runtime.h>
#include <hip/hip_cooperative_groups.h>
#include <cstdio>
#include <cstdint>
namespace cg = cooperative_groups;

#define LAS __attribute__((address_space(3)))
#define GAS __attribute__((address_space(1)))
typedef unsigned short bf16_t;
typedef short bf16x8 __attribute__((ext_vector_type(8)));
typedef float f32x4 __attribute__((ext_vector_type(4)));
typedef float f32x2 __attribute__((ext_vector_type(2)));
typedef unsigned u32x4 __attribute__((ext_vector_type(4)));
typedef unsigned u32x2 __attribute__((ext_vector_type(2)));
typedef int i32x4 __attribute__((ext_vector_type(4)));

#ifndef CONV_A0
#define CONV_A0 400
#endif
#ifndef CONV_A1
#define CONV_A1 528
#endif
#ifndef CONV_A2
#define CONV_A2 1008
#endif
#ifndef CONV_B0
#define CONV_B0 400
#endif
#ifndef CONV_B1
#define CONV_B1 720
#endif
#ifndef REP_CHA
#define REP_CHA 1
#endif
#ifndef REP_CHC
#define REP_CHC 1
#endif
#ifndef REP_DIL
#define REP_DIL 1
#endif
#ifndef REP_MOE1
#define REP_MOE1 1
#endif
#ifndef REP_MOE2
#define REP_MOE2 1
#endif
#ifndef REP_WIN
#define REP_WIN 1
#endif
#ifndef REP_WOUT
#define REP_WOUT 1
#endif
#ifndef REP_S5
#define REP_S5 1
#endif
#ifndef ONE_LAUNCH
#define ONE_LAUNCH 1
#endif

constexpr int NB = 2, SEQ = 16384, T = NB * SEQ, DM = 1024;
constexpr int NE = 16, FF = 2048, CAP = 2048;
constexpr int NTHREADS = 512, NWAVES = 8;

__device__ __forceinline__ float bf2f(bf16_t b) { return __uint_as_float(((unsigned)b) << 16); }
typedef __bf16 bf16x2_t __attribute__((ext_vector_type(2)));
__device__ __forceinline__ unsigned pk2(float lo, float hi) { const f32x2 v = {lo, hi}; const bf16x2_t b = __builtin_convertvector(v, bf16x2_t); return __builtin_bit_cast(unsigned, b); }
__device__ __forceinline__ bf16_t f2bf(float f) { return (bf16_t)(pk2(f, 0.f) & 0xffffu); }
__device__ __forceinline__ float lo_bf(unsigned w) { return __uint_as_float(w << 16); }
__device__ __forceinline__ float hi_bf(unsigned w) { return __uint_as_float(w & 0xffff0000u); }
__device__ __forceinline__ float wave_sum(float v) {
#pragma unroll
    for (int o = 1; o < 64; o <<= 1) v += __shfl_xor(v, o);
    return v;
}
__device__ __forceinline__ float sigmoidf_(float x) { return __builtin_amdgcn_rcpf(1.0f + __expf(-x)); }
__device__ __forceinline__ float siluf_(float x) { return x * __builtin_amdgcn_rcpf(1.0f + __expf(-x)); }
__device__ __forceinline__ float gelu_tanh(float x) {
    const float z = 0.7978845608028654f * (x + 0.044715f * x * x * x);
    const float e = __expf(2.0f * z);
    const float th = 1.0f - 2.0f * __builtin_amdgcn_rcpf(e + 1.0f);
    return 0.5f * x * (1.0f + th);
}
__device__ __forceinline__ void sincos_d(double ang, float& s, float& c) {
    const double rev = ang * 0.15915494309189535;
    const double fr = rev - __builtin_rint(rev);
    const float f = (float)fr;
    s = __builtin_amdgcn_sinf(f); c = __builtin_amdgcn_cosf(f);
}
#define LDS_WAIT() asm volatile("s_waitcnt lgkmcnt(0)" ::: "memory")
__device__ __forceinline__ int lane_fresh() { int l; asm volatile("v_mbcnt_lo_u32_b32 %0, -1, 0\n\tv_mbcnt_hi_u32_b32 %0, -1, %0" : "=v"(l)); return l; }

namespace pg8 {
constexpr int BM = 256, BK = 64, HALF = 128, HTB = HALF * BK * 2, STAGE_BYTES = 8 * HTB, NXCD = 8, WGM = 8, SCQ_OFF = STAGE_BYTES;
__host__ __device__ __forceinline__ int lds_byte(int r, int c) { const int st = (r >> 4) * 2 + (c >> 5), rr = r & 15, cc = c & 31, ob = rr * 64 + cc * 2; return st * 1024 + (ob ^ (((ob >> 9) & 1) << 5)); }
__host__ __device__ __forceinline__ void stage_rc(int b, int& R, int& C) { const int st = b / 1024, sb = b % 1024, swz = sb ^ (((sb >> 9) & 1) << 5); R = (st >> 1) * 16 + swz / 64; C = (st & 1) * 32 + (swz % 64) / 2; }
__host__ __device__ __forceinline__ int perm32(int rho) { const int n = rho >> 4, i = rho & 15; return 8 * (i >> 2) + 4 * n + (i & 3); }

struct Unit { int pm, pn; };
struct Gemm { const bf16_t* A; const bf16_t* Bt; int K, lda, ldb; const int* gather; const unsigned short* ksc = nullptr; };

struct TileOrder {
    int nM, nN, per, total, G, c, rep;
    __device__ void init(int ngroups, int nM_, int nN_, int G_, int c_, int rep_ = 1) { nM = nM_; nN = nN_; per = nM * nN; total = ngroups * per; G = G_; c = c_; rep = rep_; }
    __device__ bool next(int i, Unit& u) const {
        long L = (long)i * G + c; if (L >= (long)total * rep) return false;
        L %= total;
        const int g = (int)(L / per); int wgid = (int)(L % per);
        { const int q = per / NXCD, r = per % NXCD, xcd = wgid % NXCD, off = wgid / NXCD; wgid = (xcd < r ? xcd * (q + 1) : r * (q + 1) + (xcd - r) * q) + off; }
        const int nig = WGM * nN, gid = wgid / nig, fm = gid * WGM, gsz = (nM - fm) < WGM ? (nM - fm) : WGM;
        u.pm = g * nM + fm + ((wgid % nig) % gsz); u.pn = g * nN + (wgid % nig) / gsz; return true;
    }
};

template <class Epi, bool ALIGN_EPI = true, bool GATHER = false, bool I8 = false, bool KQ = false>
__device__ __forceinline__ void gemm_phase(LAS unsigned char* lds, const Gemm g, const TileOrder& S, const Epi& E, int wave_) {
    const int wid = __builtin_amdgcn_readfirstlane(wave_), lane = lane_fresh(), tid = wid * 64 + lane, wr = wid >> 2, wc = wid & 3, fr = lane & 15, fq = lane >> 4;
    const int K = g.K, nt = K / BK;
    unsigned voffA[2], voffB[2]; int stR[2], stC[2];
#pragma unroll
    for (int i = 0; i < 2; ++i) { int R, C; stage_rc(tid * 16 + i * 8192, R, C); const int Rb = Epi::PERM ? ((R & ~31) + perm32(R & 31)) : R; stR[i] = R; stC[i] = C;
        voffA[i] = (unsigned)(R * g.lda + C) * 2u; voffB[i] = (unsigned)(Rb * g.ldb + C) * 2u; }
    const size_t kstep = (size_t)(BK * 2);
    const size_t hstepA = GATHER ? 0 : (size_t)HALF * g.lda * 2, hstepB = (size_t)HALF * g.ldb * 2;
    const size_t tstepA = GATHER ? 0 : 2 * (size_t)HALF * g.lda * 2, tstepB = 2 * hstepB;
    unsigned vAc[2][2], vAn[2][2];
#define PG8_GOFF(dst, pm_) do { _Pragma("unroll") for (int _h = 0; _h < 2; ++_h) _Pragma("unroll") for (int _i = 0; _i < 2; ++_i) \
        dst[_h][_i] = (unsigned)(g.gather[(pm_) * 256 + _h * 128 + stR[_i]] * g.lda + stC[_i]) * 2u; } while (0)
    const unsigned ldsw = (unsigned)wid * 1024u;
    const int aoff = lds_byte(wr * 64 + fr, fq * 8), boff = lds_byte(wc * 32 + fr, fq * 8);
#define PG8_SA(b, h) (((b) * 2 + (h)) * HTB)
#define PG8_SB(b, h) ((4 + (b) * 2 + (h)) * HTB)
#define PG8_STAGE(bufoff, gbase, voff) do { _Pragma("unroll") for (int _i = 0; _i < 2; ++_i) \
        __builtin_amdgcn_global_load_lds((const unsigned*)((const char*)(gbase) + (voff)[_i]), (LAS unsigned*)(lds + (bufoff) + ldsw + _i * 8192), 16, 0, 0); } while (0)
#define PG8_LDA(dst, b, h) do { _Pragma("unroll") for (int m = 0; m < 4; ++m) _Pragma("unroll") for (int k = 0; k < 2; ++k) dst[m][k] = *(const LAS bf16x8*)(lds + PG8_SA(b, h) + aoff + m * 2048 + k * 1024); } while (0)
#define PG8_LDB(dst, b, h) do { _Pragma("unroll") for (int n = 0; n < 2; ++n) _Pragma("unroll") for (int k = 0; k < 2; ++k) dst[n][k] = *(const LAS bf16x8*)(lds + PG8_SB(b, h) + boff + n * 2048 + k * 1024); } while (0)
#define PG8_MMA(ai, bj, At, Bt) do { __builtin_amdgcn_s_setprio(1); _Pragma("unroll") for (int m = 0; m < 4; ++m) _Pragma("unroll") for (int n = 0; n < 2; ++n) _Pragma("unroll") for (int k = 0; k < 2; ++k) \
        acc[ai][bj][m][n] = I8 ? __builtin_bit_cast(f32x4, __builtin_amdgcn_mfma_i32_16x16x64_i8(__builtin_bit_cast(i32x4, Bt[n][k]), __builtin_bit_cast(i32x4, At[m][k]), __builtin_bit_cast(i32x4, acc[ai][bj][m][n]), 0, 0, 0)) \
                                : __builtin_amdgcn_mfma_f32_16x16x32_bf16(Bt[n][k], At[m][k], acc[ai][bj][m][n], 0, 0, 0); __builtin_amdgcn_s_setprio(0); } while (0)
    float sc[4]; int scbuf = 0;
#define PG8_LDSC(ai, kb) do { if constexpr (KQ) { const u32x2 w_ = *(const LAS u32x2*)(lds + SCQ_OFF + scbuf * 8192 + ((((kb) * 2 + ai) * 2 + wr) * 64 + fr * 4) * 2); \
        sc[0] = (float)__builtin_bit_cast(_Float16, (unsigned short)(w_.x & 0xffffu)); sc[1] = (float)__builtin_bit_cast(_Float16, (unsigned short)(w_.x >> 16)); \
        sc[2] = (float)__builtin_bit_cast(_Float16, (unsigned short)(w_.y & 0xffffu)); sc[3] = (float)__builtin_bit_cast(_Float16, (unsigned short)(w_.y >> 16)); } } while (0)
#define PG8_SCDMA(buf, pm_) do { int t16_ = lane * 16; asm volatile("" : "+v"(t16_));     \
        __builtin_amdgcn_global_load_lds((const unsigned*)((const char*)g.ksc + (size_t)(pm_) * 8192 + wid * 1024 + t16_), (LAS unsigned*)(lds + SCQ_OFF + (buf) * 8192 + ldsw), 16, 0, 0); } while (0)
    const i32x4 magicq = {0x4B400000, 0x4B400000, 0x4B400000, 0x4B400000};
#define PG8_MFQ(dst, Bt_, n_, m_) do { dst = __builtin_amdgcn_mfma_i32_16x16x64_i8(__builtin_bit_cast(i32x4, Bt_[n_][0]), __builtin_bit_cast(i32x4, At[m_][0]), magicq, 0, 0, 0); \
        dst = __builtin_amdgcn_mfma_i32_16x16x64_i8(__builtin_bit_cast(i32x4, Bt_[n_][1]), __builtin_bit_cast(i32x4, At[m_][1]), dst, 0, 0, 0); } while (0)
#define PG8_MMAQ2(ai) do { __builtin_amdgcn_s_setprio(1); i32x4 tq_[3]; _Pragma("unroll") for (int p_ = 0; p_ < 18; ++p_) { \
        if (p_ < 16) { const int m_ = (p_ >> 1) & 3, n_ = p_ & 1; if (p_ < 8) { PG8_MFQ(tq_[p_ % 3], B0, n_, m_); } else { PG8_MFQ(tq_[p_ % 3], B1, n_, m_); } } \
        if (p_ >= 2) { const int q_ = p_ - 2, m_ = (q_ >> 1) & 3, n_ = q_ & 1; acc[ai][q_ >> 3][m_][n_] += __builtin_bit_cast(f32x4, tq_[q_ % 3]) * sc[m_]; } \
        __builtin_amdgcn_sched_barrier(0); } \
        __builtin_amdgcn_s_setprio(0); } while (0)
#define PG8_MM(ai, bj, At, Bt) do { if constexpr (KQ) { if (bj == 0) { PG8_MMAQ2(ai); } } else { PG8_MMA(ai, bj, At, Bt); } } while (0)
#define PG8_WAIT_V(n) asm volatile("s_waitcnt vmcnt(" #n ")" ::: "memory")
#define PG8_WAIT_L(n) asm volatile("s_waitcnt lgkmcnt(" #n ")" ::: "memory")
#define PG8_BAR __builtin_amdgcn_s_barrier()
#define PG8_SCHED __builtin_amdgcn_sched_barrier(0)
#define PG8_STAGE_A(bufoff, gbase, h_, usenext) do { if constexpr (GATHER) { _Pragma("unroll") for (int _i = 0; _i < 2; ++_i) { const unsigned _v = (usenext) ? vAn[h_][_i] : vAc[h_][_i]; \
        __builtin_amdgcn_global_load_lds((const unsigned*)((const char*)(gbase) + _v), (LAS unsigned*)(lds + (bufoff) + ldsw + _i * 8192), 16, 0, 0); } } else { PG8_STAGE(bufoff, gbase, voffA); } } while (0)
    Unit cur, nxt; int ui = 0;
    if (!S.next(0, cur)) return;
    if constexpr (GATHER) { PG8_GOFF(vAc, cur.pm); }
    typename Epi::Pre pre; E.prefetch(pre, cur, wr, wc, fr, fq);
    f32x4 acc[2][2][4][2];
#pragma unroll
    for (int a = 0; a < 2; ++a)
#pragma unroll
        for (int b = 0; b < 2; ++b)
#pragma unroll
            for (int m = 0; m < 4; ++m)
#pragma unroll
                for (int n = 0; n < 2; ++n) acc[a][b][m][n] = (f32x4){0.f, 0.f, 0.f, 0.f};
    bf16x8 At[4][2], B0[2][2], B1[2][2];
    const char* cA = (const char*)g.A + (size_t)cur.pm * tstepA; const char* cB = (const char*)g.Bt + (size_t)cur.pn * tstepB;
    if constexpr (KQ) { PG8_SCDMA(0, cur.pm); }
    PG8_STAGE(PG8_SB(0, 0), cB, voffB); PG8_STAGE(PG8_SB(0, 1), cB + hstepB, voffB); PG8_STAGE_A(PG8_SA(0, 0), cA, 0, false); PG8_STAGE_A(PG8_SA(0, 1), cA + hstepA, 1, false);
    if (wr == 1) PG8_BAR;
    PG8_WAIT_V(2); PG8_BAR;
    PG8_STAGE(PG8_SB(1, 0), cB + kstep, voffB); PG8_STAGE_A(PG8_SA(1, 0), cA + kstep, 0, false); PG8_STAGE(PG8_SB(1, 1), cB + hstepB + kstep, voffB);
    PG8_WAIT_V(6); PG8_BAR;
    for (;;) {
        const bool has_next = S.next(ui + 1, nxt);
        if constexpr (GATHER) { if (has_next) { PG8_GOFF(vAn, nxt.pm); } else {
#pragma unroll
            for (int _h = 0; _h < 2; ++_h)
#pragma unroll
                for (int _i = 0; _i < 2; ++_i) vAn[_h][_i] = vAc[_h][_i]; } }
        const char* nA = has_next ? (const char*)g.A + (size_t)nxt.pm * tstepA : cA; const char* nB = has_next ? (const char*)g.Bt + (size_t)nxt.pn * tstepB : cB;
        if constexpr (KQ) { PG8_BAR;     if (has_next) { PG8_SCDMA(scbuf ^ 1, nxt.pm); } }
        for (int t = 0; t < nt; t += 2) {
            const bool last = (t == nt - 2);
            const char* a1 = cA + (size_t)(t + 1) * kstep;
            const char* a2 = last ? nA : cA + (size_t)(t + 2) * kstep; const char* b2 = last ? nB : cB + (size_t)(t + 2) * kstep;
            const char* a3 = a2 + kstep; const char* b3 = b2 + kstep;
            PG8_LDB(B0, 0, 0); PG8_LDB(B1, 0, 1); PG8_SCHED; PG8_LDA(At, 0, 0); PG8_LDSC(0, t); PG8_STAGE_A(PG8_SA(1, 1), a1 + hstepA, 1, false);
            PG8_WAIT_V(8); PG8_WAIT_L(0); PG8_BAR; PG8_MM(0, 0, At, B0); PG8_MM(0, 1, At, B1); PG8_BAR; PG8_SCHED;
            PG8_LDA(At, 0, 1); PG8_LDSC(1, t); PG8_STAGE(PG8_SB(0, 0), b2, voffB); PG8_STAGE(PG8_SB(0, 1), b2 + hstepB, voffB); PG8_STAGE_A(PG8_SA(0, 0), a2, 0, last);
            PG8_WAIT_V(8); PG8_WAIT_L(0); PG8_BAR; PG8_MM(1, 0, At, B0); PG8_MM(1, 1, At, B1); PG8_BAR; PG8_SCHED;
            PG8_LDB(B0, 1, 0); PG8_LDB(B1, 1, 1); PG8_SCHED; PG8_LDA(At, 1, 0); PG8_LDSC(0, t + 1); PG8_STAGE_A(PG8_SA(0, 1), a2 + hstepA, 1, last);
            PG8_WAIT_V(8); PG8_WAIT_L(0); PG8_BAR; PG8_MM(0, 0, At, B0); PG8_MM(0, 1, At, B1); PG8_BAR; PG8_SCHED;
            PG8_LDA(At, 1, 1); PG8_LDSC(1, t + 1); PG8_STAGE(PG8_SB(1, 0), b3, voffB); PG8_STAGE(PG8_SB(1, 1), b3 + hstepB, voffB); PG8_STAGE_A(PG8_SA(1, 0), a3, 0, last);
            PG8_WAIT_V(8); PG8_WAIT_L(0); PG8_BAR; PG8_MM(1, 0, At, B0); PG8_MM(1, 1, At, B1); PG8_BAR; PG8_SCHED;
        }
        if constexpr (ALIGN_EPI) { if (wr == 0) PG8_BAR; }
        if constexpr (KQ) {
#pragma unroll
            for (int ai = 0; ai < 2; ++ai) { float ss[4] = {0.f, 0.f, 0.f, 0.f};
#pragma unroll 2
                for (int k = 0; k < 16; ++k) { const u32x2 w_ = *(const LAS u32x2*)(lds + SCQ_OFF + scbuf * 8192 + (((k * 2 + ai) * 2 + wr) * 64 + fr * 4) * 2);
                    ss[0] += (float)__builtin_bit_cast(_Float16, (unsigned short)(w_.x & 0xffffu)); ss[1] += (float)__builtin_bit_cast(_Float16, (unsigned short)(w_.x >> 16));
                    ss[2] += (float)__builtin_bit_cast(_Float16, (unsigned short)(w_.y & 0xffffu)); ss[3] += (float)__builtin_bit_cast(_Float16, (unsigned short)(w_.y >> 16)); }
#pragma unroll
                for (int m = 0; m < 4; ++m) { const float corr = 12582912.0f * ss[m];
#pragma unroll
                    for (int bj = 0; bj < 2; ++bj)
#pragma unroll
                        for (int n = 0; n < 2; ++n) acc[ai][bj][m][n] -= corr; } }
        }
        E(acc, cur, wr, wc, fr, fq, pre);
        if (!has_next) break;
#pragma unroll
        for (int a = 0; a < 2; ++a)
#pragma unroll
            for (int b = 0; b < 2; ++b)
#pragma unroll
                for (int m = 0; m < 4; ++m)
#pragma unroll
                    for (int n = 0; n < 2; ++n) acc[a][b][m][n] = (f32x4){0.f, 0.f, 0.f, 0.f};
        cur = nxt; cA = nA; cB = nB; ++ui; scbuf ^= 1;
        E.prefetch(pre, cur, wr, wc, fr, fq);
        if constexpr (GATHER) {
#pragma unroll
            for (int _h = 0; _h < 2; ++_h)
#pragma unroll
                for (int _i = 0; _i < 2; ++_i) vAc[_h][_i] = vAn[_h][_i]; }
        if constexpr (ALIGN_EPI) { if (wr == 1) PG8_BAR; }
    }
    PG8_WAIT_V(0);
    if constexpr (!ALIGN_EPI) { if (wr == 0) PG8_BAR; }
    PG8_BAR;
#undef PG8_SA
#undef PG8_SB
#undef PG8_STAGE
#undef PG8_STAGE_A
#undef PG8_GOFF
#undef PG8_LDA
#undef PG8_LDB
#undef PG8_MMA
#undef PG8_MMAQ2
#undef PG8_MFQ
#undef PG8_MM
#undef PG8_LDSC
#undef PG8_SCDMA
#undef PG8_WAIT_V
#undef PG8_WAIT_L
#undef PG8_BAR
#undef PG8_SCHED
}
}
using pg8::Unit;

constexpr size_t MiB = 1024ull * 1024ull;
constexpr size_t al256(size_t x) { return (x + 255) & ~(size_t)255; }
constexpr size_t WS_COS128 = 0;
constexpr size_t WS_SIN128 = WS_COS128 + 4 * MiB;
constexpr size_t WS_COS128T = WS_SIN128 + 4 * MiB;
constexpr size_t WS_SIN128T = WS_COS128T + 4 * MiB;
constexpr size_t WS_COS64 = WS_SIN128T + 4 * MiB;
constexpr size_t WS_SIN64 = WS_COS64 + 2 * MiB;
constexpr size_t WS_WEV_MAIN = WS_SIN64 + 2 * MiB;
constexpr size_t WS_WEV_SW = WS_WEV_MAIN + 4 * MiB;
constexpr size_t WS_WEVO = WS_WEV_SW + 2 * MiB;
constexpr size_t WS_WGLU = WS_WEVO + 2 * MiB;
constexpr size_t WS_WOD_MAIN = WS_WGLU + 1 * MiB;
constexpr size_t WS_WOD_SW = WS_WOD_MAIN + 6 * MiB;
constexpr size_t WS_WODO = WS_WOD_SW + 4 * MiB;
constexpr size_t WS_WRT = WS_WODO + 2 * MiB;
constexpr size_t WS_WGT = WS_WRT + 128 * 1024;
constexpr size_t WS_S5LAM = WS_WGT + 64 * 1024;
constexpr size_t WS_S5BBAR = WS_S5LAM + 64 * 1024;
constexpr size_t WS_S5KTAB = WS_S5BBAR + 1 * MiB;
constexpr size_t WS_RSTD = WS_S5KTAB + 4 * MiB;
constexpr size_t WS_AFF = WS_RSTD + 128 * 1024;
constexpr size_t WS_TOK = WS_AFF + 2 * MiB;
constexpr size_t WS_GATEL = WS_TOK + 256 * 1024;
constexpr size_t WS_RSTDL = WS_GATEL + 256 * 1024;
constexpr size_t WS_INV = WS_RSTDL + 256 * 1024;
constexpr size_t WS_MLG = WS_INV + 2 * MiB;
constexpr size_t WS_MLEF = WS_MLG + 2 * MiB;
constexpr size_t WS_MLDEN = WS_MLEF + 1 * MiB;
constexpr size_t WS_MLA = WS_MLDEN + 1 * MiB;
constexpr size_t WS_MLN = WS_MLA + 64 * 1024;
constexpr size_t WS_LSE = WS_MLN + 1 * MiB;
constexpr size_t WS_BAR = WS_LSE + 2 * MiB;
constexpr size_t WS_XSC = WS_BAR + 64 * 1024;
constexpr size_t WS_WSC = WS_XSC + 128 * 1024;
constexpr size_t WS_WINSC = WS_WSC + 512 * 1024;
constexpr size_t WS_ACTSC = WS_WINSC + 32 * 1024;
constexpr size_t WS_W2SC = WS_ACTSC + 2 * MiB;
constexpr size_t WS_SMALL_END = WS_W2SC + 64 * 1024;
constexpr size_t WS_XB = al256(WS_SMALL_END);
constexpr size_t WS_HBUF = WS_XB + 64 * MiB;
constexpr size_t WS_W13 = WS_HBUF + 64 * MiB;
constexpr size_t WS_W2 = WS_W13 + 128 * MiB;
constexpr size_t WS_BIG = WS_W2 + 64 * MiB;
constexpr size_t WS_END = WS_BIG + 512 * MiB;
constexpr size_t BG_AXE = WS_BIG;
constexpr size_t BG_ACT = WS_BIG + 128 * MiB;
constexpr size_t BG_YE = WS_BIG + 384 * MiB;
constexpr size_t BG_Q = WS_BIG;
constexpr size_t BG_K = BG_Q + 32 * MiB;
constexpr size_t BG_KT = BG_K + 32 * MiB;
constexpr size_t BG_VT = BG_KT + 32 * MiB;
constexpr size_t BG_G = BG_VT + 32 * MiB;
constexpr size_t BG_A2 = BG_G + 32 * MiB;
constexpr size_t BG_B2 = BG_A2 + 48 * MiB;
constexpr size_t BG_GM = BG_B2 + 24 * MiB;
constexpr size_t BG_XRAW = BG_GM + 8 * MiB;
constexpr size_t BG_OINTRA = BG_XRAW + 32 * MiB;
constexpr size_t BG_KV = BG_OINTRA + 32 * MiB;
constexpr size_t BG_YG = BG_KV + 64 * MiB;
constexpr size_t BG_AOUT = BG_YG + 32 * MiB;
static_assert(BG_AOUT + 64 * MiB <= WS_END, "even scratch");
constexpr size_t BO_CQ = WS_BIG;
constexpr size_t BO_CK = BO_CQ + 48 * MiB;
constexpr size_t BO_CVT = BO_CK + 48 * MiB;
constexpr size_t BO_MQ = BO_CVT + 48 * MiB;
constexpr size_t BO_MK = BO_MQ + 32 * MiB;
constexpr size_t BO_MO = BO_MK + 32 * MiB;
constexpr size_t BO_MKT = BO_MO + 32 * MiB;
constexpr size_t BO_MVT = BO_MKT + 32 * MiB;
constexpr size_t BO_ODIL = BO_MVT + 32 * MiB;
constexpr size_t BO_NUMF = BO_ODIL + 48 * MiB;
constexpr size_t BO_NUMB = BO_NUMF + 32 * MiB;
constexpr size_t BO_KV = BO_NUMB + 32 * MiB;
constexpr size_t BO_AOUT = BO_CQ;
static_assert(BO_KV + 64 * MiB <= WS_END, "odd scratch");

struct Args { const float* in[24]; float* out; unsigned char* ws; int ph_lo, ph_hi; };

__device__ __forceinline__ unsigned q4i8(f32x4 v, float inv) {
    const f32x4 t = v * inv + 12582912.0f;
    const unsigned p01 = __builtin_amdgcn_perm(__float_as_uint(t[1]), __float_as_uint(t[0]), 0x0c0c0400u), p23 = __builtin_amdgcn_perm(__float_as_uint(t[3]), __float_as_uint(t[2]), 0x0c0c0400u);
    return __builtin_amdgcn_perm(p23, p01, 0x05040100u);
}
__device__ __forceinline__ float amax4(f32x4 v) { return fmaxf(fmaxf(fabsf(v[0]), fabsf(v[1])), fmaxf(fabsf(v[2]), fabsf(v[3]))); }
__device__ __forceinline__ float wave_max(float v) {
#pragma unroll
    for (int o = 1; o < 64; o <<= 1) v = fmaxf(v, __shfl_xor(v, o));
    return v;
}
typedef f32x4 (&AccT)[2][2][4][2];
#define EPI_NOPRE struct Pre {}; __device__ __forceinline__ void prefetch(Pre&, const Unit&, int, int, int, int) const {}
__device__ __forceinline__ void st4bf(bf16_t* p, f32x4 v) { u32x2 w; w.x = pk2(v[0], v[1]); w.y = pk2(v[2], v[3]); *(u32x2*)p = w; }
__device__ __forceinline__ f32x4 ld4bf(const bf16_t* p) { const u32x2 w = *(const u32x2*)p; return (f32x4){lo_bf(w.x), hi_bf(w.x), lo_bf(w.y), hi_bf(w.y)}; }
__device__ __forceinline__ void st_bf16x8(bf16_t* p, f32x4 a, f32x4 b) {
    u32x4 w; w.x = pk2(a[0], a[1]); w.y = pk2(a[2], a[3]); w.z = pk2(b[0], b[1]); w.w = pk2(b[2], b[3]); *(u32x4*)p = w;
}

__device__ __forceinline__ void st_t8(bf16_t* dst, size_t ld, int f0, size_t col, f32x4 a, f32x4 b) {
    const unsigned w0 = pk2(a[0], a[1]), w1 = pk2(a[2], a[3]), w2 = pk2(b[0], b[1]), w3 = pk2(b[2], b[3]);
    bf16_t* p = dst + (size_t)f0 * ld + col;
    p[0] = (bf16_t)(w0 & 0xffffu); p[ld] = (bf16_t)(w0 >> 16); p[2 * ld] = (bf16_t)(w1 & 0xffffu); p[3 * ld] = (bf16_t)(w1 >> 16);
    p[4 * ld] = (bf16_t)(w2 & 0xffffu); p[5 * ld] = (bf16_t)(w2 >> 16); p[6 * ld] = (bf16_t)(w3 & 0xffffu); p[7 * ld] = (bf16_t)(w3 >> 16);
}
constexpr int TSCR_OFF = 131072, TSCR_WAVE = 32 * 24 * 2;
__device__ __forceinline__ void tstage(LAS bf16_t* scr, int fq, int tslot, f32x4 a, f32x4 b) {
    const unsigned w0 = pk2(a[0], a[1]), w1 = pk2(a[2], a[3]), w2 = pk2(b[0], b[1]), w3 = pk2(b[2], b[3]);
    LAS bf16_t* p = scr + (8 * fq) * 24 + tslot;
    p[0] = (bf16_t)(w0 & 0xffffu); p[24] = (bf16_t)(w0 >> 16); p[48] = (bf16_t)(w1 & 0xffffu); p[72] = (bf16_t)(w1 >> 16);
    p[96] = (bf16_t)(w2 & 0xffffu); p[120] = (bf16_t)(w2 >> 16); p[144] = (bf16_t)(w3 & 0xffffu); p[168] = (bf16_t)(w3 >> 16);
}
__device__ __forceinline__ void tdrain16(LAS bf16_t* scr, int lane, bf16_t* dst, size_t ld, int fbase, size_t col0) {
    LDS_WAIT();
    const u32x4 v = *(const LAS u32x4*)(scr + (lane >> 1) * 24 + 8 * (lane & 1));
    *(u32x4*)(dst + (size_t)(fbase + (lane >> 1)) * ld + col0 + 8 * (lane & 1)) = v;
    LDS_WAIT();
}
__device__ __forceinline__ void dequant_acc(AccT acc, const float* rs, const float* cs) {
    f32x4 c[2][2];
#pragma unroll
    for (int bj = 0; bj < 2; ++bj)
#pragma unroll
        for (int n = 0; n < 2; ++n) c[bj][n] = *(const f32x4*)(cs + bj * 128 + n * 4);
#pragma unroll
    for (int ai = 0; ai < 2; ++ai)
#pragma unroll
        for (int m = 0; m < 4; ++m) { const float r = rs[ai * 128 + m * 16];
#pragma unroll
            for (int bj = 0; bj < 2; ++bj)
#pragma unroll
                for (int n = 0; n < 2; ++n)
#pragma unroll
                    for (int j = 0; j < 4; ++j) acc[ai][bj][m][n][j] = (float)__float_as_int(acc[ai][bj][m][n][j]) * (r * c[bj][n][j]); }
}
struct EpiEvenMain {
    static constexpr bool PERM = true; EPI_NOPRE
    bf16_t *q, *k, *g, *a2, *kT, *vT; const float *cosT, *sinT; LAS unsigned char* lds; const float *rsc, *csc;
    __device__ __forceinline__ void operator()(AccT acc, const Unit& u, int wr, int wc, int fr, int fq, const Pre& pre) const {
        const int pn = u.pn, cc0 = wc * 32 + fq * 8;
        dequant_acc(acc, rsc + u.pm * 256 + wr * 64 + fr, csc + pn * 256 + cc0);
        if (pn < 4) {
            bf16_t* dst = (pn < 2) ? q : k; const float sc = (pn < 2) ? 1.0f : 0.08838834764831845f;
            const int head = 2 * (pn & 1) + (cc0 >> 6), i0 = cc0 & 63;
#pragma unroll
            for (int ai = 0; ai < 2; ++ai)
#pragma unroll
                for (int m = 0; m < 4; ++m) {
                    const int t = u.pm * 256 + ai * 128 + wr * 64 + m * 16 + fr, pos = t & (SEQ - 1);
                    const f32x4 c0 = *(const f32x4*)(cosT + pos * 64 + i0), c1 = *(const f32x4*)(cosT + pos * 64 + i0 + 4);
                    const f32x4 s0 = *(const f32x4*)(sinT + pos * 64 + i0), s1 = *(const f32x4*)(sinT + pos * 64 + i0 + 4);
                    const f32x4 x10 = acc[ai][0][m][0], x11 = acc[ai][0][m][1], x20 = acc[ai][1][m][0], x21 = acc[ai][1][m][1];
                    const f32x4 a0 = (x10 * c0 - x20 * s0) * sc, a1 = (x11 * c1 - x21 * s1) * sc, b0 = (x10 * s0 + x20 * c0) * sc, b1 = (x11 * s1 + x21 * c1) * sc;
                    bf16_t* o = dst + (size_t)t * 512 + head * 128 + i0;
                    st_bf16x8(o, a0, a1); st_bf16x8(o + 64, b0, b1);
                    if (pn >= 2) { LAS bf16_t* scr = (LAS bf16_t*)(lds + TSCR_OFF + (wr * 4 + wc) * TSCR_WAVE); const int lane = fq * 16 + fr; const size_t tb = (size_t)(t - fr);
                        const int fb = (2 * (pn & 1) + (wc >> 1)) * 128 + ((wc & 1) * 32);
                        tstage(scr, fq, fr, a0, a1); tdrain16(scr, lane, kT, T, fb, tb);
                        tstage(scr, fq, fr, b0, b1); tdrain16(scr, lane, kT, T, fb + 64, tb); }
                }
        } else if (pn < 6) {
#pragma unroll
            for (int ai = 0; ai < 2; ++ai)
#pragma unroll
                for (int m = 0; m < 4; ++m) {
                    const int t = u.pm * 256 + ai * 128 + wr * 64 + m * 16 + fr;
#pragma unroll
                    for (int bj = 0; bj < 2; ++bj) st_bf16x8(g + (size_t)t * 512 + (pn - 4) * 256 + bj * 128 + cc0, acc[ai][bj][m][0], acc[ai][bj][m][1]);
                }
        } else if (pn < 8) {
#pragma unroll
            for (int ai = 0; ai < 2; ++ai)
#pragma unroll
                for (int m = 0; m < 4; ++m) {
                    const int t = u.pm * 256 + ai * 128 + wr * 64 + m * 16 + fr, mrow = t >> 5, i = t & 31;
#pragma unroll
                    for (int bj = 0; bj < 2; ++bj) { const int ch0 = (pn - 6) * 256 + bj * 128 + cc0, grp = ch0 >> 4, co0 = ch0 & 15;
                        st_bf16x8(a2 + ((size_t)(grp * 1024 + mrow) * 768 + i * 16 + co0), acc[ai][bj][m][0], acc[ai][bj][m][1]); }
                }
        } else {
#pragma unroll
            for (int ai = 0; ai < 2; ++ai)
#pragma unroll
                for (int m = 0; m < 4; ++m) {
                    const int t = u.pm * 256 + ai * 128 + wr * 64 + m * 16 + fr;
#pragma unroll
                    for (int bj = 0; bj < 2; ++bj) { LAS bf16_t* scr = (LAS bf16_t*)(lds + TSCR_OFF + (wr * 4 + wc) * TSCR_WAVE);
                        tstage(scr, fq, fr, acc[ai][bj][m][0], acc[ai][bj][m][1]); tdrain16(scr, fq * 16 + fr, vT, T, (pn - 8) * 256 + bj * 128 + wc * 32, (size_t)(t - fr)); }
                }
        }
    }
};
struct EpiS5A {
    static constexpr bool PERM = false; EPI_NOPRE
    float* xraw;
    __device__ __forceinline__ void operator()(AccT acc, const Unit& u, int wr, int wc, int fr, int fq, const Pre& pre) const {
#pragma unroll
        for (int ai = 0; ai < 2; ++ai)
#pragma unroll
            for (int m = 0; m < 4; ++m) { float* rowp = xraw + (size_t)(u.pm * 256 + ai * 128 + wr * 64 + m * 16 + fr) * 256 + wc * 32 + 4 * fq;
#pragma unroll
                for (int bj = 0; bj < 2; ++bj)
#pragma unroll
                    for (int n = 0; n < 2; ++n) *(f32x4*)(rowp + bj * 128 + n * 16) = acc[ai][bj][m][n]; }
    }
};
struct EpiS5B {
    static constexpr bool PERM = true; EPI_NOPRE
    const bf16_t* a2; const float* dskip; bf16_t* yg;
    __device__ __forceinline__ void operator()(AccT acc, const Unit& u, int wr, int wc, int fr, int fq, const Pre& pre) const {
        const int grp = u.pn >> 1, pnl = u.pn & 1, cc0 = wc * 32 + fq * 8;
#pragma unroll
        for (int ai = 0; ai < 2; ++ai)
#pragma unroll
            for (int m = 0; m < 4; ++m) {
                const int row = u.pm * 256 + ai * 128 + wr * 64 + m * 16 + fr, mr = row & 1023;
#pragma unroll
                for (int bj = 0; bj < 2; ++bj) {
                    const int col = pnl * 256 + bj * 128 + cc0, i = col >> 4, co0 = col & 15;
                    const int t = (mr >> 9) * SEQ + (mr & 511) * 32 + i, ch = grp * 16 + co0;
                    const u32x4 uw = *(const u32x4*)(a2 + (size_t)row * 768 + col);
                    const f32x4 d0 = *(const f32x4*)(dskip + ch), d1 = *(const f32x4*)(dskip + ch + 4);
                    f32x4 y0 = acc[ai][bj][m][0], y1 = acc[ai][bj][m][1];
                    y0[0] += d0[0] * lo_bf(uw.x); y0[1] += d0[1] * hi_bf(uw.x); y0[2] += d0[2] * lo_bf(uw.y); y0[3] += d0[3] * hi_bf(uw.y);
                    y1[0] += d1[0] * lo_bf(uw.z); y1[1] += d1[1] * hi_bf(uw.z); y1[2] += d1[2] * lo_bf(uw.w); y1[3] += d1[3] * hi_bf(uw.w);
#pragma unroll
                    for (int j = 0; j < 4; ++j) { y0[j] = gelu_tanh(y0[j]); y1[j] = gelu_tanh(y1[j]); }
                    st_bf16x8(yg + (size_t)t * 512 + ch, y0, y1);
                }
            }
    }
};
struct EpiGlu {
    static constexpr bool PERM = true; EPI_NOPRE
    const bf16_t* yg; const float* bias; bf16_t* aout;
    __device__ __forceinline__ void operator()(AccT acc, const Unit& u, int wr, int wc, int fr, int fq, const Pre& pre) const {
        const int cc0 = wc * 32 + fq * 8;
#pragma unroll
        for (int ai = 0; ai < 2; ++ai)
#pragma unroll
            for (int m = 0; m < 4; ++m) {
                const int t = u.pm * 256 + ai * 128 + wr * 64 + m * 16 + fr;
#pragma unroll
                for (int bj = 0; bj < 2; ++bj) {
                    const int c = u.pn * 256 + bj * 128 + cc0;
                    const u32x4 yw = *(const u32x4*)(yg + (size_t)t * 512 + c);
                    const f32x4 b0 = *(const f32x4*)(bias + c), b1 = *(const f32x4*)(bias + c + 4);
                    const f32x4 z0 = acc[ai][bj][m][0] + b0, z1 = acc[ai][bj][m][1] + b1;
                    f32x4 o0, o1;
                    o0[0] = lo_bf(yw.x) * sigmoidf_(z0[0]); o0[1] = hi_bf(yw.x) * sigmoidf_(z0[1]); o0[2] = lo_bf(yw.y) * sigmoidf_(z0[2]); o0[3] = hi_bf(yw.y) * sigmoidf_(z0[3]);
                    o1[0] = lo_bf(yw.z) * sigmoidf_(z1[0]); o1[1] = hi_bf(yw.z) * sigmoidf_(z1[1]); o1[2] = lo_bf(yw.w) * sigmoidf_(z1[2]); o1[3] = hi_bf(yw.w) * sigmoidf_(z1[3]);
                    st_bf16x8(aout + (size_t)t * 1024 + 512 + c, o0, o1);
                }
            }
    }
};
template <bool XIN_BF16> struct EpiResid {
    static constexpr bool PERM = true; EPI_NOPRE
    const float* xin32; bf16_t* xb;
    __device__ __forceinline__ void operator()(AccT acc, const Unit& u, int wr, int wc, int fr, int fq, const Pre& pre) const {
        const int c0 = u.pn * 256 + wc * 32 + 8 * fq;
#pragma unroll
        for (int ai = 0; ai < 2; ++ai)
#pragma unroll
            for (int m = 0; m < 4; ++m) { const size_t off = (size_t)(u.pm * 256 + ai * 128 + wr * 64 + m * 16 + fr) * 1024 + c0;
#pragma unroll
                for (int bj = 0; bj < 2; ++bj) { f32x4 x0, x1;
                    if (XIN_BF16) { const u32x4 w = *(const u32x4*)(xb + off + bj * 128); x0 = (f32x4){lo_bf(w.x), hi_bf(w.x), lo_bf(w.y), hi_bf(w.y)}; x1 = (f32x4){lo_bf(w.z), hi_bf(w.z), lo_bf(w.w), hi_bf(w.w)}; }
                    else { x0 = __builtin_nontemporal_load((const f32x4*)(xin32 + off + bj * 128)); x1 = __builtin_nontemporal_load((const f32x4*)(xin32 + off + bj * 128 + 4)); }
                    st_bf16x8(xb + off + bj * 128, x0 + acc[ai][bj][m][0], x1 + acc[ai][bj][m][1]); }
                asm volatile("" ::: "memory"); }
    }
};
struct EpiOddMain {
    static constexpr bool PERM = true; EPI_NOPRE
    unsigned char* ws; const float *cosT, *sinT; LAS unsigned char* lds; const float *rsc, *csc;
    __device__ __forceinline__ void operator()(AccT acc, const Unit& u, int wr, int wc, int fr, int fq, const Pre& pre) const {
        asm volatile("" : "+v"(fr), "+v"(fq));
        const int pn = u.pn, cc0 = wc * 32 + fq * 8;
        dequant_acc(acc, rsc + u.pm * 256 + wr * 64 + fr, csc + pn * 256 + cc0);
        if (pn < 6) {
            bf16_t* dst = (bf16_t*)(ws + (pn < 3 ? BO_CQ : BO_CK)); const int grp = pn < 3 ? pn : pn - 3, sh = 2 * grp, hh = wc, i0 = fq * 8;
#pragma unroll
            for (int ai = 0; ai < 2; ++ai)
#pragma unroll
                for (int m = 0; m < 4; ++m) {
                    const int t = u.pm * 256 + ai * 128 + wr * 64 + m * 16 + fr, pos = t & (SEQ - 1), b = t >> 14;
                    const int pp = (pos & ((1 << sh) - 1)) * (SEQ >> sh) + (pos >> sh);
                    const f32x4 c0 = *(const f32x4*)(cosT + pos * 32 + i0), c1 = *(const f32x4*)(cosT + pos * 32 + i0 + 4);
                    const f32x4 s0 = *(const f32x4*)(sinT + pos * 32 + i0), s1 = *(const f32x4*)(sinT + pos * 32 + i0 + 4);
                    const f32x4 x10 = acc[ai][0][m][0], x11 = acc[ai][0][m][1], x20 = acc[ai][1][m][0], x21 = acc[ai][1][m][1];
                    bf16_t* o = dst + ((size_t)(grp * 4 + hh) * T + b * SEQ + pp) * 64 + i0;
                    st_bf16x8(o, x10 * c0 - x20 * s0, x11 * c1 - x21 * s1);
                    st_bf16x8(o + 32, x10 * s0 + x20 * c0, x11 * s1 + x21 * c1);
                }
        } else if (pn < 12) {
            const size_t boff = (pn < 8) ? BO_MQ : (pn < 10 ? BO_MK : BO_MO);
            bf16_t* dst = (bf16_t*)(ws + boff); bf16_t* mkT = (bf16_t*)(ws + BO_MKT); const bool isk = (pn >= 8 && pn < 10); const float sc = isk ? 0.08838834764831845f : 1.0f;
            const int cb = (pn & 1) * 256;
#pragma unroll
            for (int ai = 0; ai < 2; ++ai)
#pragma unroll
                for (int m = 0; m < 4; ++m) {
                    const int t = u.pm * 256 + ai * 128 + wr * 64 + m * 16 + fr;
#pragma unroll
                    for (int bj = 0; bj < 2; ++bj) { const f32x4 v0 = acc[ai][bj][m][0] * sc, v1 = acc[ai][bj][m][1] * sc;
                        st_bf16x8(dst + (size_t)t * 512 + cb + bj * 128 + cc0, v0, v1);
                        if (isk) { LAS bf16_t* scr = (LAS bf16_t*)(lds + TSCR_OFF + (wr * 4 + wc) * TSCR_WAVE); tstage(scr, fq, fr, v0, v1); tdrain16(scr, fq * 16 + fr, mkT, T, cb + bj * 128 + wc * 32, (size_t)(t - fr)); } }
                }
        } else if (pn < 14) {
            bf16_t* mvT = (bf16_t*)(ws + BO_MVT); const int cb = (pn - 12) * 256;
#pragma unroll
            for (int ai = 0; ai < 2; ++ai)
#pragma unroll
                for (int m = 0; m < 4; ++m) {
                    const int t = u.pm * 256 + ai * 128 + wr * 64 + m * 16 + fr;
#pragma unroll
                    for (int bj = 0; bj < 2; ++bj) { LAS bf16_t* scr = (LAS bf16_t*)(lds + TSCR_OFF + (wr * 4 + wc) * TSCR_WAVE);
                        tstage(scr, fq, fr, acc[ai][bj][m][0], acc[ai][bj][m][1]); tdrain16(scr, fq * 16 + fr, mvT, T, cb + bj * 128 + wc * 32, (size_t)(t - fr)); }
                }
        } else {
            bf16_t* cvT = (bf16_t*)(ws + BO_CVT); const int grp = pn - 14, sh = 2 * grp;
#pragma unroll
            for (int ai = 0; ai < 2; ++ai)
#pragma unroll
                for (int m = 0; m < 4; ++m) {
                    const int t = u.pm * 256 + ai * 128 + wr * 64 + m * 16 + fr, pos = t & (SEQ - 1), b = t >> 14;
                    const int pp = (pos & ((1 << sh) - 1)) * (SEQ >> sh) + (pos >> sh);
#pragma unroll
                    for (int bj = 0; bj < 2; ++bj) {
                        if (grp == 2) st_t8(cvT, T, grp * 256 + bj * 128 + cc0, (size_t)b * SEQ + pp, acc[ai][bj][m][0], acc[ai][bj][m][1]);
                        else { LAS bf16_t* scr = (LAS bf16_t*)(lds + TSCR_OFF + (wr * 4 + wc) * TSCR_WAVE); const int lane = fq * 16 + fr, fb = grp * 256 + bj * 128 + wc * 32, pos0 = pos - fr;
                            if (grp == 0) { tstage(scr, fq, fr, acc[ai][bj][m][0], acc[ai][bj][m][1]); tdrain16(scr, lane, cvT, T, fb, (size_t)b * SEQ + pos0); }
                            else { tstage(scr, fq, (fr & 3) * 4 + (fr >> 2), acc[ai][bj][m][0], acc[ai][bj][m][1]); LDS_WAIT();
                                const u32x4 v = *(const LAS u32x4*)(scr + (lane >> 1) * 24 + 8 * (lane & 1)); bf16_t* rowp = cvT + (size_t)(fb + (lane >> 1)) * T + (size_t)b * SEQ + (pos0 >> 2);
                                *(u32x2*)(rowp + (size_t)(2 * (lane & 1)) * (SEQ >> 2)) = (u32x2){v.x, v.y}; *(u32x2*)(rowp + (size_t)(2 * (lane & 1) + 1) * (SEQ >> 2)) = (u32x2){v.z, v.w}; LDS_WAIT(); } } }
                }
        }
    }
};
constexpr int RED_OFF = 131072;
struct EpiMoe1 {
    static constexpr bool PERM = true;
    signed char* actq; unsigned short* actsc; const float* rowf; const float* wsc; LAS unsigned char* lds;
    struct Pre { float rs[2][4]; };
    __device__ __forceinline__ void prefetch(Pre& p, const Unit& u, int wr, int wc, int fr, int fq) const {
#pragma unroll
        for (int ai = 0; ai < 2; ++ai)
#pragma unroll
            for (int m = 0; m < 4; ++m) p.rs[ai][m] = rowf[u.pm * 256 + ai * 128 + wr * 64 + m * 16 + fr];
    }
    __device__ __forceinline__ void operator()(AccT acc, const Unit& u, int wr, int wc, int fr, int fq, const Pre& pre) const {
        asm volatile("" : "+v"(fr), "+v"(fq));
        const int kb = u.pn & 15;
        const float* w = wsc + (size_t)u.pn * 256 + wc * 32 + fq * 8;
        f32x4 wa[2], wg[2]; wa[0] = *(const f32x4*)w; wa[1] = *(const f32x4*)(w + 4); wg[0] = *(const f32x4*)(w + 128); wg[1] = *(const f32x4*)(w + 132);
        LAS float* red = (LAS float*)(lds + RED_OFF);
#pragma unroll
        for (int ai = 0; ai < 2; ++ai)
#pragma unroll
            for (int m = 0; m < 4; ++m) {
                const float rs = pre.rs[ai][m]; f32x4 o0, o1; float mm = 0.f;
#pragma unroll
                for (int j = 0; j < 4; ++j) {
                    const float a0 = (float)__float_as_int(acc[ai][0][m][0][j]) * (rs * wa[0][j]), g0 = (float)__float_as_int(acc[ai][1][m][0][j]) * (rs * wg[0][j]);
                    const float a1 = (float)__float_as_int(acc[ai][0][m][1][j]) * (rs * wa[1][j]), g1 = (float)__float_as_int(acc[ai][1][m][1][j]) * (rs * wg[1][j]);
                    o0[j] = a0 * g0 * __builtin_amdgcn_rcpf(1.0f + __builtin_amdgcn_exp2f(-a0)); o1[j] = a1 * g1 * __builtin_amdgcn_rcpf(1.0f + __builtin_amdgcn_exp2f(-a1)); mm = fmaxf(mm, fmaxf(fabsf(o0[j]), fabsf(o1[j]))); }
                acc[ai][0][m][0] = o0; acc[ai][0][m][1] = o1;
                mm = fmaxf(mm, __shfl_xor(mm, 16)); mm = fmaxf(mm, __shfl_xor(mm, 32));
                if (fq == 0) red[(ai * 128 + wr * 64 + m * 16 + fr) * 4 + wc] = mm;
            }
        LDS_WAIT(); __builtin_amdgcn_s_barrier();
        unsigned short shb[4];
#pragma unroll
        for (int ai = 0; ai < 2; ++ai)
#pragma unroll
            for (int m = 0; m < 4; ++m) {
                const int rl = ai * 128 + wr * 64 + m * 16 + fr; const size_t row = (size_t)u.pm * 256 + rl;
                const f32x4 r4 = *(const LAS f32x4*)(red + rl * 4);
                const _Float16 sh = (_Float16)(fmaxf(fmaxf(r4[0], r4[1]), fmaxf(r4[2], r4[3])) * (1.0f / 127.0f)); const float sf = (float)sh, inv = sf > 0.f ? __builtin_amdgcn_rcpf(sf) : 0.f;
                u32x2 q; q.x = q4i8(acc[ai][0][m][0], inv); q.y = q4i8(acc[ai][0][m][1], inv);
                *(u32x2*)(actq + row * FF + kb * 128 + wc * 32 + fq * 8) = q;
                shb[m] = __builtin_bit_cast(unsigned short, sh);
                if (m == 3 && wc == 0 && fq == 0)
                    *(u32x2*)(actsc + (size_t)u.pm * 4096 + (((kb * 2 + ai) * 2 + wr) * 64 + fr * 4)) = (u32x2){(unsigned)shb[0] | ((unsigned)shb[1] << 16), (unsigned)shb[2] | ((unsigned)shb[3] << 16)};
            }
    }
};
struct EpiMoe2 {
    static constexpr bool PERM = true;
    bf16_t* ye; const float* gate; const float* w2sc;
    EPI_NOPRE
    __device__ __forceinline__ void operator()(AccT acc, const Unit& u, int wr, int wc, int fr, int fq, const Pre& pre) const {
        asm volatile("" : "+v"(fr), "+v"(fq));
        const int c0 = (u.pn & 3) * 256 + wc * 32 + fq * 8;
        const float* cs = w2sc + (size_t)u.pn * 256 + wc * 32 + fq * 8; f32x4 c[2][2];
#pragma unroll
        for (int bj = 0; bj < 2; ++bj) { c[bj][0] = *(const f32x4*)(cs + bj * 128); c[bj][1] = *(const f32x4*)(cs + bj * 128 + 4); }
#pragma unroll
        for (int ai = 0; ai < 2; ++ai)
#pragma unroll
            for (int m = 0; m < 4; ++m) {
                const int row = u.pm * 256 + ai * 128 + wr * 64 + m * 16 + fr; const float gt = gate[row];
#pragma unroll
                for (int bj = 0; bj < 2; ++bj) st_bf16x8(ye + (size_t)row * DM + c0 + bj * 128, acc[ai][bj][m][0] * (c[bj][0] * gt), acc[ai][bj][m][1] * (c[bj][1] * gt));
            }
    }
};

typedef const __attribute__((address_space(4))) void* KargP;
template <int OFF> __device__ __forceinline__ const GAS float* ldarg_ptr(KargP kp) { unsigned long long v; asm volatile("s_load_dwordx2 %0, %1, %2\n\ts_waitcnt lgkmcnt(0)" : "=s"(v) : "s"(kp), "n"(OFF)); return (const GAS float*)v; }
struct Ctx { KargP kp; GAS float* out; GAS unsigned char* ws; LAS unsigned char* lds; int tid, lane, wave, bid, G; };
#define INP(i) ((const float*)ldarg_ptr<8 * (i)>(C.kp))
#define WSP(T_, off) ((T_*)(C.ws + (off)))

constexpr int TR_SCR = 64 * 65 * 4;
__device__ __forceinline__ void tr_item(const float* W, int ldw, int colA, int colB, bf16_t* WT, int ldt, size_t row0, int k0, LAS float* scr, int lane, const float* kscale = nullptr) {
    const float* src = W + (size_t)k0 * ldw + (lane < 32 ? colA : colB) + (lane & 31);
#pragma unroll
    for (int hb = 0; hb < 2; ++hb) {
        float v[32];
#pragma unroll
        for (int i = 0; i < 32; ++i) v[i] = __builtin_nontemporal_load(src + (size_t)(hb * 32 + i) * ldw);
#pragma unroll
        for (int i = 0; i < 32; ++i) scr[(hb * 32 + i) * 65 + lane] = kscale ? v[i] * kscale[k0 + hb * 32 + i] : v[i];
    }
    LDS_WAIT();
    const int c = lane & 7;
#pragma unroll
    for (int j = 0; j < 8; ++j) { const int n = (lane >> 3) + 8 * j; const LAS float* s = scr + (8 * c) * 65 + n;
        u32x4 o; o.x = pk2(s[0 * 65], s[1 * 65]); o.y = pk2(s[2 * 65], s[3 * 65]); o.z = pk2(s[4 * 65], s[5 * 65]); o.w = pk2(s[6 * 65], s[7 * 65]);
        __builtin_nontemporal_store(o, (u32x4*)(WT + (row0 + n) * ldt + k0 + 8 * c)); }
    LDS_WAIT();
}
__device__ __forceinline__ int col_ev_main(int rg) { const int tile = rg >> 3, w = rg & 7;
    if (tile < 4) { const int base = (tile < 2 ? 0 : 512) + (tile & 1) * 256; return base + ((w & 3) >> 1) * 128 + (w >> 2) * 64 + (w & 1) * 32; }
    if (tile < 6) return 1536 + (tile - 4) * 256 + w * 32;
    if (tile < 8) return 2048 + (tile - 6) * 256 + w * 32;
    return 1024 + (tile - 8) * 256 + w * 32; }
__device__ __forceinline__ int col_od_main(int rg) { const int tile = rg >> 3, w = rg & 7;
    if (tile < 6) { const int base = (tile < 3 ? 0 : 768), g = tile % 3; return base + g * 256 + (w & 3) * 64 + (w >> 2) * 32; }
    if (tile < 8) return 2304 + (tile - 6) * 256 + w * 32;
    if (tile < 10) return 2816 + (tile - 8) * 256 + w * 32;
    if (tile < 12) return 3840 + (tile - 10) * 256 + w * 32;
    if (tile < 14) return 3328 + (tile - 12) * 256 + w * 32;
    return 1536 + (tile - 14) * 256 + w * 32; }

__device__ __forceinline__ void conv_small_weights(const Ctx& C) {
    LAS float* scr = (LAS float*)(C.lds + C.wave * TR_SCR);
    const int gw = C.bid * NWAVES + C.wave, NGW = C.G * NWAVES;
    constexpr int I0 = 0, I1 = 0, I2 = 16 * 16, I3 = 8 * 8, I4 = 0, I5 = 0, I6 = 16 * 12;
    constexpr int NI = I0 + I1 + I2 + I3 + I4 + I5 + I6;
    const float *p5 = INP(5), *p14 = INP(14), *p17 = INP(17);
    for (int it = gw; it < NI; it += NGW) {
        int r = it;
        if (r < I2) { const int rp = r >> 4, kb = r & 15; tr_item(p5, 1024, rp * 64, rp * 64 + 32, WSP(bf16_t, WS_WEVO), 1024, (size_t)rp * 64, kb * 64, scr, C.lane); continue; } r -= I2;
        if (r < I3) { const int rp = r >> 3, kb = r & 7; tr_item(p14, 512, rp * 64, rp * 64 + 32, WSP(bf16_t, WS_WGLU), 512, (size_t)rp * 64, kb * 64, scr, C.lane); continue; } r -= I3;
        { const int rp = r / 12, kb = r % 12; tr_item(p17, 1024, rp * 64, rp * 64 + 32, WSP(bf16_t, WS_WODO), 768, (size_t)rp * 64, kb * 64, scr, C.lane); }
    }
}
constexpr int CONV_BLK_ITEMS = 1536;
template <bool GK, int NCOL = 64>
__device__ __forceinline__ void wq_block_core(const Ctx& C, const float* src, size_t ldw, const float* gk, signed char* dst, float* sc, float scmul = 1.0f) {
    const int kb = C.tid / NCOL, cl = C.tid & (NCOL - 1);
    LAS float* red = (LAS float*)C.lds;
    float v[128]; float mx = 0.f;
#pragma unroll
    for (int bt = 0; bt < 4; ++bt) {
#pragma unroll
        for (int i = 0; i < 32; ++i) v[bt * 32 + i] = __builtin_nontemporal_load(src + (size_t)(bt * 32 + i) * ldw);
#pragma unroll
        for (int i = 0; i < 32; ++i) { if (GK) v[bt * 32 + i] *= gk[bt * 32 + i]; mx = fmaxf(mx, fabsf(v[bt * 32 + i])); }
    }
    __syncthreads();
    red[kb * NCOL + cl] = mx;
    __syncthreads();
    float cm = 0.f;
#pragma unroll
    for (int k = 0; k < 512 / NCOL; ++k) cm = fmaxf(cm, red[k * NCOL + cl]);
    const float inv = cm > 0.f ? 127.0f / cm : 0.f;
    if (kb == 0) *sc = cm * (1.0f / 127.0f) * scmul;
#pragma unroll
    for (int c = 0; c < 8; ++c) { u32x4 w;
#pragma unroll
        for (int d = 0; d < 4; ++d) { const int b0 = c * 16 + d * 4; w[d] = q4i8((f32x4){v[b0], v[b0 + 1], v[b0 + 2], v[b0 + 3]}, inv); }
        *(u32x4*)(dst + c * 16) = w; }
}
__device__ __forceinline__ void w13q_block_item(const Ctx& C, int layer, int it) {
    const int e = it >> 6, half = (it >> 5) & 1, cg = it & 31, col = cg * 64 + (C.tid & 63), kb = C.tid >> 6;
    const float* src = (half ? INP(22) : INP(21)) + (size_t)layer * NE * DM * FF + (size_t)e * DM * FF + (size_t)(kb * 128) * FF + col;
    const float* gk = INP(2) + layer * DM + kb * 128;
    const int nrow = (col >> 7) * 256 + half * 128 + (col & 127);
    wq_block_core<true>(C, src, FF, gk, (signed char*)(C.ws + WS_W13) + (size_t)layer * (64 * MiB) + ((size_t)e * 4096 + nrow) * 1024 + kb * 128,
                        WSP(float, WS_WSC) + (size_t)(layer * 16 + e) * 4096 + nrow, half ? 0.6931471805599453f : 1.4426950408889634f);
}
constexpr int WIN_BLK_ITEMS = 108;
__device__ __forceinline__ void winq_block_item(const Ctx& C, int it) {
    const bool od = it >= 40; const int rp = od ? it - 40 : it, cl = C.tid & 63, kb = C.tid >> 6;
    const int rg = 2 * rp + (cl >> 5), colg = od ? col_od_main(rg) : col_ev_main(rg); const size_t ldw = od ? 4368 : 2560;
    const float* src = (od ? INP(16) : INP(4)) + (size_t)(kb * 128) * ldw + colg + (cl & 31);
    const int row = rp * 64 + cl;
    wq_block_core<false>(C, src, ldw, nullptr, (signed char*)(C.ws + (od ? WS_WOD_MAIN : WS_WEV_MAIN)) + (size_t)row * 1024 + kb * 128, WSP(float, WS_WINSC) + (od ? 2560 : 0) + row);
}
__device__ __forceinline__ void w2q_block_item(const Ctx& C, int layer, int it) {
    const int e = it >> 5, cgp = it & 31, n = cgp * 32 + (C.tid & 31), kb = C.tid >> 5;
    const float* src = INP(23) + (size_t)layer * NE * FF * DM + (size_t)e * FF * DM + (size_t)(kb * 128) * DM + n;
    wq_block_core<false, 32>(C, src, DM, nullptr, (signed char*)(C.ws + WS_W2) + ((size_t)e * 1024 + n) * 2048 + kb * 128, WSP(float, WS_W2SC) + e * 1024 + n);
}
__device__ __forceinline__ void conv_moe_weights(const Ctx& C, int layer, int it_lo, int it_hi, int blk_lo) {
    if (C.bid < blk_lo) return;
    for (int it = it_lo + (C.bid - blk_lo); it < it_hi; it += C.G - blk_lo) {
        if (it < 1024) w13q_block_item(C, layer, it);
        else w2q_block_item(C, layer, it - 1024);
    }
    __syncthreads();
}
__device__ __forceinline__ void prep_tables(const Ctx& C) {
    const int gt = C.bid * NTHREADS + C.tid, NGT = C.G * NTHREADS;
    float *c128 = WSP(float, WS_COS128), *s128 = WSP(float, WS_SIN128), *c64 = WSP(float, WS_COS64), *s64 = WSP(float, WS_SIN64);
    for (int idx = gt; idx < SEQ * 64; idx += NGT) {
        const int pos = idx >> 6, i = idx & 63;
        double inv = 1.0; for (int k = 0; k < i; ++k) inv *= 0.8659643233600653;
        const float ang = (float)pos * (float)inv; float s, c; sincos_d((double)ang, s, c);
        c128[idx] = c; s128[idx] = s;
        if (i < 32) { double inv2 = 1.0; for (int k = 0; k < i; ++k) inv2 *= 0.7498942093324559;
            const float ang2 = (float)pos * (float)inv2; sincos_d((double)ang2, s, c); c64[pos * 32 + i] = c; s64[pos * 32 + i] = s; }
    }
    float* wrt = WSP(float, WS_WRT); float* wgt = WSP(float, WS_WGT);
    const float *p1 = INP(1), *p2 = INP(2), *p16 = INP(16), *p20 = INP(20), *p6 = INP(6), *p7 = INP(7), *p8 = INP(8), *p9 = INP(9), *p12 = INP(12);
    for (int idx = gt; idx < 2 * 16 * 1024; idx += NGT) { const int l = idx >> 14, e = (idx >> 10) & 15, k = idx & 1023; wrt[idx] = p2[l * 1024 + k] * p20[(size_t)l * 1024 * 16 + k * 16 + e]; }
    for (int idx = gt; idx < 16 * 1024; idx += NGT) { const int c = idx >> 10, k = idx & 1023; wgt[idx] = p1[1024 + k] * p16[(size_t)k * 4368 + 4352 + c]; }
    float* lam = WSP(float, WS_S5LAM); float* bbar = WSP(float, WS_S5BBAR);
    for (int idx = gt; idx < 2 * 32 * 64; idx += NGT) {
        const int dg = idx >> 6;
        const float are = p6[idx], aim = p7[idx], step = __expf(p12[dg]);
        const float xr = are * step; const double th = (double)aim * (double)step;
        float s, c, sh, ch; sincos_d(th, s, c); sincos_d(0.5 * th, sh, ch);
        const float em1 = expm1f(xr), mag = em1 + 1.0f;
        const float nr = em1 * c - 2.0f * sh * sh, ni = mag * s;
        const float den = are * are + aim * aim;
        const float fr = (nr * are + ni * aim) / den, fi = (ni * are - nr * aim) / den;
        lam[idx * 2] = xr; lam[idx * 2 + 1] = (float)th;
        for (int ci = 0; ci < 16; ++ci) { const float br = p8[idx * 16 + ci], bi = p9[idx * 16 + ci];
            bbar[(idx * 16 + ci) * 2] = fr * br - fi * bi; bbar[(idx * 16 + ci) * 2 + 1] = fr * bi + fi * br; }
    }
}
__device__ __forceinline__ void apow(const float* lam, int idx, int m, float& re, float& im) {
    const float xr = lam[idx * 2], th = lam[idx * 2 + 1]; float s, c; sincos_d((double)m * (double)th, s, c);
    const float mag = __expf((float)m * xr); re = mag * c; im = mag * s;
}
__device__ __forceinline__ void rmsnorm_rows(const Ctx& C, const float* x, const float* g, unsigned* hq, float* hsc) {
    const int gw = C.bid * NWAVES + C.wave, NGW = C.G * NWAVES;
    f32x4 gv[4];
#pragma unroll
    for (int j = 0; j < 4; ++j) gv[j] = *(const f32x4*)(g + j * 256 + C.lane * 4);
    for (int r = gw; r < T; r += 2 * NGW) {
        const int r2 = (r + NGW < T) ? r + NGW : r; f32x4 v[4], u[4]; float s = 0.f, s2 = 0.f, m = 0.f, m2 = 0.f;
#pragma unroll
        for (int j = 0; j < 4; ++j) { v[j] = __builtin_nontemporal_load((const f32x4*)(x + (size_t)r * DM + j * 256 + C.lane * 4)); u[j] = __builtin_nontemporal_load((const f32x4*)(x + (size_t)r2 * DM + j * 256 + C.lane * 4)); }
#pragma unroll
        for (int j = 0; j < 4; ++j) { s += v[j][0] * v[j][0] + v[j][1] * v[j][1] + v[j][2] * v[j][2] + v[j][3] * v[j][3]; s2 += u[j][0] * u[j][0] + u[j][1] * u[j][1] + u[j][2] * u[j][2] + u[j][3] * u[j][3];
            v[j] *= gv[j]; u[j] *= gv[j]; m = fmaxf(m, amax4(v[j])); m2 = fmaxf(m2, amax4(u[j])); }
        const float rstd = rsqrtf(wave_sum(s) * (1.0f / DM) + 1e-6f), rstd2 = rsqrtf(wave_sum(s2) * (1.0f / DM) + 1e-6f);
        m = wave_max(m); m2 = wave_max(m2);
        const float inv = m > 0.f ? 127.0f / m : 0.f, inv2 = m2 > 0.f ? 127.0f / m2 : 0.f;
#pragma unroll
        for (int j = 0; j < 4; ++j) { hq[(size_t)r * 256 + j * 64 + C.lane] = q4i8(v[j], inv); hq[(size_t)r2 * 256 + j * 64 + C.lane] = q4i8(u[j], inv2); }
        if (C.lane == 0) { hsc[r] = m * rstd * (1.0f / 127.0f); hsc[r2] = m2 * rstd2 * (1.0f / 127.0f); }
    }
}
constexpr int SC = 32, SCL = 5, SK = SC * 16, SLD = SK + 256, NCH = SEQ / SC, SROWS = 2 * NCH;
__device__ __forceinline__ void s5_ktab(const Ctx& C) {
    LAS float* W = (LAS float*)C.lds;
    const float* lam = WSP(float, WS_S5LAM); const float* bbar = WSP(float, WS_S5BBAR); float* kt = WSP(float, WS_S5KTAB);
    const float *p10 = INP(10), *p11 = INP(11);
    for (int it = C.bid; it < 2 * 32 * SC; it += C.G) {
        const int dg = it >> SCL, d = it & (SC - 1), dir = dg >> 5, g = dg & 31;
        __syncthreads();
        if (C.tid < 64) { float re, im; apow(lam, dg * 64 + C.tid, d, re, im); W[C.tid * 2] = re; W[C.tid * 2 + 1] = im; }
        __syncthreads();
        if (C.tid < 256) { const int co = C.tid >> 4, ci = C.tid & 15; float acc = 0.f;
            const float* cr = p10 + (size_t)(dg * 16 + co) * 64; const float* cim = p11 + (size_t)(dg * 16 + co) * 64;
            for (int p = 0; p < 64; ++p) { const float wr = W[p * 2], wi = W[p * 2 + 1]; const float br = bbar[((dg * 64 + p) * 16 + ci) * 2], bi = bbar[((dg * 64 + p) * 16 + ci) * 2 + 1];
                const float xr = wr * br - wi * bi, xi = wr * bi + wi * br; acc += cr[p] * xr - cim[p] * xi; }
            kt[((size_t)(g * 2 + dir) * SC + d) * 256 + C.tid] = acc; }
    }
}
__device__ __forceinline__ void s5_gmat(const Ctx& C) {
    const int gt = C.bid * NTHREADS + C.tid, NGT = C.G * NTHREADS;
    const float* lam = WSP(float, WS_S5LAM); const float* bbar = WSP(float, WS_S5BBAR); bf16_t* gm = WSP(bf16_t, BG_GM);
    for (int idx = gt; idx < 32 * 2 * 64 * SC; idx += NGT) {
        const int j = idx & (SC - 1), p = (idx >> SCL) & 63, dir = (idx >> (SCL + 6)) & 1, g = idx >> (SCL + 7), dgp = (dir * 32 + g) * 64 + p;
        float wr, wi; apow(lam, dgp, dir == 0 ? SC - 1 - j : j, wr, wi);
        float xr[16], xi[16];
#pragma unroll
        for (int ci = 0; ci < 16; ++ci) { const float br = bbar[(dgp * 16 + ci) * 2], bi = bbar[(dgp * 16 + ci) * 2 + 1]; xr[ci] = wr * br - wi * bi; xi[ci] = wr * bi + wi * br; }
        bf16_t* r0 = gm + ((size_t)(g * 256 + dir * 128 + p)) * SK + j * 16; bf16_t* r1 = r0 + (size_t)64 * SK;
        st_bf16x8(r0, (f32x4){xr[0], xr[1], xr[2], xr[3]}, (f32x4){xr[4], xr[5], xr[6], xr[7]}); st_bf16x8(r0 + 8, (f32x4){xr[8], xr[9], xr[10], xr[11]}, (f32x4){xr[12], xr[13], xr[14], xr[15]});
        st_bf16x8(r1, (f32x4){xi[0], xi[1], xi[2], xi[3]}, (f32x4){xi[4], xi[5], xi[6], xi[7]}); st_bf16x8(r1 + 8, (f32x4){xi[8], xi[9], xi[10], xi[11]}, (f32x4){xi[12], xi[13], xi[14], xi[15]});
    }
}
__device__ __forceinline__ void s5_b2mat(const Ctx& C) {
    const int gt = C.bid * NTHREADS + C.tid, NGT = C.G * NTHREADS;
    const float* lam = WSP(float, WS_S5LAM); const float* kt = WSP(float, WS_S5KTAB); bf16_t* b2 = WSP(bf16_t, BG_B2);
    const float *p10 = INP(10), *p11 = INP(11);
    for (int idx = gt; idx < 32 * SC * 16 * 2 * 8; idx += NGT) {
        const int pc = idx & 7, dir = (idx >> 3) & 1, co = (idx >> 4) & 15, i = (idx >> 8) & (SC - 1), g = idx >> (8 + SCL), dg = dir * 32 + g;
        const float* cr = p10 + (size_t)(dg * 16 + co) * 64 + pc * 8; const float* cim = p11 + (size_t)(dg * 16 + co) * 64 + pc * 8;
        float hr[8], hi[8];
#pragma unroll
        for (int k = 0; k < 8; ++k) { float wr, wi; apow(lam, dg * 64 + pc * 8 + k, dir == 0 ? i + 1 : SC - i, wr, wi); hr[k] = cr[k] * wr - cim[k] * wi; hi[k] = -(cr[k] * wi + cim[k] * wr); }
        bf16_t* row = b2 + ((size_t)(g * SK + i * 16 + co)) * SLD + SK + dir * 128 + pc * 8;
        st_bf16x8(row, (f32x4){hr[0], hr[1], hr[2], hr[3]}, (f32x4){hr[4], hr[5], hr[6], hr[7]});
        st_bf16x8(row + 64, (f32x4){hi[0], hi[1], hi[2], hi[3]}, (f32x4){hi[4], hi[5], hi[6], hi[7]});
    }
    for (int idx = gt; idx < 32 * SC * 16 * SC; idx += NGT) {
        const int j = idx & (SC - 1), co = (idx >> SCL) & 15, i = (idx >> (SCL + 4)) & (SC - 1), g = idx >> (2 * SCL + 4);
        f32x4 v[4];
        if (j < i) { const float* s = kt + ((size_t)(g * 2 + 0) * SC + (i - j)) * 256 + co * 16;
#pragma unroll
            for (int k = 0; k < 4; ++k) v[k] = *(const f32x4*)(s + 4 * k);
        } else if (j > i) { const float* s = kt + ((size_t)(g * 2 + 1) * SC + (j - i)) * 256 + co * 16;
#pragma unroll
            for (int k = 0; k < 4; ++k) v[k] = *(const f32x4*)(s + 4 * k);
        } else { const float* s0 = kt + ((size_t)(g * 2 + 0) * SC) * 256 + co * 16; const float* s1 = kt + ((size_t)(g * 2 + 1) * SC) * 256 + co * 16;
#pragma unroll
            for (int k = 0; k < 4; ++k) v[k] = *(const f32x4*)(s0 + 4 * k) + *(const f32x4*)(s1 + 4 * k);
        }
        bf16_t* row = b2 + ((size_t)(g * SK + i * 16 + co)) * SLD + j * 16;
        st_bf16x8(row, v[0], v[1]); st_bf16x8(row + 8, v[2], v[3]);
    }
}
__device__ __forceinline__ void s5_scan(const Ctx& C) {
    const int gt = C.bid * NTHREADS + C.tid;
    if (gt >= 2 * 32 * 2 * 64) return;
    const int p = gt & 63, dir = (gt >> 6) & 1, g = (gt >> 7) & 31, b = gt >> 12;
    const float* lam = WSP(float, WS_S5LAM); const float* xraw = WSP(float, BG_XRAW); bf16_t* a2 = WSP(bf16_t, BG_A2);
    float ar, ai; apow(lam, (dir * 32 + g) * 64 + p, SC, ar, ai);
    float sr = 0.f, si = 0.f;
    const size_t rowbase = (size_t)g * SROWS + b * NCH; const int q = dir * 128 + p;
    for (int n0 = 0; n0 < NCH; n0 += 64) {
        float xr[64], xi[64];
#pragma unroll
        for (int k = 0; k < 64; ++k) { const int n = dir == 0 ? n0 + k : NCH - 1 - n0 - k; xr[k] = xraw[(rowbase + n) * 256 + q]; xi[k] = xraw[(rowbase + n) * 256 + q + 64]; }
#pragma unroll
        for (int k = 0; k < 64; ++k) { const int n = dir == 0 ? n0 + k : NCH - 1 - n0 - k;
            a2[(rowbase + n) * SLD + SK + q] = f2bf(sr); a2[(rowbase + n) * SLD + SK + q + 64] = f2bf(si);
            const float nr = ar * sr - ai * si + xr[k], ni = ar * si + ai * sr + xi[k]; sr = nr; si = ni; }
    }
}

constexpr int TS = 136;
constexpr int TILE_B = 128 * TS * 2;
constexpr int VEC_OFF = 3 * TILE_B;
__device__ __forceinline__ void load_tile(LAS bf16_t* dst, const bf16_t* src, size_t ld, int tid) {
#pragma unroll
    for (int jj = 0; jj < 4; ++jj) { const int p = tid + 512 * jj, row = p >> 4, c16 = p & 15; *(LAS u32x4*)(dst + row * TS + c16 * 8) = *(const u32x4*)(src + (size_t)row * ld + c16 * 8); }
}
__device__ __forceinline__ void load_tile_colscale(LAS bf16_t* dst, const bf16_t* src, size_t ld, const LAS float* w, int tid) {
#pragma unroll
    for (int jj = 0; jj < 4; ++jj) { const int p = tid + 512 * jj, row = p >> 4, c16 = p & 15; const u32x4 v = *(const u32x4*)(src + (size_t)row * ld + c16 * 8);
        const f32x4 w0 = *(const LAS f32x4*)(w + c16 * 8), w1 = *(const LAS f32x4*)(w + c16 * 8 + 4);
        u32x4 o; o.x = pk2(lo_bf(v.x) * w0[0], hi_bf(v.x) * w0[1]); o.y = pk2(lo_bf(v.y) * w0[2], hi_bf(v.y) * w0[3]); o.z = pk2(lo_bf(v.z) * w1[0], hi_bf(v.z) * w1[1]); o.w = pk2(lo_bf(v.w) * w1[2], hi_bf(v.w) * w1[3]);
        *(LAS u32x4*)(dst + row * TS + c16 * 8) = o; }
}
__device__ __forceinline__ void mma_nt(f32x4 (&acc)[2][4], const LAS bf16_t* A, const LAS bf16_t* B, int wr, int wc, int lane) {
    const int fr = lane & 15, fq = lane >> 4;
#pragma unroll
    for (int ks = 0; ks < 4; ++ks) {
        bf16x8 a[2], b[4];
#pragma unroll
        for (int mi = 0; mi < 2; ++mi) a[mi] = *(const LAS bf16x8*)(A + (32 * wr + 16 * mi + fr) * TS + ks * 32 + fq * 8);
#pragma unroll
        for (int ni = 0; ni < 4; ++ni) b[ni] = *(const LAS bf16x8*)(B + (64 * wc + 16 * ni + fr) * TS + ks * 32 + fq * 8);
#pragma unroll
        for (int mi = 0; mi < 2; ++mi)
#pragma unroll
            for (int ni = 0; ni < 4; ++ni) acc[mi][ni] = __builtin_amdgcn_mfma_f32_16x16x32_bf16(b[ni], a[mi], acc[mi][ni], 0, 0, 0);
    }
}
__device__ __forceinline__ void zero_acc(f32x4 (&acc)[2][4]) {
#pragma unroll
    for (int mi = 0; mi < 2; ++mi)
#pragma unroll
        for (int ni = 0; ni < 4; ++ni) acc[mi][ni] = (f32x4){0.f, 0.f, 0.f, 0.f};
}

struct MixA { const bf16_t *Q, *K, *KT, *VT; bf16_t *O1, *O2, *KV; };
constexpr int VEC_OFF4 = 4 * TILE_B;
template <bool ML>
__device__ __forceinline__ void chunk_phaseA(const Ctx& C, const MixA& M) {
    LAS bf16_t* buf0 = (LAS bf16_t*)C.lds; LAS bf16_t* buf1 = (LAS bf16_t*)(C.lds + TILE_B); LAS bf16_t* buf2 = (LAS bf16_t*)(C.lds + 2 * TILE_B);
    LAS float* vec = (LAS float*)(C.lds + VEC_OFF);
    LAS float *bc = vec, *cf = vec + 128, *rc = vec + 256, *cb = vec + 384, *wf = vec + 512, *wb = vec + 640, *denp = vec + 768  , *wtot = vec + 1280  ;
    const int wr = C.wave >> 1, wc = C.wave & 1, fr = C.lane & 15, fq = C.lane >> 4;
    const int prow = C.tid >> 4, pc = (C.tid & 15) * 8;
    const float* mlg = WSP(float, WS_MLG);
    u32x4 rq[4], rk[4]; float pg0 = 0.f, pg1 = 0.f, pg2 = 0.f, pg3 = 0.f;
#define CHA_ISSUE(it_) do { const int b_ = (it_) >> 9, h_ = ((it_) >> 7) & 3, n_ = (it_) & 127; const size_t t0_ = (size_t)b_ * SEQ + n_ * 128; \
        _Pragma("unroll") for (int jj = 0; jj < 4; ++jj) { const int row = prow + 32 * jj; \
            rq[jj] = *(const u32x4*)(M.Q + (t0_ + row) * 512 + h_ * 128 + pc); rk[jj] = *(const u32x4*)(M.K + (t0_ + row) * 512 + h_ * 128 + pc); } \
        if (ML && C.tid < 128) { const size_t gi_ = (size_t)(b_ * 4 + h_) * SEQ + n_ * 128 + C.tid; pg0 = mlg[gi_]; pg1 = mlg[8 * SEQ + gi_]; pg2 = mlg[16 * SEQ + gi_]; pg3 = mlg[24 * SEQ + gi_]; } } while (0)
    constexpr int NIT = 1024 * REP_CHA;
    if (C.bid < NIT) CHA_ISSUE(C.bid & 1023);
    for (int item_ = C.bid; item_ < NIT; item_ += C.G) { const int item = item_ & 1023;
        const int b = item >> 9, h = (item >> 7) & 3, n = item & 127; const size_t t0 = (size_t)b * SEQ + n * 128;
        const size_t gi = (size_t)(b * 4 + h) * SEQ + n * 128 + (C.tid & 127);
        const float l2g = log2f(1.0f - exp2f(-5.0f - (float)h));
#pragma unroll
        for (int jj = 0; jj < 4; ++jj) { const int o = (prow + 32 * jj) * TS + pc; *(LAS u32x4*)(buf0 + o) = rq[jj]; *(LAS u32x4*)(buf1 + o) = rk[jj]; }
        float igf = pg0, igb = pg1, lfb = pg3, sf = pg2, sb = pg3;
        u32x4 rv[4];
#pragma unroll
        for (int jj = 0; jj < 4; ++jj) rv[jj] = *(const u32x4*)(M.VT + (size_t)(h * 128 + prow + 32 * jj) * T + t0 + pc);
        if (item_ + C.G < NIT) CHA_ISSUE((item_ + C.G) & 1023);
        if (ML && C.tid < 128) {
#pragma unroll
            for (int o = 1; o < 64; o <<= 1) { const float uf = __shfl_up(sf, o), ub = __shfl_up(sb, o); if (C.lane >= o) { sf += uf; sb += ub; } }
            if (C.lane == 63) { wtot[C.wave * 2] = sf; wtot[C.wave * 2 + 1] = sb; }
        }
        __syncthreads();
        if (C.tid < 128) {
            if (ML) {
                const float totf = wtot[0] + wtot[2], totb = wtot[1] + wtot[3];
                if (C.wave == 1) { sf += wtot[0]; sb += wtot[1]; }
                const float bcum = sf, rcum = totb - (sb - lfb);
                bc[C.tid] = bcum; cf[C.tid] = igf - bcum; rc[C.tid] = rcum; cb[C.tid] = igb - rcum;
                wf[C.tid] = __expf(totf + igf - bcum); wb[C.tid] = __expf(totb - rcum + igb);
                float* mlef = WSP(float, WS_MLEF); mlef[gi] = __expf(bcum); mlef[8 * SEQ + gi] = __expf(rcum);
                if (C.tid == 0) { float* mla = WSP(float, WS_MLA); mla[item * 2] = __expf(totf); mla[item * 2 + 1] = __expf(totb); }
            } else { wf[C.tid] = exp2f((float)(127 - C.tid) * l2g); wb[C.tid] = exp2f((float)C.tid * l2g); }
        }
        __syncthreads();
        f32x4 S[2][4]; zero_acc(S);
        mma_nt(S, buf0, buf1, wr, wc, C.lane);
        if (ML && C.tid < 256) {
            const int dir = C.tid >> 7, d = C.tid & 127; const LAS float* w = dir ? wb : wf; float a = 0.f;
#pragma unroll 8
            for (int j = 0; j < 128; ++j) a += w[j] * bf2f(buf1[j * TS + d]);
            WSP(float, WS_MLN)[(size_t)(item * 2 + dir) * 128 + d] = a;
        }
#pragma unroll
        for (int jj = 0; jj < 4; ++jj) *(LAS u32x4*)(buf2 + (prow + 32 * jj) * TS + pc) = rv[jj];
        __syncthreads();
        int frm = fr, fqm = fq; asm volatile("" : "+v"(frm), "+v"(fqm));
#pragma unroll
        for (int mi = 0; mi < 2; ++mi) {
            const int i = 32 * wr + 16 * mi + frm; float dsf = 0.f, dsb = 0.f;
            const float bci = ML ? bc[i] : 0.f, rci = ML ? rc[i] : 0.f;
#pragma unroll
            for (int ni = 0; ni < 4; ++ni) {
                const int j0 = 64 * wc + 16 * ni + 4 * fqm;
                if (ML) {
                    f32x4 pf, pb;
#pragma unroll
                    for (int r = 0; r < 4; ++r) { const int j = j0 + r;
                        pf[r] = (j <= i) ? S[mi][ni][r] * __expf(bci + cf[j]) : 0.f; pb[r] = (j >= i) ? S[mi][ni][r] * __expf(rci + cb[j]) : 0.f;
                        dsf += pf[r]; dsb += pb[r]; }
                    u32x2 w; w.x = pk2(pf[0], pf[1]); w.y = pk2(pf[2], pf[3]); *(LAS u32x2*)(buf0 + i * TS + j0) = w;
                    w.x = pk2(pb[0], pb[1]); w.y = pk2(pb[2], pb[3]); *(LAS u32x2*)(buf1 + i * TS + j0) = w;
                } else {
                    f32x4 pv;
#pragma unroll
                    for (int r = 0; r < 4; ++r) { const int j = j0 + r, dd = i > j ? i - j : j - i; pv[r] = S[mi][ni][r] * exp2f((float)dd * l2g); }
                    u32x2 w; w.x = pk2(pv[0], pv[1]); w.y = pk2(pv[2], pv[3]); *(LAS u32x2*)(buf0 + i * TS + j0) = w;
                }
            }
            if (ML) { dsf += __shfl_xor(dsf, 16); dsf += __shfl_xor(dsf, 32); dsb += __shfl_xor(dsb, 16); dsb += __shfl_xor(dsb, 32);
                if (fqm == 0) { denp[(0 * 2 + wc) * 128 + i] = dsf; denp[(1 * 2 + wc) * 128 + i] = dsb; } }
        }
        __syncthreads();
        if (ML && C.tid < 256) { const int dir = C.tid >> 7, i = C.tid & 127;
            WSP(float, WS_MLDEN)[(size_t)dir * 8 * SEQ + (size_t)(b * 4 + h) * SEQ + n * 128 + i] = denp[(dir * 2 + 0) * 128 + i] + denp[(dir * 2 + 1) * 128 + i]; }
        u32x4 rt[4];
#pragma unroll
        for (int jj = 0; jj < 4; ++jj) rt[jj] = *(const u32x4*)(M.KT + (size_t)(h * 128 + prow + 32 * jj) * T + t0 + pc);
        {
            f32x4 O[2][4]; zero_acc(O); mma_nt(O, buf0, buf2, wr, wc, C.lane);
#pragma unroll
            for (int mi = 0; mi < 2; ++mi)
#pragma unroll
                for (int ni = 0; ni < 4; ++ni) st4bf(M.O1 + (t0 + 32 * wr + 16 * mi + fr) * 512 + h * 128 + 64 * wc + 16 * ni + 4 * fq, O[mi][ni]);
            if (ML) { zero_acc(O); mma_nt(O, buf1, buf2, wr, wc, C.lane);
#pragma unroll
                for (int mi = 0; mi < 2; ++mi)
#pragma unroll
                    for (int ni = 0; ni < 4; ++ni) st4bf(M.O2 + (t0 + 32 * wr + 16 * mi + fr) * 512 + h * 128 + 64 * wc + 16 * ni + 4 * fq, O[mi][ni]); }
        }
        __syncthreads();
#pragma unroll
        for (int jj = 0; jj < 4; ++jj) { const int o = (prow + 32 * jj) * TS + pc; const u32x4 v = rt[jj];
            const f32x4 a0 = *(const LAS f32x4*)(wf + pc), a1 = *(const LAS f32x4*)(wf + pc + 4), c0 = *(const LAS f32x4*)(wb + pc), c1 = *(const LAS f32x4*)(wb + pc + 4);
            u32x4 x; x.x = pk2(lo_bf(v.x) * a0[0], hi_bf(v.x) * a0[1]); x.y = pk2(lo_bf(v.y) * a0[2], hi_bf(v.y) * a0[3]); x.z = pk2(lo_bf(v.z) * a1[0], hi_bf(v.z) * a1[1]); x.w = pk2(lo_bf(v.w) * a1[2], hi_bf(v.w) * a1[3]);
            *(LAS u32x4*)(buf0 + o) = x;
            x.x = pk2(lo_bf(v.x) * c0[0], hi_bf(v.x) * c0[1]); x.y = pk2(lo_bf(v.y) * c0[2], hi_bf(v.y) * c0[3]); x.z = pk2(lo_bf(v.z) * c1[0], hi_bf(v.z) * c1[1]); x.w = pk2(lo_bf(v.w) * c1[2], hi_bf(v.w) * c1[3]);
            *(LAS u32x4*)(buf1 + o) = x; }
        __syncthreads();
        {
            f32x4 A[2][4]; zero_acc(A); mma_nt(A, buf2, buf0, wr, wc, C.lane);
            bf16_t* kv = M.KV + (size_t)item * 2 * 16384;
#pragma unroll
            for (int mi = 0; mi < 2; ++mi)
#pragma unroll
                for (int ni = 0; ni < 4; ++ni) st4bf(kv + (32 * wr + 16 * mi + fr) * 128 + 64 * wc + 16 * ni + 4 * fq, A[mi][ni]);
            zero_acc(A); mma_nt(A, buf2, buf1, wr, wc, C.lane);
#pragma unroll
            for (int mi = 0; mi < 2; ++mi)
#pragma unroll
                for (int ni = 0; ni < 4; ++ni) st4bf(kv + 16384 + (32 * wr + 16 * mi + fr) * 128 + 64 * wc + 16 * ni + 4 * fq, A[mi][ni]);
        }
        __syncthreads();
    }
#undef CHA_ISSUE
}
template <bool ML>
__device__ __forceinline__ void chunk_scan(const Ctx& C, bf16_t* KV) {
    const int gt = C.bid * NTHREADS + C.tid, NGT = C.G * NTHREADS;
    const float* mla = WSP(float, WS_MLA);
    for (int idx = gt; idx < 8 * 2 * 8192; idx += NGT) {
        const int e2 = idx & 8191, dir = (idx >> 13) & 1, bh = idx >> 14;
        const float aconst = exp2f(128.0f * log2f(1.0f - exp2f(-5.0f - (float)(bh & 3))));
        float s0 = 0.f, s1 = 0.f;
        for (int n0 = 0; n0 < 128; n0 += 32) {
            unsigned raw[32]; float a[32];
#pragma unroll
            for (int k = 0; k < 32; ++k) { const int n = dir == 0 ? n0 + k : 127 - n0 - k; const int item = bh * 128 + n;
                raw[k] = *(const unsigned*)(KV + ((size_t)item * 2 + dir) * 16384 + e2 * 2); a[k] = ML ? mla[item * 2 + dir] : aconst; }
#pragma unroll
            for (int k = 0; k < 32; ++k) { const int n = dir == 0 ? n0 + k : 127 - n0 - k; const int item = bh * 128 + n;
                *(unsigned*)(KV + ((size_t)item * 2 + dir) * 16384 + e2 * 2) = pk2(s0, s1);
                s0 = a[k] * s0 + lo_bf(raw[k]); s1 = a[k] * s1 + hi_bf(raw[k]); }
        }
    }
    if (ML) {
        float* mln = WSP(float, WS_MLN);
        for (int idx = gt; idx < 8 * 2 * 128; idx += NGT) {
            const int d = idx & 127, dir = (idx >> 7) & 1, bh = idx >> 8; float s = 0.f;
            for (int k0 = 0; k0 < 128; k0 += 32) { float raw[32], a[32];
#pragma unroll
                for (int k = 0; k < 32; ++k) { const int n = dir == 0 ? k0 + k : 127 - k0 - k; const int item = bh * 128 + n; raw[k] = mln[(size_t)(item * 2 + dir) * 128 + d]; a[k] = mla[item * 2 + dir]; }
#pragma unroll
                for (int k = 0; k < 32; ++k) { const int n = dir == 0 ? k0 + k : 127 - k0 - k; const int item = bh * 128 + n; mln[(size_t)(item * 2 + dir) * 128 + d] = s; s = a[k] * s + raw[k]; } }
        }
    }
}
struct MixC { const bf16_t *Q, *KV, *O1, *O2, *GS; bf16_t* dst; int ldd, col0; };
template <bool ML>
__device__ __forceinline__ void chunk_phaseC(const Ctx& C, const MixC& M) {
    LAS bf16_t* buf0 = (LAS bf16_t*)C.lds; LAS bf16_t* buf1 = (LAS bf16_t*)(C.lds + TILE_B); LAS bf16_t* buf2 = (LAS bf16_t*)(C.lds + 2 * TILE_B);
    LAS float* vec = (LAS float*)(C.lds + VEC_OFF);
    LAS float *nf = vec, *nb = vec + 128, *qn = vec + 256  , *st = vec + 512  , *st2 = vec + 768  ;
    const int wr = C.wave >> 1, wc = C.wave & 1, fr = C.lane & 15, fq = C.lane >> 4;
    const int prow = C.tid >> 4, pc = (C.tid & 15) * 8;
    const float* mln = WSP(float, WS_MLN); const float* mlef = WSP(float, WS_MLEF); const float* mlden = WSP(float, WS_MLDEN);
    u32x4 rq[4], rf[4]; float pn = 0.f;
#define CHC_ISSUE(it_) do { const int b_ = (it_) >> 9, h_ = ((it_) >> 7) & 3, n_ = (it_) & 127; const size_t t0_ = (size_t)b_ * SEQ + n_ * 128; const bf16_t* kv_ = M.KV + (size_t)(it_) * 2 * 16384; \
        _Pragma("unroll") for (int jj = 0; jj < 4; ++jj) { const int row = prow + 32 * jj; \
            rq[jj] = *(const u32x4*)(M.Q + (t0_ + row) * 512 + h_ * 128 + pc); rf[jj] = *(const u32x4*)(kv_ + row * 128 + pc); } \
        if (ML && C.tid < 256) pn = mln[(size_t)((it_) * 2 + (C.tid >> 7)) * 128 + (C.tid & 127)]; } while (0)
    constexpr int NIT = 1024 * REP_CHC;
    if (C.bid < NIT) CHC_ISSUE(C.bid & 1023);
    for (int item_ = C.bid; item_ < NIT; item_ += C.G) { const int item = item_ & 1023;
        const int b = item >> 9, h = (item >> 7) & 3, n = item & 127; const size_t t0 = (size_t)b * SEQ + n * 128;
        const float l2g = log2f(1.0f - exp2f(-5.0f - (float)h));
#pragma unroll
        for (int jj = 0; jj < 4; ++jj) { const int o = (prow + 32 * jj) * TS + pc; *(LAS u32x4*)(buf0 + o) = rq[jj]; *(LAS u32x4*)(buf1 + o) = rf[jj]; }
        if (ML && C.tid < 256) ((C.tid >> 7) ? nb : nf)[C.tid & 127] = pn;
        u32x4 rb[4];
#pragma unroll
        for (int jj = 0; jj < 4; ++jj) rb[jj] = *(const u32x4*)(M.KV + (size_t)item * 2 * 16384 + 16384 + (prow + 32 * jj) * 128 + pc);
        u32x2 e1[2][4], e2[2][4]; float cfw[2], cbw[2], dfi[2], dbi[2];
#pragma unroll
        for (int mi = 0; mi < 2; ++mi) { const int i = 32 * wr + 16 * mi + fr; const size_t t = t0 + i;
#pragma unroll
            for (int ni = 0; ni < 4; ++ni) { const size_t off = t * 512 + h * 128 + 64 * wc + 16 * ni + 4 * fq;
                e1[mi][ni] = *(const u32x2*)(M.O1 + off); if (ML) e2[mi][ni] = *(const u32x2*)(M.O2 + off); }
            if (ML) { const size_t gi = (size_t)(b * 4 + h) * SEQ + n * 128 + i; cfw[mi] = mlef[gi]; cbw[mi] = mlef[8 * SEQ + gi]; dfi[mi] = mlden[gi]; dbi[mi] = mlden[8 * SEQ + gi]; }
            else { cfw[mi] = exp2f((float)(i + 1) * l2g); cbw[mi] = exp2f((float)(128 - i) * l2g); dfi[mi] = 0.f; dbi[mi] = 0.f; } }
        if (item_ + C.G < NIT) CHC_ISSUE((item_ + C.G) & 1023);
        __syncthreads();
        if (ML) { const int i = C.tid >> 2, part = C.tid & 3; float a0 = 0.f, a1 = 0.f;
#pragma unroll 1
            for (int c = 0; c < 4; ++c) { const int d0 = part * 32 + c * 8; const u32x4 qw = *(const LAS u32x4*)(buf0 + i * TS + d0);
                const f32x4 f0 = *(const LAS f32x4*)(nf + d0), f1 = *(const LAS f32x4*)(nf + d0 + 4), g0 = *(const LAS f32x4*)(nb + d0), g1 = *(const LAS f32x4*)(nb + d0 + 4);
                const float q0 = lo_bf(qw.x), q1 = hi_bf(qw.x), q2 = lo_bf(qw.y), q3 = hi_bf(qw.y), q4 = lo_bf(qw.z), q5 = hi_bf(qw.z), q6 = lo_bf(qw.w), q7 = hi_bf(qw.w);
                a0 += q0 * f0[0] + q1 * f0[1] + q2 * f0[2] + q3 * f0[3] + q4 * f1[0] + q5 * f1[1] + q6 * f1[2] + q7 * f1[3];
                a1 += q0 * g0[0] + q1 * g0[1] + q2 * g0[2] + q3 * g0[3] + q4 * g1[0] + q5 * g1[1] + q6 * g1[2] + q7 * g1[3]; }
            a0 += __shfl_xor(a0, 1); a0 += __shfl_xor(a0, 2); a1 += __shfl_xor(a1, 1); a1 += __shfl_xor(a1, 2);
            if (part == 0) { qn[i] = a0; qn[128 + i] = a1; } }
        __builtin_amdgcn_sched_barrier(0);
        f32x4 Xf[2][4], Xb[2][4]; zero_acc(Xf); zero_acc(Xb);
        mma_nt(Xf, buf0, buf1, wr, wc, C.lane);
        __builtin_amdgcn_sched_barrier(0);
#pragma unroll
        for (int jj = 0; jj < 4; ++jj) *(LAS u32x4*)(buf2 + (prow + 32 * jj) * TS + pc) = rb[jj];
        __syncthreads();
        mma_nt(Xb, buf0, buf2, wr, wc, C.lane);
        __builtin_amdgcn_sched_barrier(0);
#pragma unroll
        for (int mi = 0; mi < 2; ++mi)
#pragma unroll
            for (int ni = 0; ni < 4; ++ni) { const f32x4 o1 = (f32x4){lo_bf(e1[mi][ni].x), hi_bf(e1[mi][ni].x), lo_bf(e1[mi][ni].y), hi_bf(e1[mi][ni].y)};
                if (ML) { const f32x4 o2 = (f32x4){lo_bf(e2[mi][ni].x), hi_bf(e2[mi][ni].x), lo_bf(e2[mi][ni].y), hi_bf(e2[mi][ni].y)}; Xf[mi][ni] = o1 + cfw[mi] * Xf[mi][ni]; Xb[mi][ni] = o2 + cbw[mi] * Xb[mi][ni]; }
                else Xf[mi][ni] = o1 + cfw[mi] * Xf[mi][ni] + cbw[mi] * Xb[mi][ni]; }
        u32x2 eg[2][4];
#pragma unroll
        for (int mi = 0; mi < 2; ++mi)
#pragma unroll
            for (int ni = 0; ni < 4; ++ni) eg[mi][ni] = *(const u32x2*)(M.GS + (t0 + 32 * wr + 16 * mi + fr) * 512 + h * 128 + 64 * wc + 16 * ni + 4 * fq);
        __syncthreads();
        float rs[2] = {0.f, 0.f};
#pragma unroll
        for (int mi = 0; mi < 2; ++mi) {
            const int i = 32 * wr + 16 * mi + fr;
            float dnf = 0.f, dnb = 0.f;
            if (ML) { dnf = 1.0f / fmaxf(fabsf(dfi[mi] + cfw[mi] * qn[i]), 1.0f); dnb = 1.0f / fmaxf(fabsf(dbi[mi] + cbw[mi] * qn[128 + i]), 1.0f); }
#pragma unroll
            for (int ni = 0; ni < 4; ++ni) {
                f32x4 o;
                if (ML) o = Xf[mi][ni] * dnf + Xb[mi][ni] * dnb; else o = Xf[mi][ni];
                Xf[mi][ni] = o; rs[mi] += (o[0] + o[1]) + (o[2] + o[3]);
            }
            rs[mi] += __shfl_xor(rs[mi], 16); rs[mi] += __shfl_xor(rs[mi], 32);
            if (fq == 0) st[wc * 128 + i] = rs[mi];
        }
        __syncthreads();
        float mu[2];
#pragma unroll
        for (int mi = 0; mi < 2; ++mi) { const int i = 32 * wr + 16 * mi + fr; mu[mi] = (st[i] + st[128 + i]) * (1.0f / 128.0f); float q2 = 0.f;
#pragma unroll
            for (int ni = 0; ni < 4; ++ni) { const f32x4 d = Xf[mi][ni] - mu[mi]; q2 += (d[0] * d[0] + d[1] * d[1]) + (d[2] * d[2] + d[3] * d[3]); }
            q2 += __shfl_xor(q2, 16); q2 += __shfl_xor(q2, 32);
            if (fq == 0) st2[wc * 128 + i] = q2; }
        __syncthreads();
#pragma unroll
        for (int mi = 0; mi < 2; ++mi) { const int i = 32 * wr + 16 * mi + fr; const size_t t = t0 + i;
            const float rstd = rsqrtf((st2[i] + st2[128 + i]) * (1.0f / 128.0f) + 1e-6f);
#pragma unroll
            for (int ni = 0; ni < 4; ++ni) { const int e0 = 64 * wc + 16 * ni + 4 * fq; const f32x4 gv = (f32x4){lo_bf(eg[mi][ni].x), hi_bf(eg[mi][ni].x), lo_bf(eg[mi][ni].y), hi_bf(eg[mi][ni].y)}; f32x4 o;
#pragma unroll
                for (int r = 0; r < 4; ++r) o[r] = (Xf[mi][ni][r] - mu[mi]) * rstd * (ML ? sigmoidf_(gv[r]) : siluf_(gv[r]));
                st4bf(M.dst + t * M.ldd + M.col0 + h * 128 + e0, o); } }
        __syncthreads();
    }
#undef CHC_ISSUE
}

constexpr int DKS = 72, DVS = 392;
constexpr int DK_OFF = 0, DV_OFF = 384 * DKS * 2;
__device__ __forceinline__ void dilated_attn(const Ctx& C) {
    LAS bf16_t* Ks = (LAS bf16_t*)(C.lds + DK_OFF); LAS bf16_t* Vt = (LAS bf16_t*)(C.lds + DV_OFF);
    const bf16_t* cq = WSP(bf16_t, BO_CQ); const bf16_t* ck = WSP(bf16_t, BO_CK); const bf16_t* cvT = WSP(bf16_t, BO_CVT);
    bf16_t* odil = WSP(bf16_t, BO_ODIL); float* lse = WSP(float, WS_LSE);
    const int w = C.wave, fr = C.lane & 15, fq = C.lane >> 4, qbl = w >> 1;
    u32x4 pk_[6], pv_[6]; bf16x8 pq_[2][2];
#define DIL_ISSUE(it_) do { const int run_ = (it_) & 63, hh_ = ((it_) >> 6) & 3, g_ = ((it_) >> 8) % 3, b_ = (it_) / 768, sh_ = 2 * g_; \
        const int NBk_ = 256 >> sh_, qb0_ = run_ * 4, nb0_ = qb0_ & (NBk_ - 1); const size_t hrow_ = (size_t)(g_ * 4 + hh_) * T + (size_t)b_ * SEQ; const int kp0_ = qb0_ * 64 - 64; \
        _Pragma("unroll") for (int jj = 0; jj < 6; ++jj) { const int p = C.tid + 512 * jj, row = p >> 3, c16 = p & 7; const int nbk = nb0_ - 1 + (row >> 6); const bool ok = nbk >= 0 && nbk < NBk_; \
            pk_[jj] = (u32x4){0u, 0u, 0u, 0u}; if (ok) pk_[jj] = *(const u32x4*)(ck + (hrow_ + kp0_ + row) * 64 + c16 * 8); } \
        _Pragma("unroll") for (int jj = 0; jj < 6; ++jj) { const int p = C.tid + 512 * jj, e = p / 48, c = p % 48, t8 = c * 8; const int nbk = nb0_ - 1 + (t8 >> 6); const bool ok = nbk >= 0 && nbk < NBk_; \
            pv_[jj] = (u32x4){0u, 0u, 0u, 0u}; if (ok) pv_[jj] = *(const u32x4*)(cvT + (size_t)((g_ * 4 + hh_) * 64 + e) * T + (size_t)b_ * SEQ + kp0_ + t8); } \
        _Pragma("unroll") for (int mt = 0; mt < 2; ++mt) _Pragma("unroll") for (int ks = 0; ks < 2; ++ks) pq_[mt][ks] = *(const bf16x8*)(cq + (hrow_ + qb0_ * 64 + 32 * w + 16 * mt + fr) * 64 + ks * 32 + fq * 8); } while (0)
    constexpr int NITD = 1536 * REP_DIL;
    if (C.bid < NITD) DIL_ISSUE(C.bid % 1536);
    for (int item_ = C.bid; item_ < NITD; item_ += C.G) { const int item = item_ % 1536;
        const int run = item & 63, hh = (item >> 6) & 3, g = (item >> 8) % 3, b = item / 768, sh = 2 * g;
        const int NBk = 256 >> sh, qb0 = run * 4, nb0 = qb0 & (NBk - 1), cls = qb0 >> (8 - sh);
#pragma unroll
        for (int jj = 0; jj < 6; ++jj) { const int p = C.tid + 512 * jj, row = p >> 3, c16 = p & 7; *(LAS u32x4*)(Ks + row * DKS + c16 * 8) = pk_[jj]; }
#pragma unroll
        for (int jj = 0; jj < 6; ++jj) { const int p = C.tid + 512 * jj, e = p / 48, c = p % 48; *(LAS u32x4*)(Vt + e * DVS + c * 8) = pv_[jj]; }
        bf16x8 qf[2][2];
#pragma unroll
        for (int mt = 0; mt < 2; ++mt)
#pragma unroll
            for (int ks = 0; ks < 2; ++ks) qf[mt][ks] = pq_[mt][ks];
        if (item_ + C.G < NITD) DIL_ISSUE((item_ + C.G) % 1536);
        __syncthreads();
        const int kl0 = 64 * qbl;
#pragma unroll
        for (int mt = 0; mt < 2; ++mt) {
            __builtin_amdgcn_sched_barrier(0);
            unsigned pk[12][2]; float rden, mrow;
            {
                f32x4 acc[12];
#pragma unroll
                for (int ni = 0; ni < 12; ++ni) acc[ni] = (f32x4){0.f, 0.f, 0.f, 0.f};
                const bf16x8 q0 = qf[mt][0], q1 = qf[mt][1];
#pragma unroll
                for (int ni = 0; ni < 12; ++ni) { const bf16x8 kf0 = *(const LAS bf16x8*)(Ks + (kl0 + 16 * ni + fr) * DKS + fq * 8), kf1 = *(const LAS bf16x8*)(Ks + (kl0 + 16 * ni + fr) * DKS + 32 + fq * 8);
                    acc[ni] = __builtin_amdgcn_mfma_f32_16x16x32_bf16(kf0, q0, acc[ni], 0, 0, 0); acc[ni] = __builtin_amdgcn_mfma_f32_16x16x32_bf16(kf1, q1, acc[ni], 0, 0, 0); }
                int frm = fr, fqm = fq; asm volatile("" : "+v"(frm), "+v"(fqm));
                const int ib = 32 * (w & 1) + 16 * mt + frm;
                float mx = -3e38f;
#pragma unroll
                for (int ni = 0; ni < 12; ++ni) { const int nbk = nb0 + qbl - 1 + (ni >> 2); const bool bok = nbk >= 0 && nbk < NBk;
#pragma unroll
                    for (int r = 0; r < 4; ++r) { const int rel = 16 * ni + 4 * fqm + r - 64 - ib; const bool ok = bok && rel <= 64 && rel >= -64;
                        const float sv = ok ? acc[ni][r] * 0.125f : -1e30f; acc[ni][r] = sv; mx = fmaxf(mx, sv); } }
                mx = fmaxf(mx, __shfl_xor(mx, 16)); mx = fmaxf(mx, __shfl_xor(mx, 32));
                float sm = 0.f;
#pragma unroll
                for (int ni = 0; ni < 12; ++ni) { f32x4 p;
#pragma unroll
                    for (int r = 0; r < 4; ++r) { p[r] = __expf(acc[ni][r] - mx); sm += p[r]; }
                    pk[ni][0] = pk2(p[0], p[1]); pk[ni][1] = pk2(p[2], p[3]); }
                sm += __shfl_xor(sm, 16); sm += __shfl_xor(sm, 32);
                rden = 1.0f / sm; mrow = mx + __logf(sm);
            }
            f32x4 o[4];
#pragma unroll
            for (int ne = 0; ne < 4; ++ne) o[ne] = (f32x4){0.f, 0.f, 0.f, 0.f};
#pragma unroll
            for (int ks2 = 0; ks2 < 6; ++ks2) {
                const u32x4 t4 = (u32x4){pk[2 * ks2][0], pk[2 * ks2][1], pk[2 * ks2 + 1][0], pk[2 * ks2 + 1][1]}; const bf16x8 pf = __builtin_bit_cast(bf16x8, t4);
#pragma unroll
                for (int ne = 0; ne < 4; ++ne) { const LAS bf16_t* vp = Vt + (16 * ne + fr) * DVS + kl0 + 32 * ks2 + 4 * fq;
                    const u32x2 v0 = *(const LAS u32x2*)vp, v1 = *(const LAS u32x2*)(vp + 16);
                    const u32x4 v4 = (u32x4){v0.x, v0.y, v1.x, v1.y}; const bf16x8 vf = __builtin_bit_cast(bf16x8, v4);
                    o[ne] = __builtin_amdgcn_mfma_f32_16x16x32_bf16(vf, pf, o[ne], 0, 0, 0); }
            }
            const int ib = 32 * (w & 1) + 16 * mt + fr, p = (((nb0 + qbl) * 64 + ib) << sh) + cls; const size_t trow = (size_t)g * T + (size_t)b * SEQ + p;
#pragma unroll
            for (int ne = 0; ne < 4; ++ne) st4bf(odil + trow * 256 + hh * 64 + 16 * ne + 4 * fq, o[ne] * rden);
            if (fq == 0) lse[trow * 4 + hh] = mrow;
        }
        __syncthreads();
    }
#undef DIL_ISSUE
}
__device__ __forceinline__ void dilated_merge(const Ctx& C) {
    const int gt = C.bid * NTHREADS + C.tid, NGT = C.G * NTHREADS;
    const bf16_t* odil = WSP(bf16_t, BO_ODIL); const float* lse = WSP(float, WS_LSE); bf16_t* aout = WSP(bf16_t, BO_AOUT);
    for (int idx = gt; idx < T * 32; idx += NGT) {
        const int t = idx >> 5, c8 = idx & 31, hh = c8 >> 3;
        const float l0 = lse[(size_t)t * 4 + hh], l1 = lse[((size_t)T + t) * 4 + hh], l2 = lse[((size_t)2 * T + t) * 4 + hh];
        const float mx = fmaxf(l0, fmaxf(l1, l2)); const float e0 = __expf(l0 - mx), e1 = __expf(l1 - mx), e2 = __expf(l2 - mx), rs = 1.0f / (e0 + e1 + e2);
        const float w0 = e0 * rs, w1 = e1 * rs, w2 = e2 * rs;
        const u32x4 a = *(const u32x4*)(odil + (size_t)t * 256 + c8 * 8), bq = *(const u32x4*)(odil + ((size_t)T + t) * 256 + c8 * 8), cc = *(const u32x4*)(odil + ((size_t)2 * T + t) * 256 + c8 * 8);
        u32x4 o;
        o.x = pk2(w0 * lo_bf(a.x) + w1 * lo_bf(bq.x) + w2 * lo_bf(cc.x), w0 * hi_bf(a.x) + w1 * hi_bf(bq.x) + w2 * hi_bf(cc.x));
        o.y = pk2(w0 * lo_bf(a.y) + w1 * lo_bf(bq.y) + w2 * lo_bf(cc.y), w0 * hi_bf(a.y) + w1 * hi_bf(bq.y) + w2 * hi_bf(cc.y));
        o.z = pk2(w0 * lo_bf(a.z) + w1 * lo_bf(bq.z) + w2 * lo_bf(cc.z), w0 * hi_bf(a.z) + w1 * hi_bf(bq.z) + w2 * hi_bf(cc.z));
        o.w = pk2(w0 * lo_bf(a.w) + w1 * lo_bf(bq.w) + w2 * lo_bf(cc.w), w0 * hi_bf(a.w) + w1 * hi_bf(bq.w) + w2 * hi_bf(cc.w));
        *(u32x4*)(aout + (size_t)t * 768 + c8 * 8) = o;
    }
}

template <int MODE>
__device__ __forceinline__ void skinny16(const Ctx& C, const bf16_t* x, const float* wT, const float* bias_i, const float* bias_f) {
    const int gw = C.bid * NWAVES + C.wave, NGW = C.G * NWAVES, l15 = C.lane & 15, q = C.lane >> 4;
    for (int tile = gw; tile < T / 16; tile += NGW) {
        const bf16_t* xr = x + (size_t)(tile * 16 + l15) * DM + 8 * q; const float* wr = wT + (size_t)l15 * DM + 8 * q;
        f32x4 acc = (f32x4){0.f, 0.f, 0.f, 0.f}, acc2 = (f32x4){0.f, 0.f, 0.f, 0.f}; float ss = 0.f;
        for (int s0 = 0; s0 < 32; s0 += 8) {
            u32x4 xw[8]; f32x4 w0[8], w1[8];
#pragma unroll
            for (int s = 0; s < 8; ++s) { xw[s] = *(const u32x4*)(xr + 32 * (s0 + s)); w0[s] = *(const f32x4*)(wr + 32 * (s0 + s)); w1[s] = *(const f32x4*)(wr + 32 * (s0 + s) + 4); }
#pragma unroll
            for (int s = 0; s < 8; ++s) {
                const float x0 = lo_bf(xw[s].x), x1 = hi_bf(xw[s].x), x2 = lo_bf(xw[s].y), x3 = hi_bf(xw[s].y), x4 = lo_bf(xw[s].z), x5 = hi_bf(xw[s].z), x6 = lo_bf(xw[s].w), x7 = hi_bf(xw[s].w);
                ss += (x0 * x0 + x1 * x1) + (x2 * x2 + x3 * x3) + (x4 * x4 + x5 * x5) + (x6 * x6 + x7 * x7);
                acc = __builtin_amdgcn_mfma_f32_16x16x4f32(x0, w0[s][0], acc, 0, 0, 0); acc2 = __builtin_amdgcn_mfma_f32_16x16x4f32(x1, w0[s][1], acc2, 0, 0, 0);
                acc = __builtin_amdgcn_mfma_f32_16x16x4f32(x2, w0[s][2], acc, 0, 0, 0); acc2 = __builtin_amdgcn_mfma_f32_16x16x4f32(x3, w0[s][3], acc2, 0, 0, 0);
                acc = __builtin_amdgcn_mfma_f32_16x16x4f32(x4, w1[s][0], acc, 0, 0, 0); acc2 = __builtin_amdgcn_mfma_f32_16x16x4f32(x5, w1[s][1], acc2, 0, 0, 0);
                acc = __builtin_amdgcn_mfma_f32_16x16x4f32(x6, w1[s][2], acc, 0, 0, 0); acc2 = __builtin_amdgcn_mfma_f32_16x16x4f32(x7, w1[s][3], acc2, 0, 0, 0); }
        }
        acc += acc2;
        ss += __shfl_xor(ss, 16); ss += __shfl_xor(ss, 32);
        const float rstd = rsqrtf(ss * (1.0f / DM) + 1e-6f);
        f32x4 lg;
#pragma unroll
        for (int r = 0; r < 4; ++r) lg[r] = acc[r] * __shfl(rstd, 4 * q + r);
        const int tok0 = tile * 16 + 4 * q, b = tok0 >> 14, pos0 = tok0 & (SEQ - 1);
        if (MODE == 0) {
            if (q == 0) WSP(float, WS_RSTD)[tile * 16 + l15] = rstd;
            f32x4 mx = lg;
#pragma unroll
            for (int o = 1; o < 16; o <<= 1)
#pragma unroll
                for (int r = 0; r < 4; ++r) mx[r] = fmaxf(mx[r], __shfl_xor(mx[r], o));
            f32x4 p, sm;
#pragma unroll
            for (int r = 0; r < 4; ++r) { p[r] = __expf(lg[r] - mx[r]); sm[r] = p[r]; }
#pragma unroll
            for (int o = 1; o < 16; o <<= 1)
#pragma unroll
                for (int r = 0; r < 4; ++r) sm[r] += __shfl_xor(sm[r], o);
#pragma unroll
            for (int r = 0; r < 4; ++r) p[r] = p[r] / sm[r];
            *(f32x4*)(WSP(float, WS_AFF) + (size_t)(b * 16 + l15) * SEQ + pos0) = p;
        } else {
            const int type = l15 >> 2, head = l15 & 3; f32x4 o;
            if (type < 2) { const float bi = bias_i[type * 4 + head];
#pragma unroll
                for (int r = 0; r < 4; ++r) o[r] = lg[r] + bi;
            } else { const float bf = bias_f[(type - 2) * 4 + head];
#pragma unroll
                for (int r = 0; r < 4; ++r) { const float z = lg[r] + bf; o[r] = fminf(z, 0.f) - log1pf(__expf(-fabsf(z))); } }
            *(f32x4*)(WSP(float, WS_MLG) + (size_t)type * 8 * SEQ + (size_t)(b * 4 + head) * SEQ + pos0) = o;
        }
    }
}

__device__ __forceinline__ void quant_rows(const Ctx& C) {
    const int gw = C.bid * NWAVES + C.wave, NGW = C.G * NWAVES;
    const bf16_t* x = WSP(bf16_t, WS_XB); unsigned* xq = WSP(unsigned, WS_HBUF); float* xsc = WSP(float, WS_XSC);
    for (int t = gw; t < T; t += NGW) {
        f32x4 v[4]; float mx = 0.f;
#pragma unroll
        for (int j = 0; j < 4; ++j) { v[j] = ld4bf(x + (size_t)t * DM + j * 256 + C.lane * 4); mx = fmaxf(mx, fmaxf(fmaxf(fabsf(v[j][0]), fabsf(v[j][1])), fmaxf(fabsf(v[j][2]), fabsf(v[j][3])))); }
#pragma unroll
        for (int o = 1; o < 64; o <<= 1) mx = fmaxf(mx, __shfl_xor(mx, o));
        const float inv = mx > 0.f ? 127.0f / mx : 0.f;
#pragma unroll
        for (int j = 0; j < 4; ++j) xq[(size_t)t * 256 + j * 64 + C.lane] = q4i8(v[j], inv);
        if (C.lane == 0) xsc[t] = mx * (1.0f / 127.0f);
    }
}

__device__ __forceinline__ void topk_select(const Ctx& C) {
    LAS unsigned* cnt = (LAS unsigned*)C.lds;
    const float* aff = WSP(float, WS_AFF); int* tok = WSP(int, WS_TOK); float* gatel = WSP(float, WS_GATEL); int* inv = WSP(int, WS_INV); float* rstdl = WSP(float, WS_RSTDL); const float* rstdv = WSP(float, WS_RSTD); const float* xscv = WSP(float, WS_XSC);
    for (int item = C.bid; item < NB * NE; item += C.G) {
        const int b = item >> 4, e = item & 15; const float* a = aff + (size_t)item * SEQ + C.tid * 32;
        unsigned key[32];
#pragma unroll
        for (int k = 0; k < 8; ++k) { const f32x4 v = *(const f32x4*)(a + 4 * k); key[4 * k] = __float_as_uint(v[0]); key[4 * k + 1] = __float_as_uint(v[1]); key[4 * k + 2] = __float_as_uint(v[2]); key[4 * k + 3] = __float_as_uint(v[3]); }
        unsigned prefix = 0u;
        for (int bit = 30; bit >= 0; --bit) {
            const unsigned cand = prefix | (1u << bit); unsigned c = 0;
#pragma unroll
            for (int k = 0; k < 32; ++k) c += (key[k] >= cand) ? 1u : 0u;
#pragma unroll
            for (int o = 1; o < 64; o <<= 1) c += __shfl_xor(c, o);
            LAS unsigned* slot = cnt + (bit & 1) * 8;
            if (C.lane == 0) slot[C.wave] = c;
            __syncthreads();
            unsigned tot = 0;
#pragma unroll
            for (int w = 0; w < 8; ++w) tot += slot[w];
            if (tot >= (unsigned)CAP) prefix = cand;
        }
        __syncthreads();
        unsigned cg_ = 0, ce = 0;
#pragma unroll
        for (int k = 0; k < 32; ++k) { cg_ += (key[k] > prefix) ? 1u : 0u; ce += (key[k] == prefix) ? 1u : 0u; }
        unsigned pkd = cg_ | (ce << 16), inc = pkd;
#pragma unroll
        for (int o = 1; o < 64; o <<= 1) { const unsigned u = __shfl_up(inc, o); if (C.lane >= o) inc += u; }
        if (C.lane == 63) cnt[16 + C.wave] = inc;
        __syncthreads();
        unsigned base = 0, total = 0;
#pragma unroll
        for (int w = 0; w < 8; ++w) { const unsigned v = cnt[16 + w]; if (w < C.wave) base += v; total += v; }
        const unsigned excl = base + inc - pkd;
        const unsigned gt_before = excl & 0xffffu, eq_before = excl >> 16, gt_total = total & 0xffffu;
        const unsigned need_eq = (unsigned)CAP - gt_total;
        unsigned eq_taken_before = eq_before < need_eq ? eq_before : need_eq;
        unsigned slot = gt_before + eq_taken_before, eqr = eq_before;
        const int rowbase = e * 4096 + b * 2048;
#pragma unroll
        for (int k = 0; k < 32; ++k) {
            const int pos = C.tid * 32 + k; int sl = -1;
            if (key[k] > prefix) sl = (int)slot++;
            else if (key[k] == prefix) { if (eqr < need_eq) sl = (int)slot++; ++eqr; }
            inv[((size_t)b * SEQ + pos) * 16 + e] = sl;
            if (sl >= 0) { tok[rowbase + sl] = b * SEQ + pos; gatel[rowbase + sl] = __uint_as_float(key[k]); rstdl[rowbase + sl] = rstdv[b * SEQ + pos] * xscv[b * SEQ + pos]; }
        }
        __syncthreads();
    }
}
template <bool FINAL>
__device__ __forceinline__ void moe_combine(const Ctx& C, const float* g, unsigned* hq, float* hsc, float* out) {
    const int gw = C.bid * NWAVES + C.wave, NGW = C.G * NWAVES;
    bf16_t* x = WSP(bf16_t, WS_XB); const int* inv = WSP(int, WS_INV); const bf16_t* ye = WSP(bf16_t, BG_YE);
    f32x4 gv[4];
#pragma unroll
    for (int j = 0; j < 4; ++j) gv[j] = *(const f32x4*)(g + j * 256 + C.lane * 4);
    for (int t = gw; t < T; t += NGW) {
        const int b = t >> 14; f32x4 v[4];
#pragma unroll
        for (int j = 0; j < 4; ++j) v[j] = ld4bf(x + (size_t)t * DM + j * 256 + C.lane * 4);
        const int myinv = inv[(size_t)t * 16 + (C.lane & 15)];
        unsigned msk = (unsigned)__ballot(myinv >= 0) & 0xffffu;
        while (msk) {
            const bf16_t* yr[4]; float wk[4];
#pragma unroll
            for (int k = 0; k < 4; ++k) { wk[k] = 0.f; yr[k] = ye;
                if (msk) { const int e = __builtin_ctz(msk); msk &= msk - 1; const int sl = __shfl(myinv, e); wk[k] = 1.f; yr[k] = ye + (size_t)(e * 4096 + b * 2048 + sl) * DM + C.lane * 4; } }
            u32x2 r[4][4];
#pragma unroll
            for (int k = 0; k < 4; ++k)
#pragma unroll
                for (int j = 0; j < 4; ++j) r[k][j] = __builtin_nontemporal_load((const u32x2*)(yr[k] + j * 256));
#pragma unroll
            for (int k = 0; k < 4; ++k)
#pragma unroll
                for (int j = 0; j < 4; ++j) v[j] += wk[k] * (f32x4){lo_bf(r[k][j].x), hi_bf(r[k][j].x), lo_bf(r[k][j].y), hi_bf(r[k][j].y)};
        }
        if (!FINAL) {
#pragma unroll
            for (int j = 0; j < 4; ++j) { u32x2 w; w.x = pk2(v[j][0], v[j][1]); w.y = pk2(v[j][2], v[j][3]); *(u32x2*)(x + (size_t)t * DM + j * 256 + C.lane * 4) = w;
                v[j] = (f32x4){lo_bf(w.x), hi_bf(w.x), lo_bf(w.y), hi_bf(w.y)}; } }
        float s = 0.f;
#pragma unroll
        for (int j = 0; j < 4; ++j) s += (v[j][0] * v[j][0] + v[j][1] * v[j][1]) + (v[j][2] * v[j][2] + v[j][3] * v[j][3]);
        const float rstd = rsqrtf(wave_sum(s) * (1.0f / DM) + 1e-6f);
        if (FINAL) {
#pragma unroll
            for (int j = 0; j < 4; ++j) *(f32x4*)(out + (size_t)t * DM + j * 256 + C.lane * 4) = v[j] * rstd * gv[j];
        } else {
            float m = 0.f;
#pragma unroll
            for (int j = 0; j < 4; ++j) { v[j] *= gv[j]; m = fmaxf(m, amax4(v[j])); }
            m = wave_max(m); const float inv = m > 0.f ? 127.0f / m : 0.f;
#pragma unroll
            for (int j = 0; j < 4; ++j) hq[(size_t)t * 256 + j * 64 + C.lane] = q4i8(v[j], inv);
            if (C.lane == 0) hsc[t] = m * rstd * (1.0f / 127.0f);
        }
    }
}

#define XB_TMO      128
#define XB_XCNT(j)  (256  + 64 * (j))
#define XB_XSUB(j)  (1280 + 64 * (j))
#define XB_XGEN(j)  (2304 + 64 * (j))
#define XB_TOP      3328
#define XB_TOPGEN   3392
#define XCD_BAR_WORDS 3456
#define XB_SPIN_CAP (1u << 22)
__device__ __forceinline__ unsigned xb_ld(unsigned* p)              { return __hip_atomic_load(p, __ATOMIC_RELAXED, __HIP_MEMORY_SCOPE_AGENT); }
__device__ __forceinline__ unsigned xb_add(unsigned* p, unsigned v) { return __hip_atomic_fetch_add(p, v, __ATOMIC_RELAXED, __HIP_MEMORY_SCOPE_AGENT); }
__device__ __forceinline__ unsigned xb_xcc_id() { return (unsigned)__builtin_amdgcn_s_getreg((3 << 11) | 20) & 0xFu; }
#define XB_SPIN(cond, bar) do { unsigned _sp = 0; while (cond) { __builtin_amdgcn_s_sleep(1); \
    if ((++_sp & 255u) == 0u) { if (xb_ld(&(bar)[XB_TMO])) break; if (_sp > XB_SPIN_CAP) { atomicAdd(&(bar)[XB_TMO], 1u); break; } } } } while (0)
struct XcdBarrier { unsigned* bar; unsigned x; volatile LAS unsigned* st; int wave; };
__device__ __forceinline__ XcdBarrier xcd_barrier_post(unsigned* bar, volatile LAS unsigned* st, int wave) {
    XcdBarrier b; b.bar = bar; b.x = xb_xcc_id(); b.st = st; b.wave = wave;
    if (wave == 0 && lane_fresh() == 0) (void)xb_add(&bar[XB_XCNT(b.x)], 1u);
    return b;
}
__device__ __forceinline__ void xcd_barrier_complete(unsigned* bar, unsigned x, unsigned& nloc, unsigned& nx) {
    const unsigned G = gridDim.x * gridDim.y * gridDim.z;
    unsigned sum, cnt, mine, sp = 0u;
    for (;;) {
        sum = 0u; cnt = 0u; mine = 0u;
#pragma unroll
        for (unsigned j = 0; j < 16; ++j) { const unsigned c = xb_ld(&bar[XB_XCNT(j)]); sum += c; cnt += (c > 0u) ? 1u : 0u; mine = (j == x) ? c : mine; }
        if (sum == G) break;
        __builtin_amdgcn_s_sleep(1);
        if ((++sp & 255u) == 0u) { if (xb_ld(&bar[XB_TMO])) break; if (sp > XB_SPIN_CAP) { atomicAdd(&bar[XB_TMO], 1u); break; } }
    }
    nloc = mine > 0u ? mine : 1u; nx = cnt > 0u ? cnt : 1u;
}
__device__ __forceinline__ void xcd_barrier(const XcdBarrier& b) {
    asm volatile("s_waitcnt vmcnt(0)" ::: "memory");
    __syncthreads();
    if (b.wave == 0 && lane_fresh() == 0) {
        unsigned* bar = b.bar;
        __builtin_amdgcn_s_waitcnt(0);
        unsigned nloc = b.st[0], nx = b.st[1];
        if (nloc == 0u) { xcd_barrier_complete(bar, b.x, nloc, nx); b.st[0] = nloc; b.st[1] = nx; }
        const unsigned old = xb_add(&bar[XB_XSUB(b.x)], 1u);
        const unsigned gen = old / nloc;
        if (old + 1u == (gen + 1u) * nloc) {
            __builtin_amdgcn_fence(__ATOMIC_RELEASE, "agent");
            asm volatile("s_waitcnt vmcnt(0)" ::: "memory");
            const unsigned og = xb_add(&bar[XB_TOP], 1u);
            const unsigned tg = og / nx;
            if (og + 1u == (tg + 1u) * nx) xb_add(&bar[XB_TOPGEN], 1u);
            else XB_SPIN(xb_ld(&bar[XB_TOPGEN]) == tg, bar);
            __builtin_amdgcn_fence(__ATOMIC_ACQUIRE, "agent");
            xb_add(&bar[XB_XGEN(b.x)], 1u);
            asm volatile("s_waitcnt vmcnt(0)" ::: "memory");
        } else {
            XB_SPIN(xb_ld(&bar[XB_XGEN(b.x)]) == gen, bar);
            __builtin_amdgcn_fence(__ATOMIC_ACQUIRE, "agent");
            asm volatile("s_waitcnt vmcnt(0)" ::: "memory");
        }
    }
    __syncthreads();
}

constexpr int LDS_BYTES = 148480;
constexpr int NPHASE = 24;

__device__ __forceinline__ void moe_gemms1(const Ctx& C, int layer) {
    pg8::Gemm g{WSP(bf16_t, WS_HBUF), (const bf16_t*)(C.ws + WS_W13 + (size_t)layer * (64 * MiB)), 512, 512, 512, WSP(int, WS_TOK)}; pg8::TileOrder S; S.init(16, 16, 16, C.G, C.bid, REP_MOE1);
    EpiMoe1 E{WSP(signed char, BG_ACT), WSP(unsigned short, WS_ACTSC), WSP(float, WS_RSTDL), WSP(float, WS_WSC) + (size_t)layer * 16 * 4096, C.lds}; pg8::gemm_phase<EpiMoe1, true, true, true>(C.lds, g, S, E, C.wave);
}
__device__ __forceinline__ void moe_gemms2(const Ctx& C) {
    pg8::Gemm g{WSP(bf16_t, BG_ACT), WSP(bf16_t, WS_W2), 1024, 1024, 1024, nullptr, WSP(unsigned short, WS_ACTSC)}; pg8::TileOrder S; S.init(16, 16, 4, C.G, C.bid, REP_MOE2);
    EpiMoe2 E{WSP(bf16_t, BG_YE), WSP(float, WS_GATEL), WSP(float, WS_W2SC)}; pg8::gemm_phase<EpiMoe2, true, false, true, true>(C.lds, g, S, E, C.wave);
}

__global__ void __launch_bounds__(NTHREADS, 2) mega(Args args) {
    extern __shared__ __attribute__((aligned(16))) unsigned char lds_raw[];
    Ctx C0; C0.kp = (KargP)__builtin_amdgcn_kernarg_segment_ptr(); C0.out = (GAS float*)ldarg_ptr<192>(C0.kp); C0.ws = (GAS unsigned char*)ldarg_ptr<200>(C0.kp); C0.lds = (LAS unsigned char*)lds_raw;
    C0.tid = threadIdx.x; C0.lane = C0.tid & 63; C0.wave = __builtin_amdgcn_readfirstlane(C0.tid >> 6); C0.bid = blockIdx.x; C0.G = gridDim.x;
    const unsigned long long phw = (unsigned long long)ldarg_ptr<208>(C0.kp); const int lo = (int)(unsigned)phw, hi = (int)(unsigned)(phw >> 32);
#ifndef PHMASK
#define PHMASK 0xFFFFFFu
#endif
#define IN(k) (((PHMASK >> (k)) & 1u) && lo <= (k) && (k) < hi)
#ifndef REPMASK
#define REPMASK 0u
#endif
    volatile LAS unsigned* bst = (volatile LAS unsigned*)(C0.lds + LDS_BYTES - 64);
    if (C0.tid < 2) bst[C0.tid] = 0u;
    __syncthreads();
    XcdBarrier gbar; gbar.bar = (unsigned*)(C0.ws + WS_BAR); gbar.x = 0; gbar.st = bst; gbar.wave = C0.wave;
    if (hi - lo > 1 || REPMASK != 0u) gbar = xcd_barrier_post((unsigned*)(C0.ws + WS_BAR), bst, C0.wave);
    if (lo == 0x7fffffff) cg::this_grid().sync();
#define GRID_BAR() xcd_barrier(gbar)
#define SEAM(k) do { if (IN(k) && IN((k) + 1)) GRID_BAR(); } while (0)
#define PH_BEGIN(k) if (IN(k)) { Ctx C = C0; C.lane = lane_fresh(); C.tid = C.wave * 64 + C.lane; for (int rep_ = 0; rep_ <= (int)((REPMASK >> (k)) & 1u); ++rep_) { if (rep_) GRID_BAR();
#define PH_END(k) } } SEAM(k);

    PH_BEGIN(0) { prep_tables(C); conv_small_weights(C); for (int i = C.G - 1 - C.bid; i < WIN_BLK_ITEMS; i += C.G) winq_block_item(C, i);
        conv_moe_weights(C, 0, 0, CONV_A0, 0); rmsnorm_rows(C, INP(0), INP(1), WSP(unsigned, WS_HBUF), WSP(float, WS_XSC)); }
    PH_END(0)
    PH_BEGIN(1) {
        s5_ktab(C); s5_gmat(C); __syncthreads();
        { pg8::Gemm g{WSP(bf16_t, WS_HBUF), WSP(bf16_t, WS_WEV_MAIN), 512, 512, 512, nullptr}; pg8::TileOrder S; S.init(1, 128, 10, C.G, C.bid, REP_WIN);
          EpiEvenMain E{WSP(bf16_t, BG_Q), WSP(bf16_t, BG_K), WSP(bf16_t, BG_G), WSP(bf16_t, BG_A2), WSP(bf16_t, BG_KT), WSP(bf16_t, BG_VT), WSP(float, WS_COS128), WSP(float, WS_SIN128), C.lds, WSP(float, WS_XSC), WSP(float, WS_WINSC)}; pg8::gemm_phase<EpiEvenMain, true, false, true>(C.lds, g, S, E, C.wave); }
    }
    PH_END(1)
    PH_BEGIN(2) {
        s5_b2mat(C); __syncthreads();
        { MixA M{WSP(bf16_t, BG_Q), WSP(bf16_t, BG_K), WSP(bf16_t, BG_KT), WSP(bf16_t, BG_VT), WSP(bf16_t, BG_OINTRA), nullptr, WSP(bf16_t, BG_KV)}; chunk_phaseA<false>(C, M); }
        conv_moe_weights(C, 0, CONV_A0, CONV_A1, 128); __syncthreads();
        { pg8::Gemm g{WSP(bf16_t, BG_A2), WSP(bf16_t, BG_GM), 512, 768, 512, nullptr}; pg8::TileOrder S; S.init(32, 4, 1, C.G, C.bid, REP_S5);
          EpiS5A E{WSP(float, BG_XRAW)}; pg8::gemm_phase<EpiS5A>(C.lds, g, S, E, C.wave); }
    }
    PH_END(2)
    PH_BEGIN(3) { chunk_scan<false>(C, WSP(bf16_t, BG_KV)); s5_scan(C); conv_moe_weights(C, 0, CONV_A1, CONV_A2, 16); }
    PH_END(3)
    PH_BEGIN(4) {
        { MixC M{WSP(bf16_t, BG_Q), WSP(bf16_t, BG_KV), WSP(bf16_t, BG_OINTRA), nullptr, WSP(bf16_t, BG_G), WSP(bf16_t, BG_AOUT), 1024, 0}; chunk_phaseC<false>(C, M); }
        { pg8::Gemm g{WSP(bf16_t, BG_A2), WSP(bf16_t, BG_B2), 768, 768, 768, nullptr}; pg8::TileOrder S; S.init(32, 4, 2, C.G, C.bid, REP_S5);
          EpiS5B E{WSP(bf16_t, BG_A2), INP(13), WSP(bf16_t, BG_YG)}; pg8::gemm_phase<EpiS5B>(C.lds, g, S, E, C.wave); }
    }
    PH_END(4)
    PH_BEGIN(5) { pg8::Gemm g{WSP(bf16_t, BG_YG), WSP(bf16_t, WS_WGLU), 512, 512, 512, nullptr}; pg8::TileOrder S; S.init(1, 128, 2, C.G, C.bid, REP_WOUT);
        EpiGlu E{WSP(bf16_t, BG_YG), INP(15), WSP(bf16_t, BG_AOUT)}; pg8::gemm_phase<EpiGlu>(C.lds, g, S, E, C.wave); }
    PH_END(5)
    PH_BEGIN(6) { pg8::Gemm g{WSP(bf16_t, BG_AOUT), WSP(bf16_t, WS_WEVO), 1024, 1024, 1024, nullptr}; pg8::TileOrder S; S.init(1, 128, 4, C.G, C.bid, REP_WOUT);
        EpiResid<false> E{INP(0), WSP(bf16_t, WS_XB)}; pg8::gemm_phase<EpiResid<false>>(C.lds, g, S, E, C.wave); }
    PH_END(6)
    PH_BEGIN(7) { skinny16<0>(C, WSP(bf16_t, WS_XB), WSP(float, WS_WRT), nullptr, nullptr); quant_rows(C); }
    PH_END(7)
    PH_BEGIN(8) { topk_select(C); conv_moe_weights(C, 0, CONV_A2, CONV_BLK_ITEMS, 32); }
    PH_END(8)
    PH_BEGIN(10) moe_gemms1(C, 0);
    PH_END(10)
    PH_BEGIN(11) moe_gemms2(C);
    PH_END(11)
    PH_BEGIN(12) { moe_combine<false>(C, INP(1) + 1024, WSP(unsigned, WS_HBUF), WSP(float, WS_XSC), nullptr); conv_moe_weights(C, 1, 0, CONV_B0, 0); }
    PH_END(12)
    PH_BEGIN(13) {
        skinny16<1>(C, WSP(bf16_t, WS_XB), WSP(float, WS_WGT), INP(18), INP(19)); __syncthreads();
        { pg8::Gemm g{WSP(bf16_t, WS_HBUF), WSP(bf16_t, WS_WOD_MAIN), 512, 512, 512, nullptr}; pg8::TileOrder S; S.init(1, 128, 17, C.G, C.bid, REP_WIN);
          EpiOddMain E{(unsigned char*)C.ws, WSP(float, WS_COS64), WSP(float, WS_SIN64), C.lds, WSP(float, WS_XSC), WSP(float, WS_WINSC) + 2560}; pg8::gemm_phase<EpiOddMain, true, false, true>(C.lds, g, S, E, C.wave); }
        conv_moe_weights(C, 1, CONV_B0, CONV_B1, 128);
    }
    PH_END(13)
    PH_BEGIN(14) {
        dilated_attn(C);
        { MixA M{WSP(bf16_t, BO_MQ), WSP(bf16_t, BO_MK), WSP(bf16_t, BO_MKT), WSP(bf16_t, BO_MVT), WSP(bf16_t, BO_NUMF), WSP(bf16_t, BO_NUMB), WSP(bf16_t, BO_KV)}; chunk_phaseA<true>(C, M); }
    }
    PH_END(14)
    PH_BEGIN(15) chunk_scan<true>(C, WSP(bf16_t, BO_KV));
    PH_END(15)
    PH_BEGIN(16) {
        dilated_merge(C);
        { MixC M{WSP(bf16_t, BO_MQ), WSP(bf16_t, BO_KV), WSP(bf16_t, BO_NUMF), WSP(bf16_t, BO_NUMB), WSP(bf16_t, BO_MO), WSP(bf16_t, BO_AOUT), 768, 256}; chunk_phaseC<true>(C, M); }
    }
    PH_END(16)
    PH_BEGIN(17) { pg8::Gemm g{WSP(bf16_t, BO_AOUT), WSP(bf16_t, WS_WODO), 768, 768, 768, nullptr}; pg8::TileOrder S; S.init(1, 128, 4, C.G, C.bid);
        EpiResid<true> E{nullptr, WSP(bf16_t, WS_XB)}; pg8::gemm_phase<EpiResid<true>>(C.lds, g, S, E, C.wave); }
    PH_END(17)
    PH_BEGIN(18) { skinny16<0>(C, WSP(bf16_t, WS_XB), WSP(float, WS_WRT) + 16 * 1024, nullptr, nullptr); quant_rows(C); }
    PH_END(18)
    PH_BEGIN(19) { topk_select(C); conv_moe_weights(C, 1, CONV_B1, CONV_BLK_ITEMS, 32); }
    PH_END(19)
    PH_BEGIN(21) moe_gemms1(C, 1);
    PH_END(21)
    PH_BEGIN(22) moe_gemms2(C);
    PH_END(22)
    PH_BEGIN(23) moe_combine<true>(C, INP(3), nullptr, nullptr, (float*)C.out);
    PH_END(23)
#ifdef DBG_STOP
    if (lo == 100) {
        const Ctx& C = C0;
        const size_t gt = (size_t)C.bid * NTHREADS + C.tid, NGT = (size_t)C.G * NTHREADS;
        for (size_t i = gt; i < (size_t)T * DM; i += NGT) { float v = 0.f; if (i < (size_t)DBG_N) v = DBG_F32 ? ((const float*)(C.ws + DBG_OFF))[i] : bf2f(((const bf16_t*)(C.ws + DBG_OFF))[i]); C.out[i] = v; }
    }
#endif
#undef IN
#undef SEAM
#undef PH_BEGIN
#undef PH_END
}

extern "C" void kernel_launch(void* const* d_in, const int* in_sizes, int n_in, void* d_out, int out_size, void* d_ws, size_t ws_size, hipStream_t stream) {
    static int grid = 0;
    if (grid == 0) {
        if (n_in != 24 || out_size != T * DM || ws_size < WS_END) { fprintf(stderr, "kernel_launch: unexpected shapes (n_in %d out %d ws %zu need %zu)\n", n_in, out_size, ws_size, (size_t)WS_END); grid = -1; return; }
        int dev = 0, cus = 0, per_cu = 0;
        hipGetDevice(&dev); hipDeviceGetAttribute(&cus, hipDeviceAttributeMultiprocessorCount, dev);
        hipFuncSetAttribute((const void*)mega, hipFuncAttributeMaxDynamicSharedMemorySize, LDS_BYTES);
        hipOccupancyMaxActiveBlocksPerMultiprocessor(&per_cu, (const void*)mega, NTHREADS, LDS_BYTES);
        if (per_cu < 1) { fprintf(stderr, "kernel_launch: occupancy query says %d blocks per CU\n", per_cu); per_cu = 1; }
        grid = cus * (per_cu > 1 ? 1 : per_cu);
        (void)hipGetLastError();
    }
    if (grid < 0) return;
    Args a{};
    for (int i = 0; i < 24; ++i) a.in[i] = (const float*)d_in[i];
    a.out = (float*)d_out; a.ws = (unsigned char*)d_ws;
    (void)hipMemsetAsync((unsigned char*)d_ws + WS_BAR, 0, XCD_BAR_WORDS * 4, stream);
#if ONE_LAUNCH
    a.ph_lo = 0; a.ph_hi = NPHASE;
    void* kargs[] = {&a};
    hipError_t e = hipLaunchCooperativeKernel((const void*)mega, dim3(grid), dim3(NTHREADS), kargs, LDS_BYTES, stream);
    if (e != hipSuccess) fprintf(stderr, "cooperative launch failed: %s (grid %d)\n", hipGetErrorString(e), grid);
#else
#ifdef DBG_STOP
    for (int p = 0; p <= DBG_STOP; ++p) { a.ph_lo = p; a.ph_hi = p + 1; hipLaunchKernelGGL(mega, dim3(grid), dim3(NTHREADS), LDS_BYTES, stream, a); }
    a.ph_lo = 100; a.ph_hi = 101; hipLaunchKernelGGL(mega, dim3(grid), dim3(NTHREADS), LDS_BYTES, stream, a);
#else
    for (int p = 0; p < NPHASE; ++p) { a.ph_lo = p; a.ph_hi = p + 1; hipLaunchKernelGGL(mega, dim3(grid), dim3(NTHREADS), LDS_BYTES, stream, a); }
#endif
#endif
}
```

```cpp
#include <hip/hip_runtime.h>
#include <hip/hip_cooperative_groups.h>
#include <cstdio>
#include <cstdint>
namespace cg = cooperative_groups;

#define LAS __attribute__((address_space(3)))
#define GAS __attribute__((address_space(1)))
typedef unsigned short bf16_t;
typedef short bf16x8 __attribute__((ext_vector_type(8)));
typedef float f32x4 __attribute__((ext_vector_type(4)));
typedef float f32x2 __attribute__((ext_vector_type(2)));
typedef unsigned u32x4 __attribute__((ext_vector_type(4)));
typedef unsigned u32x2 __attribute__((ext_vector_type(2)));
typedef int i32x4 __attribute__((ext_vector_type(4)));

#ifndef CONV_A0
#define CONV_A0 400
#endif
#ifndef CONV_A1
#define CONV_A1 528
#endif
#ifndef CONV_A2
#define CONV_A2 1008
#endif
#ifndef CONV_B0
#define CONV_B0 400
#endif
#ifndef CONV_B1
#define CONV_B1 720
#endif
#ifndef REP_CHA
#define REP_CHA 1
#endif
#ifndef REP_CHC
#define REP_CHC 1
#endif
#ifndef REP_DIL
#define REP_DIL 1
#endif
#ifndef REP_MOE1
#define REP_MOE1 1
#endif
#ifndef REP_MOE2
#define REP_MOE2 1
#endif
#ifndef REP_WIN
#define REP_WIN 1
#endif
#ifndef REP_WOUT
#define REP_WOUT 1
#endif
#ifndef REP_S5
#define REP_S5 1
#endif
#ifndef ONE_LAUNCH
#define ONE_LAUNCH 1
#endif

constexpr int NB = 2, SEQ = 16384, T = NB * SEQ, DM = 1024;
constexpr int NE = 16, FF = 2048, CAP = 2048;
constexpr int NTHREADS = 512, NWAVES = 8;

__device__ __forceinline__ float bf2f(bf16_t b) { return __uint_as_float(((unsigned)b) << 16); }
typedef __bf16 bf16x2_t __attribute__((ext_vector_type(2)));
__device__ __forceinline__ unsigned pk2(float lo, float hi) { const f32x2 v = {lo, hi}; const bf16x2_t b = __builtin_convertvector(v, bf16x2_t); return __builtin_bit_cast(unsigned, b); }
__device__ __forceinline__ bf16_t f2bf(float f) { return (bf16_t)(pk2(f, 0.f) & 0xffffu); }
__device__ __forceinline__ float lo_bf(unsigned w) { return __uint_as_float(w << 16); }
__device__ __forceinline__ float hi_bf(unsigned w) { return __uint_as_float(w & 0xffff0000u); }
__device__ __forceinline__ float wave_sum(float v) {
#pragma unroll
    for (int o = 1; o < 64; o <<= 1) v += __shfl_xor(v, o);
    return v;
}
__device__ __forceinline__ float sigmoidf_(float x) { return __builtin_amdgcn_rcpf(1.0f + __expf(-x)); }
__device__ __forceinline__ float siluf_(float x) { return x * __builtin_amdgcn_rcpf(1.0f + __expf(-x)); }
__device__ __forceinline__ float gelu_tanh(float x) {
    const float z = 0.7978845608028654f * (x + 0.044715f * x * x * x);
    const float e = __expf(2.0f * z);
    const float th = 1.0f - 2.0f * __builtin_amdgcn_rcpf(e + 1.0f);
    return 0.5f * x * (1.0f + th);
}
__device__ __forceinline__ void sincos_d(double ang, float& s, float& c) {
    const double rev = ang * 0.15915494309189535;
    const double fr = rev - __builtin_rint(rev);
    const float f = (float)fr;
    s = __builtin_amdgcn_sinf(f); c = __builtin_amdgcn_cosf(f);
}
#define LDS_WAIT() asm volatile("s_waitcnt lgkmcnt(0)" ::: "memory")
__device__ __forceinline__ int lane_fresh() { int l; asm volatile("v_mbcnt_lo_u32_b32 %0, -1, 0\n\tv_mbcnt_hi_u32_b32 %0, -1, %0" : "=v"(l)); return l; }

namespace pg8 {
constexpr int BM = 256, BK = 64, HALF = 128, HTB = HALF * BK * 2, STAGE_BYTES = 8 * HTB, NXCD = 8, WGM = 8, SCQ_OFF = STAGE_BYTES;
__host__ __device__ __forceinline__ int lds_byte(int r, int c) { const int st = (r >> 4) * 2 + (c >> 5), rr = r & 15, cc = c & 31, ob = rr * 64 + cc * 2; return st * 1024 + (ob ^ (((ob >> 9) & 1) << 5)); }
__host__ __device__ __forceinline__ void stage_rc(int b, int& R, int& C) { const int st = b / 1024, sb = b % 1024, swz = sb ^ (((sb >> 9) & 1) << 5); R = (st >> 1) * 16 + swz / 64; C = (st & 1) * 32 + (swz % 64) / 2; }
__host__ __device__ __forceinline__ int perm32(int rho) { const int n = rho >> 4, i = rho & 15; return 8 * (i >> 2) + 4 * n + (i & 3); }

struct Unit { int pm, pn; };
struct Gemm { const bf16_t* A; const bf16_t* Bt; int K, lda, ldb; const int* gather; const unsigned short* ksc = nullptr; };

struct TileOrder {
    int nM, nN, per, total, G, c, rep;
    __device__ void init(int ngroups, int nM_, int nN_, int G_, int c_, int rep_ = 1) { nM = nM_; nN = nN_; per = nM * nN; total = ngroups * per; G = G_; c = c_; rep = rep_; }
    __device__ bool next(int i, Unit& u) const {
        long L = (long)i * G + c; if (L >= (long)total * rep) return false;
        L %= total;
        const int g = (int)(L / per); int wgid = (int)(L % per);
        { const int q = per / NXCD, r = per % NXCD, xcd = wgid % NXCD, off = wgid / NXCD; wgid = (xcd < r ? xcd * (q + 1) : r * (q + 1) + (xcd - r) * q) + off; }
        const int nig = WGM * nN, gid = wgid / nig, fm = gid * WGM, gsz = (nM - fm) < WGM ? (nM - fm) : WGM;
        u.pm = g * nM + fm + ((wgid % nig) % gsz); u.pn = g * nN + (wgid % nig) / gsz; return true;
    }
};

template <class Epi, bool ALIGN_EPI = true, bool GATHER = false, bool I8 = false, bool KQ = false>
__device__ __forceinline__ void gemm_phase(LAS unsigned char* lds, const Gemm g, const TileOrder& S, const Epi& E, int wave_) {
    const int wid = __builtin_amdgcn_readfirstlane(wave_), lane = lane_fresh(), tid = wid * 64 + lane, wr = wid >> 2, wc = wid & 3, fr = lane & 15, fq = lane >> 4;
    const int K = g.K, nt = K / BK;
    unsigned voffA[2], voffB[2]; int stR[2], stC[2];
#pragma unroll
    for (int i = 0; i < 2; ++i) { int R, C; stage_rc(tid * 16 + i * 8192, R, C); const int Rb = Epi::PERM ? ((R & ~31) + perm32(R & 31)) : R; stR[i] = R; stC[i] = C;
        voffA[i] = (unsigned)(R * g.lda + C) * 2u; voffB[i] = (unsigned)(Rb * g.ldb + C) * 2u; }
    const size_t kstep = (size_t)(BK * 2);
    const size_t hstepA = GATHER ? 0 : (size_t)HALF * g.lda * 2, hstepB = (size_t)HALF * g.ldb * 2;
    const size_t tstepA = GATHER ? 0 : 2 * (size_t)HALF * g.lda * 2, tstepB = 2 * hstepB;
    unsigned vAc[2][2], vAn[2][2];
#define PG8_GOFF(dst, pm_) do { _Pragma("unroll") for (int _h = 0; _h < 2; ++_h) _Pragma("unroll") for (int _i = 0; _i < 2; ++_i) \
        dst[_h][_i] = (unsigned)(g.gather[(pm_) * 256 + _h * 128 + stR[_i]] * g.lda + stC[_i]) * 2u; } while (0)
    const unsigned ldsw = (unsigned)wid * 1024u;
    const int aoff = lds_byte(wr * 64 + fr, fq * 8), boff = lds_byte(wc * 32 + fr, fq * 8);
#define PG8_SA(b, h) (((b) * 2 + (h)) * HTB)
#define PG8_SB(b, h) ((4 + (b) * 2 + (h)) * HTB)
#define PG8_STAGE(bufoff, gbase, voff) do { _Pragma("unroll") for (int _i = 0; _i < 2; ++_i) \
        __builtin_amdgcn_global_load_lds((const unsigned*)((const char*)(gbase) + (voff)[_i]), (LAS unsigned*)(lds + (bufoff) + ldsw + _i * 8192), 16, 0, 0); } while (0)
#define PG8_LDA(dst, b, h) do { _Pragma("unroll") for (int m = 0; m < 4; ++m) _Pragma("unroll") for (int k = 0; k < 2; ++k) dst[m][k] = *(const LAS bf16x8*)(lds + PG8_SA(b, h) + aoff + m * 2048 + k * 1024); } while (0)
#define PG8_LDB(dst, b, h) do { _Pragma("unroll") for (int n = 0; n < 2; ++n) _Pragma("unroll") for (int k = 0; k < 2; ++k) dst[n][k] = *(const LAS bf16x8*)(lds + PG8_SB(b, h) + boff + n * 2048 + k * 1024); } while (0)
#define PG8_MMA(ai, bj, At, Bt) do { __builtin_amdgcn_s_setprio(1); _Pragma("unroll") for (int m = 0; m < 4; ++m) _Pragma("unroll") for (int n = 0; n < 2; ++n) _Pragma("unroll") for (int k = 0; k < 2; ++k) \
        acc[ai][bj][m][n] = I8 ? __builtin_bit_cast(f32x4, __builtin_amdgcn_mfma_i32_16x16x64_i8(__builtin_bit_cast(i32x4, Bt[n][k]), __builtin_bit_cast(i32x4, At[m][k]), __builtin_bit_cast(i32x4, acc[ai][bj][m][n]), 0, 0, 0)) \
                                : __builtin_amdgcn_mfma_f32_16x16x32_bf16(Bt[n][k], At[m][k], acc[ai][bj][m][n], 0, 0, 0); __builtin_amdgcn_s_setprio(0); } while (0)
    float sc[4]; int scbuf = 0;
#define PG8_LDSC(ai, kb) do { if constexpr (KQ) { const u32x2 w_ = *(const LAS u32x2*)(lds + SCQ_OFF + scbuf * 8192 + ((((kb) * 2 + ai) * 2 + wr) * 64 + fr * 4) * 2); \
        sc[0] = (float)__builtin_bit_cast(_Float16, (unsigned short)(w_.x & 0xffffu)); sc[1] = (float)__builtin_bit_cast(_Float16, (unsigned short)(w_.x >> 16)); \
        sc[2] = (float)__builtin_bit_cast(_Float16, (unsigned short)(w_.y & 0xffffu)); sc[3] = (float)__builtin_bit_cast(_Float16, (unsigned short)(w_.y >> 16)); } } while (0)
#define PG8_SCDMA(buf, pm_) do { int t16_ = lane * 16; asm volatile("" : "+v"(t16_));     \
        __builtin_amdgcn_global_load_lds((const unsigned*)((const char*)g.ksc + (size_t)(pm_) * 8192 + wid * 1024 + t16_), (LAS unsigned*)(lds + SCQ_OFF + (buf) * 8192 + ldsw), 16, 0, 0); } while (0)
    const i32x4 magicq = {0x4B400000, 0x4B400000, 0x4B400000, 0x4B400000};
#define PG8_MFQ(dst, Bt_, n_, m_) do { dst = __builtin_amdgcn_mfma_i32_16x16x64_i8(__builtin_bit_cast(i32x4, Bt_[n_][0]), __builtin_bit_cast(i32x4, At[m_][0]), magicq, 0, 0, 0); \
        dst = __builtin_amdgcn_mfma_i32_16x16x64_i8(__builtin_bit_cast(i32x4, Bt_[n_][1]), __builtin_bit_cast(i32x4, At[m_][1]), dst, 0, 0, 0); } while (0)
#define PG8_MMAQ2(ai) do { __builtin_amdgcn_s_setprio(1); i32x4 tq_[3]; _Pragma("unroll") for (int p_ = 0; p_ < 18; ++p_) { \
        if (p_ < 16) { const int m_ = (p_ >> 1) & 3, n_ = p_ & 1; if (p_ < 8) { PG8_MFQ(tq_[p_ % 3], B0, n_, m_); } else { PG8_MFQ(tq_[p_ % 3], B1, n_, m_); } } \
        if (p_ >= 2) { const int q_ = p_ - 2, m_ = (q_ >> 1) & 3, n_ = q_ & 1; acc[ai][q_ >> 3][m_][n_] += __builtin_bit_cast(f32x4, tq_[q_ % 3]) * sc[m_]; } \
        __builtin_amdgcn_sched_barrier(0); } \
        __builtin_amdgcn_s_setprio(0); } while (0)
#define PG8_MM(ai, bj, At, Bt) do { if constexpr (KQ) { if (bj == 0) { PG8_MMAQ2(ai); } } else { PG8_MMA(ai, bj, At, Bt); } } while (0)
#define PG8_WAIT_V(n) asm volatile("s_waitcnt vmcnt(" #n ")" ::: "memory")
#define PG8_WAIT_L(n) asm volatile("s_waitcnt lgkmcnt(" #n ")" ::: "memory")
#define PG8_BAR __builtin_amdgcn_s_barrier()
#define PG8_SCHED __builtin_amdgcn_sched_barrier(0)
#define PG8_STAGE_A(bufoff, gbase, h_, usenext) do { if constexpr (GATHER) { _Pragma("unroll") for (int _i = 0; _i < 2; ++_i) { const unsigned _v = (usenext) ? vAn[h_][_i] : vAc[h_][_i]; \
        __builtin_amdgcn_global_load_lds((const unsigned*)((const char*)(gbase) + _v), (LAS unsigned*)(lds + (bufoff) + ldsw + _i * 8192), 16, 0, 0); } } else { PG8_STAGE(bufoff, gbase, voffA); } } while (0)
    Unit cur, nxt; int ui = 0;
    if (!S.next(0, cur)) return;
    if constexpr (GATHER) { PG8_GOFF(vAc, cur.pm); }
    typename Epi::Pre pre; E.prefetch(pre, cur, wr, wc, fr, fq);
    f32x4 acc[2][2][4][2];
#pragma unroll
    for (int a = 0; a < 2; ++a)
#pragma unroll
        for (int b = 0; b < 2; ++b)
#pragma unroll
            for (int m = 0; m < 4; ++m)
#pragma unroll
                for (int n = 0; n < 2; ++n) acc[a][b][m][n] = (f32x4){0.f, 0.f, 0.f, 0.f};
    bf16x8 At[4][2], B0[2][2], B1[2][2];
    const char* cA = (const char*)g.A + (size_t)cur.pm * tstepA; const char* cB = (const char*)g.Bt + (size_t)cur.pn * tstepB;
    if constexpr (KQ) { PG8_SCDMA(0, cur.pm); }
    PG8_STAGE(PG8_SB(0, 0), cB, voffB); PG8_STAGE(PG8_SB(0, 1), cB + hstepB, voffB); PG8_STAGE_A(PG8_SA(0, 0), cA, 0, false); PG8_STAGE_A(PG8_SA(0, 1), cA + hstepA, 1, false);
    if (wr == 1) PG8_BAR;
    PG8_WAIT_V(2); PG8_BAR;
    PG8_STAGE(PG8_SB(1, 0), cB + kstep, voffB); PG8_STAGE_A(PG8_SA(1, 0), cA + kstep, 0, false); PG8_STAGE(PG8_SB(1, 1), cB + hstepB + kstep, voffB);
    PG8_WAIT_V(6); PG8_BAR;
    for (;;) {
        const bool has_next = S.next(ui + 1, nxt);
        if constexpr (GATHER) { if (has_next) { PG8_GOFF(vAn, nxt.pm); } else {
#pragma unroll
            for (int _h = 0; _h < 2; ++_h)
#pragma unroll
                for (int _i = 0; _i < 2; ++_i) vAn[_h][_i] = vAc[_h][_i]; } }
        const char* nA = has_next ? (const char*)g.A + (size_t)nxt.pm * tstepA : cA; const char* nB = has_next ? (const char*)g.Bt + (size_t)nxt.pn * tstepB : cB;
        if constexpr (KQ) { PG8_BAR;     if (has_next) { PG8_SCDMA(scbuf ^ 1, nxt.pm); } }
        for (int t = 0; t < nt; t += 2) {
            const bool last = (t == nt - 2);
            const char* a1 = cA + (size_t)(t + 1) * kstep;
            const char* a2 = last ? nA : cA + (size_t)(t + 2) * kstep; const char* b2 = last ? nB : cB + (size_t)(t + 2) * kstep;
            const char* a3 = a2 + kstep; const char* b3 = b2 + kstep;
            PG8_LDB(B0, 0, 0); PG8_LDB(B1, 0, 1); PG8_SCHED; PG8_LDA(At, 0, 0); PG8_LDSC(0, t); PG8_STAGE_A(PG8_SA(1, 1), a1 + hstepA, 1, false);
            PG8_WAIT_V(8); PG8_WAIT_L(0); PG8_BAR; PG8_MM(0, 0, At, B0); PG8_MM(0, 1, At, B1); PG8_BAR; PG8_SCHED;
            PG8_LDA(At, 0, 1); PG8_LDSC(1, t); PG8_STAGE(PG8_SB(0, 0), b2, voffB); PG8_STAGE(PG8_SB(0, 1), b2 + hstepB, voffB); PG8_STAGE_A(PG8_SA(0, 0), a2, 0, last);
            PG8_WAIT_V(8); PG8_WAIT_L(0); PG8_BAR; PG8_MM(1, 0, At, B0); PG8_MM(1, 1, At, B1); PG8_BAR; PG8_SCHED;
            PG8_LDB(B0, 1, 0); PG8_LDB(B1, 1, 1); PG8_SCHED; PG8_LDA(At, 1, 0); PG8_LDSC(0, t + 1); PG8_STAGE_A(PG8_SA(0, 1), a2 + hstepA, 1, last);
            PG8_WAIT_V(8); PG8_WAIT_L(0); PG8_BAR; PG8_MM(0, 0, At, B0); PG8_MM(0, 1, At, B1); PG8_BAR; PG8_SCHED;
            PG8_LDA(At, 1, 1); PG8_LDSC(1, t + 1); PG8_STAGE(PG8_SB(1, 0), b3, voffB); PG8_STAGE(PG8_SB(1, 1), b3 + hstepB, voffB); PG8_STAGE_A(PG8_SA(1, 0), a3, 0, last);
            PG8_WAIT_V(8); PG8_WAIT_L(0); PG8_BAR; PG8_MM(1, 0, At, B0); PG8_MM(1, 1, At, B1); PG8_BAR; PG8_SCHED;
        }
        if constexpr (ALIGN_EPI) { if (wr == 0) PG8_BAR; }
        if constexpr (KQ) {
#pragma unroll
            for (int ai = 0; ai < 2; ++ai) { float ss[4] = {0.f, 0.f, 0.f, 0.f};
#pragma unroll 2
                for (int k = 0; k < 16; ++k) { const u32x2 w_ = *(const LAS u32x2*)(lds + SCQ_OFF + scbuf * 8192 + (((k * 2 + ai) * 2 + wr) * 64 + fr * 4) * 2);
                    ss[0] += (float)__builtin_bit_cast(_Float16, (unsigned short)(w_.x & 0xffffu)); ss[1] += (float)__builtin_bit_cast(_Float16, (unsigned short)(w_.x >> 16));
                    ss[2] += (float)__builtin_bit_cast(_Float16, (unsigned short)(w_.y & 0xffffu)); ss[3] += (float)__builtin_bit_cast(_Float16, (unsigned short)(w_.y >> 16)); }
#pragma unroll
                for (int m = 0; m < 4; ++m) { const float corr = 12582912.0f * ss[m];
#pragma unroll
                    for (int bj = 0; bj < 2; ++bj)
#pragma unroll
                        for (int n = 0; n < 2; ++n) acc[ai][bj][m][n] -= corr; } }
        }
        E(acc, cur, wr, wc, fr, fq, pre);
        if (!has_next) break;
#pragma unroll
        for (int a = 0; a < 2; ++a)
#pragma unroll
            for (int b = 0; b < 2; ++b)
#pragma unroll
                for (int m = 0; m < 4; ++m)
#pragma unroll
                    for (int n = 0; n < 2; ++n) acc[a][b][m][n] = (f32x4){0.f, 0.f, 0.f, 0.f};
        cur = nxt; cA = nA; cB = nB; ++ui; scbuf ^= 1;
        E.prefetch(pre, cur, wr, wc, fr, fq);
        if constexpr (GATHER) {
#pragma unroll
            for (int _h = 0; _h < 2; ++_h)
#pragma unroll
                for (int _i = 0; _i < 2; ++_i) vAc[_h][_i] = vAn[_h][_i]; }
        if constexpr (ALIGN_EPI) { if (wr == 1) PG8_BAR; }
    }
    PG8_WAIT_V(0);
    if constexpr (!ALIGN_EPI) { if (wr == 0) PG8_BAR; }
    PG8_BAR;
#undef PG8_SA
#undef PG8_SB
#undef PG8_STAGE
#undef PG8_STAGE_A
#undef PG8_GOFF
#undef PG8_LDA
#undef PG8_LDB
#undef PG8_MMA
#undef PG8_MMAQ2
#undef PG8_MFQ
#undef PG8_MM
#undef PG8_LDSC
#undef PG8_SCDMA
#undef PG8_WAIT_V
#undef PG8_WAIT_L
#undef PG8_BAR
#undef PG8_SCHED
}
}
using pg8::Unit;

constexpr size_t MiB = 1024ull * 1024ull;
constexpr size_t al256(size_t x) { return (x + 255) & ~(size_t)255; }
constexpr size_t WS_COS128 = 0;
constexpr size_t WS_SIN128 = WS_COS128 + 4 * MiB;
constexpr size_t WS_COS128T = WS_SIN128 + 4 * MiB;
constexpr size_t WS_SIN128T = WS_COS128T + 4 * MiB;
constexpr size_t WS_COS64 = WS_SIN128T + 4 * MiB;
constexpr size_t WS_SIN64 = WS_COS64 + 2 * MiB;
constexpr size_t WS_WEV_MAIN = WS_SIN64 + 2 * MiB;
constexpr size_t WS_WEV_SW = WS_WEV_MAIN + 4 * MiB;
constexpr size_t WS_WEVO = WS_WEV_SW + 2 * MiB;
constexpr size_t WS_WGLU = WS_WEVO + 2 * MiB;
constexpr size_t WS_WOD_MAIN = WS_WGLU + 1 * MiB;
constexpr size_t WS_WOD_SW = WS_WOD_MAIN + 6 * MiB;
constexpr size_t WS_WODO = WS_WOD_SW + 4 * MiB;
constexpr size_t WS_WRT = WS_WODO + 2 * MiB;
constexpr size_t WS_WGT = WS_WRT + 128 * 1024;
constexpr size_t WS_S5LAM = WS_WGT + 64 * 1024;
constexpr size_t WS_S5BBAR = WS_S5LAM + 64 * 1024;
constexpr size_t WS_S5KTAB = WS_S5BBAR + 1 * MiB;
constexpr size_t WS_RSTD = WS_S5KTAB + 4 * MiB;
constexpr size_t WS_AFF = WS_RSTD + 128 * 1024;
constexpr size_t WS_TOK = WS_AFF + 2 * MiB;
constexpr size_t WS_GATEL = WS_TOK + 256 * 1024;
constexpr size_t WS_RSTDL = WS_GATEL + 256 * 1024;
constexpr size_t WS_INV = WS_RSTDL + 256 * 1024;
constexpr size_t WS_MLG = WS_INV + 2 * MiB;
constexpr size_t WS_MLEF = WS_MLG + 2 * MiB;
constexpr size_t WS_MLDEN = WS_MLEF + 1 * MiB;
constexpr size_t WS_MLA = WS_MLDEN + 1 * MiB;
constexpr size_t WS_MLN = WS_MLA + 64 * 1024;
constexpr size_t WS_LSE = WS_MLN + 1 * MiB;
constexpr size_t WS_BAR = WS_LSE + 2 * MiB;
constexpr size_t WS_XSC = WS_BAR + 64 * 1024;
constexpr size_t WS_WSC = WS_XSC + 128 * 1024;
constexpr size_t WS_WINSC = WS_WSC + 512 * 1024;
constexpr size_t WS_ACTSC = WS_WINSC + 32 * 1024;
constexpr size_t WS_W2SC = WS_ACTSC + 2 * MiB;
constexpr size_t WS_SMALL_END = WS_W2SC + 64 * 1024;
constexpr size_t WS_XB = al256(WS_SMALL_END);
constexpr size_t WS_HBUF = WS_XB + 64 * MiB;
constexpr size_t WS_W13 = WS_HBUF + 64 * MiB;
constexpr size_t WS_W2 = WS_W13 + 128 * MiB;
constexpr size_t WS_BIG = WS_W2 + 64 * MiB;
constexpr size_t WS_END = WS_BIG + 512 * MiB;
constexpr size_t BG_AXE = WS_BIG;
constexpr size_t BG_ACT = WS_BIG + 128 * MiB;
constexpr size_t BG_YE = WS_BIG + 384 * MiB;
constexpr size_t BG_Q = WS_BIG;
constexpr size_t BG_K = BG_Q + 32 * MiB;
constexpr size_t BG_KT = BG_K + 32 * MiB;
constexpr size_t BG_VT = BG_KT + 32 * MiB;
constexpr size_t BG_G = BG_VT + 32 * MiB;
constexpr size_t BG_A2 = BG_G + 32 * MiB;
constexpr size_t BG_B2 = BG_A2 + 48 * MiB;
constexpr size_t BG_GM = BG_B2 + 24 * MiB;
constexpr size_t BG_XRAW = BG_GM + 8 * MiB;
constexpr size_t BG_OINTRA = BG_XRAW + 32 * MiB;
constexpr size_t BG_KV = BG_OINTRA + 32 * MiB;
constexpr size_t BG_YG = BG_KV + 64 * MiB;
constexpr size_t BG_AOUT = BG_YG + 32 * MiB;
static_assert(BG_AOUT + 64 * MiB <= WS_END, "even scratch");
constexpr size_t BO_CQ = WS_BIG;
constexpr size_t BO_CK = BO_CQ + 48 * MiB;
constexpr size_t BO_CVT = BO_CK + 48 * MiB;
constexpr size_t BO_MQ = BO_CVT + 48 * MiB;
constexpr size_t BO_MK = BO_MQ + 32 * MiB;
constexpr size_t BO_MO = BO_MK + 32 * MiB;
constexpr size_t BO_MKT = BO_MO + 32 * MiB;
constexpr size_t BO_MVT = BO_MKT + 32 * MiB;
constexpr size_t BO_ODIL = BO_MVT + 32 * MiB;
constexpr size_t BO_NUMF = BO_ODIL + 48 * MiB;
constexpr size_t BO_NUMB = BO_NUMF + 32 * MiB;
constexpr size_t BO_KV = BO_NUMB + 32 * MiB;
constexpr size_t BO_AOUT = BO_CQ;
static_assert(BO_KV + 64 * MiB <= WS_END, "odd scratch");

struct Args { const float* in[24]; float* out; unsigned char* ws; int ph_lo, ph_hi; };

__device__ __forceinline__ unsigned q4i8(f32x4 v, float inv) {
    const f32x4 t = v * inv + 12582912.0f;
    const unsigned p01 = __builtin_amdgcn_perm(__float_as_uint(t[1]), __float_as_uint(t[0]), 0x0c0c0400u), p23 = __builtin_amdgcn_perm(__float_as_uint(t[3]), __float_as_uint(t[2]), 0x0c0c0400u);
    return __builtin_amdgcn_perm(p23, p01, 0x05040100u);
}
__device__ __forceinline__ float amax4(f32x4 v) { return fmaxf(fmaxf(fabsf(v[0]), fabsf(v[1])), fmaxf(fabsf(v[2]), fabsf(v[3]))); }
__device__ __forceinline__ float wave_max(float v) {
#pragma unroll
    for (int o = 1; o < 64; o <<= 1) v = fmaxf(v, __shfl_xor(v, o));
    return v;
}
typedef f32x4 (&AccT)[2][2][4][2];
#define EPI_NOPRE struct Pre {}; __device__ __forceinline__ void prefetch(Pre&, const Unit&, int, int, int, int) const {}
__device__ __forceinline__ void st4bf(bf16_t* p, f32x4 v) { u32x2 w; w.x = pk2(v[0], v[1]); w.y = pk2(v[2], v[3]); *(u32x2*)p = w; }
__device__ __forceinline__ f32x4 ld4bf(const bf16_t* p) { const u32x2 w = *(const u32x2*)p; return (f32x4){lo_bf(w.x), hi_bf(w.x), lo_bf(w.y), hi_bf(w.y)}; }
__device__ __forceinline__ void st_bf16x8(bf16_t* p, f32x4 a, f32x4 b) {
    u32x4 w; w.x = pk2(a[0], a[1]); w.y = pk2(a[2], a[3]); w.z = pk2(b[0], b[1]); w.w = pk2(b[2], b[3]); *(u32x4*)p = w;
}

__device__ __forceinline__ void st_t8(bf16_t* dst, size_t ld, int f0, size_t col, f32x4 a, f32x4 b) {
    const unsigned w0 = pk2(a[0], a[1]), w1 = pk2(a[2], a[3]), w2 = pk2(b[0], b[1]), w3 = pk2(b[2], b[3]);
    bf16_t* p = dst + (size_t)f0 * ld + col;
    p[0] = (bf16_t)(w0 & 0xffffu); p[ld] = (bf16_t)(w0 >> 16); p[2 * ld] = (bf16_t)(w1 & 0xffffu); p[3 * ld] = (bf16_t)(w1 >> 16);
    p[4 * ld] = (bf16_t)(w2 & 0xffffu); p[5 * ld] = (bf16_t)(w2 >> 16); p[6 * ld] = (bf16_t)(w3 & 0xffffu); p[7 * ld] = (bf16_t)(w3 >> 16);
}
constexpr int TSCR_OFF = 131072, TSCR_WAVE = 32 * 24 * 2;
__device__ __forceinline__ void tstage(LAS bf16_t* scr, int fq, int tslot, f32x4 a, f32x4 b) {
    const unsigned w0 = pk2(a[0], a[1]), w1 = pk2(a[2], a[3]), w2 = pk2(b[0], b[1]), w3 = pk2(b[2], b[3]);
    LAS bf16_t* p = scr + (8 * fq) * 24 + tslot;
    p[0] = (bf16_t)(w0 & 0xffffu); p[24] = (bf16_t)(w0 >> 16); p[48] = (bf16_t)(w1 & 0xffffu); p[72] = (bf16_t)(w1 >> 16);
    p[96] = (bf16_t)(w2 & 0xffffu); p[120] = (bf16_t)(w2 >> 16); p[144] = (bf16_t)(w3 & 0xffffu); p[168] = (bf16_t)(w3 >> 16);
}
__device__ __forceinline__ void tdrain16(LAS bf16_t* scr, int lane, bf16_t* dst, size_t ld, int fbase, size_t col0) {
    LDS_WAIT();
    const u32x4 v = *(const LAS u32x4*)(scr + (lane >> 1) * 24 + 8 * (lane & 1));
    *(u32x4*)(dst + (size_t)(fbase + (lane >> 1)) * ld + col0 + 8 * (lane & 1)) = v;
    LDS_WAIT();
}
__device__ __forceinline__ void dequant_acc(AccT acc, const float* rs, const float* cs) {
    f32x4 c[2][2];
#pragma unroll
    for (int bj = 0; bj < 2; ++bj)
#pragma unroll
        for (int n = 0; n < 2; ++n) c[bj][n] = *(const f32x4*)(cs + bj * 128 + n * 4);
#pragma unroll
    for (int ai = 0; ai < 2; ++ai)
#pragma unroll
        for (int m = 0; m < 4; ++m) { const float r = rs[ai * 128 + m * 16];
#pragma unroll
            for (int bj = 0; bj < 2; ++bj)
#pragma unroll
                for (int n = 0; n < 2; ++n)
#pragma unroll
                    for (int j = 0; j < 4; ++j) acc[ai][bj][m][n][j] = (float)__float_as_int(acc[ai][bj][m][n][j]) * (r * c[bj][n][j]); }
}
struct EpiEvenMain {
    static constexpr bool PERM = true; EPI_NOPRE
    bf16_t *q, *k, *g, *a2, *kT, *vT; const float *cosT, *sinT; LAS unsigned char* lds; const float *rsc, *csc;
    __device__ __forceinline__ void operator()(AccT acc, const Unit& u, int wr, int wc, int fr, int fq, const Pre& pre) const {
        const int pn = u.pn, cc0 = wc * 32 + fq * 8;
        dequant_acc(acc, rsc + u.pm * 256 + wr * 64 + fr, csc + pn * 256 + cc0);
        if (pn < 4) {
            bf16_t* dst = (pn < 2) ? q : k; const float sc = (pn < 2) ? 1.0f : 0.08838834764831845f;
            const int head = 2 * (pn & 1) + (cc0 >> 6), i0 = cc0 & 63;
#pragma unroll
            for (int ai = 0; ai < 2; ++ai)
#pragma unroll
                for (int m = 0; m < 4; ++m) {
                    const int t = u.pm * 256 + ai * 128 + wr * 64 + m * 16 + fr, pos = t & (SEQ - 1);
                    const f32x4 c0 = *(const f32x4*)(cosT + pos * 64 + i0), c1 = *(const f32x4*)(cosT + pos * 64 + i0 + 4);
                    const f32x4 s0 = *(const f32x4*)(sinT + pos * 64 + i0), s1 = *(const f32x4*)(sinT + pos * 64 + i0 + 4);
                    const f32x4 x10 = acc[ai][0][m][0], x11 = acc[ai][0][m][1], x20 = acc[ai][1][m][0], x21 = acc[ai][1][m][1];
                    const f32x4 a0 = (x10 * c0 - x20 * s0) * sc, a1 = (x11 * c1 - x21 * s1) * sc, b0 = (x10 * s0 + x20 * c0) * sc, b1 = (x11 * s1 + x21 * c1) * sc;
                    bf16_t* o = dst + (size_t)t * 512 + head * 128 + i0;
                    st_bf16x8(o, a0, a1); st_bf16x8(o + 64, b0, b1);
                    if (pn >= 2) { LAS bf16_t* scr = (LAS bf16_t*)(lds + TSCR_OFF + (wr * 4 + wc) * TSCR_WAVE); const int lane = fq * 16 + fr; const size_t tb = (size_t)(t - fr);
                        const int fb = (2 * (pn & 1) + (wc >> 1)) * 128 + ((wc & 1) * 32);
                        tstage(scr, fq, fr, a0, a1); tdrain16(scr, lane, kT, T, fb, tb);
                        tstage(scr, fq, fr, b0, b1); tdrain16(scr, lane, kT, T, fb + 64, tb); }
                }
        } else if (pn < 6) {
#pragma unroll
            for (int ai = 0; ai < 2; ++ai)
#pragma unroll
                for (int m = 0; m < 4; ++m) {
                    const int t = u.pm * 256 + ai * 128 + wr * 64 + m * 16 + fr;
#pragma unroll
                    for (int bj = 0; bj < 2; ++bj) st_bf16x8(g + (size_t)t * 512 + (pn - 4) * 256 + bj * 128 + cc0, acc[ai][bj][m][0], acc[ai][bj][m][1]);
                }
        } else if (pn < 8) {
#pragma unroll
            for (int ai = 0; ai < 2; ++ai)
#pragma unroll
                for (int m = 0; m < 4; ++m) {
                    const int t = u.pm * 256 + ai * 128 + wr * 64 + m * 16 + fr, mrow = t >> 5, i = t & 31;
#pragma unroll
                    for (int bj = 0; bj < 2; ++bj) { const int ch0 = (pn - 6) * 256 + bj * 128 + cc0, grp = ch0 >> 4, co0 = ch0 & 15;
                        st_bf16x8(a2 + ((size_t)(grp * 1024 + mrow) * 768 + i * 16 + co0), acc[ai][bj][m][0], acc[ai][bj][m][1]); }
                }
        } else {
#pragma unroll
            for (int ai = 0; ai < 2; ++ai)
#pragma unroll
                for (int m = 0; m < 4; ++m) {
                    const int t = u.pm * 256 + ai * 128 + wr * 64 + m * 16 + fr;
#pragma unroll
                    for (int bj = 0; bj < 2; ++bj) { LAS bf16_t* scr = (LAS bf16_t*)(lds + TSCR_OFF + (wr * 4 + wc) * TSCR_WAVE);
                        tstage(scr, fq, fr, acc[ai][bj][m][0], acc[ai][bj][m][1]); tdrain16(scr, fq * 16 + fr, vT, T, (pn - 8) * 256 + bj * 128 + wc * 32, (size_t)(t - fr)); }
                }
        }
    }
};
struct EpiS5A {
    static constexpr bool PERM = false; EPI_NOPRE
    float* xraw;
    __device__ __forceinline__ void operator()(AccT acc, const Unit& u, int wr, int wc, int fr, int fq, const Pre& pre) const {
#pragma unroll
        for (int ai = 0; ai < 2; ++ai)
#pragma unroll
            for (int m = 0; m < 4; ++m) { float* rowp = xraw + (size_t)(u.pm * 256 + ai * 128 + wr * 64 + m * 16 + fr) * 256 + wc * 32 + 4 * fq;
#pragma unroll
                for (int bj = 0; bj < 2; ++bj)
#pragma unroll
                    for (int n = 0; n < 2; ++n) *(f32x4*)(rowp + bj * 128 + n * 16) = acc[ai][bj][m][n]; }
    }
};
struct EpiS5B {
    static constexpr bool PERM = true; EPI_NOPRE
    const bf16_t* a2; const float* dskip; bf16_t* yg;
    __device__ __forceinline__ void operator()(AccT acc, const Unit& u, int wr, int wc, int fr, int fq, const Pre& pre) const {
        const int grp = u.pn >> 1, pnl = u.pn & 1, cc0 = wc * 32 + fq * 8;
#pragma unroll
        for (int ai = 0; ai < 2; ++ai)
#pragma unroll
            for (int m = 0; m < 4; ++m) {
                const int row = u.pm * 256 + ai * 128 + wr * 64 + m * 16 + fr, mr = row & 1023;
#pragma unroll
                for (int bj = 0; bj < 2; ++bj) {
                    const int col = pnl * 256 + bj * 128 + cc0, i = col >> 4, co0 = col & 15;
                    const int t = (mr >> 9) * SEQ + (mr & 511) * 32 + i, ch = grp * 16 + co0;
                    const u32x4 uw = *(const u32x4*)(a2 + (size_t)row * 768 + col);
                    const f32x4 d0 = *(const f32x4*)(dskip + ch), d1 = *(const f32x4*)(dskip + ch + 4);
                    f32x4 y0 = acc[ai][bj][m][0], y1 = acc[ai][bj][m][1];
                    y0[0] += d0[0] * lo_bf(uw.x); y0[1] += d0[1] * hi_bf(uw.x); y0[2] += d0[2] * lo_bf(uw.y); y0[3] += d0[3] * hi_bf(uw.y);
                    y1[0] += d1[0] * lo_bf(uw.z); y1[1] += d1[1] * hi_bf(uw.z); y1[2] += d1[2] * lo_bf(uw.w); y1[3] += d1[3] * hi_bf(uw.w);
#pragma unroll
                    for (int j = 0; j < 4; ++j) { y0[j] = gelu_tanh(y0[j]); y1[j] = gelu_tanh(y1[j]); }
                    st_bf16x8(yg + (size_t)t * 512 + ch, y0, y1);
                }
            }
    }
};
struct EpiGlu {
    static constexpr bool PERM = true; EPI_NOPRE
    const bf16_t* yg; const float* bias; bf16_t* aout;
    __device__ __forceinline__ void operator()(AccT acc, const Unit& u, int wr, int wc, int fr, int fq, const Pre& pre) const {
        const int cc0 = wc * 32 + fq * 8;
#pragma unroll
        for (int ai = 0; ai < 2; ++ai)
#pragma unroll
            for (int m = 0; m < 4; ++m) {
                const int t = u.pm * 256 + ai * 128 + wr * 64 + m * 16 + fr;
#pragma unroll
                for (int bj = 0; bj < 2; ++bj) {
                    const int c = u.pn * 256 + bj * 128 + cc0;
                    const u32x4 yw = *(const u32x4*)(yg + (size_t)t * 512 + c);
                    const f32x4 b0 = *(const f32x4*)(bias + c), b1 = *(const f32x4*)(bias + c + 4);
                    const f32x4 z0 = acc[ai][bj][m][0] + b0, z1 = acc[ai][bj][m][1] + b1;
                    f32x4 o0, o1;
                    o0[0] = lo_bf(yw.x) * sigmoidf_(z0[0]); o0[1] = hi_bf(yw.x) * sigmoidf_(z0[1]); o0[2] = lo_bf(yw.y) * sigmoidf_(z0[2]); o0[3] = hi_bf(yw.y) * sigmoidf_(z0[3]);
                    o1[0] = lo_bf(yw.z) * sigmoidf_(z1[0]); o1[1] = hi_bf(yw.z) * sigmoidf_(z1[1]); o1[2] = lo_bf(yw.w) * sigmoidf_(z1[2]); o1[3] = hi_bf(yw.w) * sigmoidf_(z1[3]);
                    st_bf16x8(aout + (size_t)t * 1024 + 512 + c, o0, o1);
                }
            }
    }
};
template <bool XIN_BF16> struct EpiResid {
    static constexpr bool PERM = true; EPI_NOPRE
    const float* xin32; bf16_t* xb;
    __device__ __forceinline__ void operator()(AccT acc, const Unit& u, int wr, int wc, int fr, int fq, const Pre& pre) const {
        const int c0 = u.pn * 256 + wc * 32 + 8 * fq;
#pragma unroll
        for (int ai = 0; ai < 2; ++ai)
#pragma unroll
            for (int m = 0; m < 4; ++m) { const size_t off = (size_t)(u.pm * 256 + ai * 128 + wr * 64 + m * 16 + fr) * 1024 + c0;
#pragma unroll
                for (int bj = 0; bj < 2; ++bj) { f32x4 x0, x1;
                    if (XIN_BF16) { const u32x4 w = *(const u32x4*)(xb + off + bj * 128); x0 = (f32x4){lo_bf(w.x), hi_bf(w.x), lo_bf(w.y), hi_bf(w.y)}; x1 = (f32x4){lo_bf(w.z), hi_bf(w.z), lo_bf(w.w), hi_bf(w.w)}; }
                    else { x0 = __builtin_nontemporal_load((const f32x4*)(xin32 + off + bj * 128)); x1 = __builtin_nontemporal_load((const f32x4*)(xin32 + off + bj * 128 + 4)); }
                    st_bf16x8(xb + off + bj * 128, x0 + acc[ai][bj][m][0], x1 + acc[ai][bj][m][1]); }
                asm volatile("" ::: "memory"); }
    }
};
struct EpiOddMain {
    static constexpr bool PERM = true; EPI_NOPRE
    unsigned char* ws; const float *cosT, *sinT; LAS unsigned char* lds; const float *rsc, *csc;
    __device__ __forceinline__ void operator()(AccT acc, const Unit& u, int wr, int wc, int fr, int fq, const Pre& pre) const {
        asm volatile("" : "+v"(fr), "+v"(fq));
        const int pn = u.pn, cc0 = wc * 32 + fq * 8;
        dequant_acc(acc, rsc + u.pm * 256 + wr * 64 + fr, csc + pn * 256 + cc0);
        if (pn < 6) {
            bf16_t* dst = (bf16_t*)(ws + (pn < 3 ? BO_CQ : BO_CK)); const int grp = pn < 3 ? pn : pn - 3, sh = 2 * grp, hh = wc, i0 = fq * 8;
#pragma unroll
            for (int ai = 0; ai < 2; ++ai)
#pragma unroll
                for (int m = 0; m < 4; ++m) {
                    const int t = u.pm * 256 + ai * 128 + wr * 64 + m * 16 + fr, pos = t & (SEQ - 1), b = t >> 14;
                    const int pp = (pos & ((1 << sh) - 1)) * (SEQ >> sh) + (pos >> sh);
                    const f32x4 c0 = *(const f32x4*)(cosT + pos * 32 + i0), c1 = *(const f32x4*)(cosT + pos * 32 + i0 + 4);
                    const f32x4 s0 = *(const f32x4*)(sinT + pos * 32 + i0), s1 = *(const f32x4*)(sinT + pos * 32 + i0 + 4);
                    const f32x4 x10 = acc[ai][0][m][0], x11 = acc[ai][0][m][1], x20 = acc[ai][1][m][0], x21 = acc[ai][1][m][1];
                    bf16_t* o = dst + ((size_t)(grp * 4 + hh) * T + b * SEQ + pp) * 64 + i0;
                    st_bf16x8(o, x10 * c0 - x20 * s0, x11 * c1 - x21 * s1);
                    st_bf16x8(o + 32, x10 * s0 + x20 * c0, x11 * s1 + x21 * c1);
                }
        } else if (pn < 12) {
            const size_t boff = (pn < 8) ? BO_MQ : (pn < 10 ? BO_MK : BO_MO);
            bf16_t* dst = (bf16_t*)(ws + boff); bf16_t* mkT = (bf16_t*)(ws + BO_MKT); const bool isk = (pn >= 8 && pn < 10); const float sc = isk ? 0.08838834764831845f : 1.0f;
            const int cb = (pn & 1) * 256;
#pragma unroll
            for (int ai = 0; ai < 2; ++ai)
#pragma unroll
                for (int m = 0; m < 4; ++m) {
                    const int t = u.pm * 256 + ai * 128 + wr * 64 + m * 16 + fr;
#pragma unroll
                    for (int bj = 0; bj < 2; ++bj) { const f32x4 v0 = acc[ai][bj][m][0] * sc, v1 = acc[ai][bj][m][1] * sc;
                        st_bf16x8(dst + (size_t)t * 512 + cb + bj * 128 + cc0, v0, v1);
                        if (isk) { LAS bf16_t* scr = (LAS bf16_t*)(lds + TSCR_OFF + (wr * 4 + wc) * TSCR_WAVE); tstage(scr, fq, fr, v0, v1); tdrain16(scr, fq * 16 + fr, mkT, T, cb + bj * 128 + wc * 32, (size_t)(t - fr)); } }
                }
        } else if (pn < 14) {
            bf16_t* mvT = (bf16_t*)(ws + BO_MVT); const int cb = (pn - 12) * 256;
#pragma unroll
            for (int ai = 0; ai < 2; ++ai)
#pragma unroll
                for (int m = 0; m < 4; ++m) {
                    const int t = u.pm * 256 + ai * 128 + wr * 64 + m * 16 + fr;
#pragma unroll
                    for (int bj = 0; bj < 2; ++bj) { LAS bf16_t* scr = (LAS bf16_t*)(lds + TSCR_OFF + (wr * 4 + wc) * TSCR_WAVE);
                        tstage(scr, fq, fr, acc[ai][bj][m][0], acc[ai][bj][m][1]); tdrain16(scr, fq * 16 + fr, mvT, T, cb + bj * 128 + wc * 32, (size_t)(t - fr)); }
                }
        } else {
            bf16_t* cvT = (bf16_t*)(ws + BO_CVT); const int grp = pn - 14, sh = 2 * grp;
#pragma unroll
            for (int ai = 0; ai < 2; ++ai)
#pragma unroll
                for (int m = 0; m < 4; ++m) {
                    const int t = u.pm * 256 + ai * 128 + wr * 64 + m * 16 + fr, pos = t & (SEQ - 1), b = t >> 14;
                    const int pp = (pos & ((1 << sh) - 1)) * (SEQ >> sh) + (pos >> sh);
#pragma unroll
                    for (int bj = 0; bj < 2; ++bj) {
                        if (grp == 2) st_t8(cvT, T, grp * 256 + bj * 128 + cc0, (size_t)b * SEQ + pp, acc[ai][bj][m][0], acc[ai][bj][m][1]);
                        else { LAS bf16_t* scr = (LAS bf16_t*)(lds + TSCR_OFF + (wr * 4 + wc) * TSCR_WAVE); const int lane = fq * 16 + fr, fb = grp * 256 + bj * 128 + wc * 32, pos0 = pos - fr;
                            if (grp == 0) { tstage(scr, fq, fr, acc[ai][bj][m][0], acc[ai][bj][m][1]); tdrain16(scr, lane, cvT, T, fb, (size_t)b * SEQ + pos0); }
                            else { tstage(scr, fq, (fr & 3) * 4 + (fr >> 2), acc[ai][bj][m][0], acc[ai][bj][m][1]); LDS_WAIT();
                                const u32x4 v = *(const LAS u32x4*)(scr + (lane >> 1) * 24 + 8 * (lane & 1)); bf16_t* rowp = cvT + (size_t)(fb + (lane >> 1)) * T + (size_t)b * SEQ + (pos0 >> 2);
                                *(u32x2*)(rowp + (size_t)(2 * (lane & 1)) * (SEQ >> 2)) = (u32x2){v.x, v.y}; *(u32x2*)(rowp + (size_t)(2 * (lane & 1) + 1) * (SEQ >> 2)) = (u32x2){v.z, v.w}; LDS_WAIT(); } } }
                }
        }
    }
};
constexpr int RED_OFF = 131072;
struct EpiMoe1 {
    static constexpr bool PERM = true;
    signed char* actq; unsigned short* actsc; const float* rowf; const float* wsc; LAS unsigned char* lds;
    struct Pre { float rs[2][4]; };
    __device__ __forceinline__ void prefetch(Pre& p, const Unit& u, int wr, int wc, int fr, int fq) const {
#pragma unroll
        for (int ai = 0; ai < 2; ++ai)
#pragma unroll
            for (int m = 0; m < 4; ++m) p.rs[ai][m] = rowf[u.pm * 256 + ai * 128 + wr * 64 + m * 16 + fr];
    }
    __device__ __forceinline__ void operator()(AccT acc, const Unit& u, int wr, int wc, int fr, int fq, const Pre& pre) const {
        asm volatile("" : "+v"(fr), "+v"(fq));
        const int kb = u.pn & 15;
        const float* w = wsc + (size_t)u.pn * 256 + wc * 32 + fq * 8;
        f32x4 wa[2], wg[2]; wa[0] = *(const f32x4*)w; wa[1] = *(const f32x4*)(w + 4); wg[0] = *(const f32x4*)(w + 128); wg[1] = *(const f32x4*)(w + 132);
        LAS float* red = (LAS float*)(lds + RED_OFF);
#pragma unroll
        for (int ai = 0; ai < 2; ++ai)
#pragma unroll
            for (int m = 0; m < 4; ++m) {
                const float rs = pre.rs[ai][m]; f32x4 o0, o1; float mm = 0.f;
#pragma unroll
                for (int j = 0; j < 4; ++j) {
                    const float a0 = (float)__float_as_int(acc[ai][0][m][0][j]) * (rs * wa[0][j]), g0 = (float)__float_as_int(acc[ai][1][m][0][j]) * (rs * wg[0][j]);
                    const float a1 = (float)__float_as_int(acc[ai][0][m][1][j]) * (rs * wa[1][j]), g1 = (float)__float_as_int(acc[ai][1][m][1][j]) * (rs * wg[1][j]);
                    o0[j] = a0 * g0 * __builtin_amdgcn_rcpf(1.0f + __builtin_amdgcn_exp2f(-a0)); o1[j] = a1 * g1 * __builtin_amdgcn_rcpf(1.0f + __builtin_amdgcn_exp2f(-a1)); mm = fmaxf(mm, fmaxf(fabsf(o0[j]), fabsf(o1[j]))); }
                acc[ai][0][m][0] = o0; acc[ai][0][m][1] = o1;
                mm = fmaxf(mm, __shfl_xor(mm, 16)); mm = fmaxf(mm, __shfl_xor(mm, 32));
                if (fq == 0) red[(ai * 128 + wr * 64 + m * 16 + fr) * 4 + wc] = mm;
            }
        LDS_WAIT(); __builtin_amdgcn_s_barrier();
        unsigned short shb[4];
#pragma unroll
        for (int ai = 0; ai < 2; ++ai)
#pragma unroll
            for (int m = 0; m < 4; ++m) {
                const int rl = ai * 128 + wr * 64 + m * 16 + fr; const size_t row = (size_t)u.pm * 256 + rl;
                const f32x4 r4 = *(const LAS f32x4*)(red + rl * 4);
                const _Float16 sh = (_Float16)(fmaxf(fmaxf(r4[0], r4[1]), fmaxf(r4[2], r4[3])) * (1.0f / 127.0f)); const float sf = (float)sh, inv = sf > 0.f ? __builtin_amdgcn_rcpf(sf) : 0.f;
                u32x2 q; q.x = q4i8(acc[ai][0][m][0], inv); q.y = q4i8(acc[ai][0][m][1], inv);
                *(u32x2*)(actq + row * FF + kb * 128 + wc * 32 + fq * 8) = q;
                shb[m] = __builtin_bit_cast(unsigned short, sh);
                if (m == 3 && wc == 0 && fq == 0)
                    *(u32x2*)(actsc + (size_t)u.pm * 4096 + (((kb * 2 + ai) * 2 + wr) * 64 + fr * 4)) = (u32x2){(unsigned)shb[0] | ((unsigned)shb[1] << 16), (unsigned)shb[2] | ((unsigned)shb[3] << 16)};
            }
    }
};
struct EpiMoe2 {
    static constexpr bool PERM = true;
    bf16_t* ye; const float* gate; const float* w2sc;
    EPI_NOPRE
    __device__ __forceinline__ void operator()(AccT acc, const Unit& u, int wr, int wc, int fr, int fq, const Pre& pre) const {
        asm volatile("" : "+v"(fr), "+v"(fq));
        const int c0 = (u.pn & 3) * 256 + wc * 32 + fq * 8;
        const float* cs = w2sc + (size_t)u.pn * 256 + wc * 32 + fq * 8; f32x4 c[2][2];
#pragma unroll
        for (int bj = 0; bj < 2; ++bj) { c[bj][0] = *(const f32x4*)(cs + bj * 128); c[bj][1] = *(const f32x4*)(cs + bj * 128 + 4); }
#pragma unroll
        for (int ai = 0; ai < 2; ++ai)
#pragma unroll
            for (int m = 0; m < 4; ++m) {
                const int row = u.pm * 256 + ai * 128 + wr * 64 + m * 16 + fr; const float gt = gate[row];
#pragma unroll
                for (int bj = 0; bj < 2; ++bj) st_bf16x8(ye + (size_t)row * DM + c0 + bj * 128, acc[ai][bj][m][0] * (c[bj][0] * gt), acc[ai][bj][m][1] * (c[bj][1] * gt));
            }
    }
};

typedef const __attribute__((address_space(4))) void* KargP;
template <int OFF> __device__ __forceinline__ const GAS float* ldarg_ptr(KargP kp) { unsigned long long v; asm volatile("s_load_dwordx2 %0, %1, %2\n\ts_waitcnt lgkmcnt(0)" : "=s"(v) : "s"(kp), "n"(OFF)); return (const GAS float*)v; }
struct Ctx { KargP kp; GAS float* out; GAS unsigned char* ws; LAS unsigned char* lds; int tid, lane, wave, bid, G; };
#define INP(i) ((const float*)ldarg_ptr<8 * (i)>(C.kp))
#define WSP(T_, off) ((T_*)(C.ws + (off)))

constexpr int TR_SCR = 64 * 65 * 4;
__device__ __forceinline__ void tr_item(const float* W, int ldw, int colA, int colB, bf16_t* WT, int ldt, size_t row0, int k0, LAS float* scr, int lane, const float* kscale = nullptr) {
    const float* src = W + (size_t)k0 * ldw + (lane < 32 ? colA : colB) + (lane & 31);
#pragma unroll
    for (int hb = 0; hb < 2; ++hb) {
        float v[32];
#pragma unroll
        for (int i = 0; i < 32; ++i) v[i] = __builtin_nontemporal_load(src + (size_t)(hb * 32 + i) * ldw);
#pragma unroll
        for (int i = 0; i < 32; ++i) scr[(hb * 32 + i) * 65 + lane] = kscale ? v[i] * kscale[k0 + hb * 32 + i] : v[i];
    }
    LDS_WAIT();
    const int c = lane & 7;
#pragma unroll
    for (int j = 0; j < 8; ++j) { const int n = (lane >> 3) + 8 * j; const LAS float* s = scr + (8 * c) * 65 + n;
        u32x4 o; o.x = pk2(s[0 * 65], s[1 * 65]); o.y = pk2(s[2 * 65], s[3 * 65]); o.z = pk2(s[4 * 65], s[5 * 65]); o.w = pk2(s[6 * 65], s[7 * 65]);
        __builtin_nontemporal_store(o, (u32x4*)(WT + (row0 + n) * ldt + k0 + 8 * c)); }
    LDS_WAIT();
}
__device__ __forceinline__ int col_ev_main(int rg) { const int tile = rg >> 3, w = rg & 7;
    if (tile < 4) { const int base = (tile < 2 ? 0 : 512) + (tile & 1) * 256; return base + ((w & 3) >> 1) * 128 + (w >> 2) * 64 + (w & 1) * 32; }
    if (tile < 6) return 1536 + (tile - 4) * 256 + w * 32;
    if (tile < 8) return 2048 + (tile - 6) * 256 + w * 32;
    return 1024 + (tile - 8) * 256 + w * 32; }
__device__ __forceinline__ int col_od_main(int rg) { const int tile = rg >> 3, w = rg & 7;
    if (tile < 6) { const int base = (tile < 3 ? 0 : 768), g = tile % 3; return base + g * 256 + (w & 3) * 64 + (w >> 2) * 32; }
    if (tile < 8) return 2304 + (tile - 6) * 256 + w * 32;
    if (tile < 10) return 2816 + (tile - 8) * 256 + w * 32;
    if (tile < 12) return 3840 + (tile - 10) * 256 + w * 32;
    if (tile < 14) return 3328 + (tile - 12) * 256 + w * 32;
    return 1536 + (tile - 14) * 256 + w * 32; }

__device__ __forceinline__ void conv_small_weights(const Ctx& C) {
    LAS float* scr = (LAS float*)(C.lds + C.wave * TR_SCR);
    const int gw = C.bid * NWAVES + C.wave, NGW = C.G * NWAVES;
    constexpr int I0 = 0, I1 = 0, I2 = 16 * 16, I3 = 8 * 8, I4 = 0, I5 = 0, I6 = 16 * 12;
    constexpr int NI = I0 + I1 + I2 + I3 + I4 + I5 + I6;
    const float *p5 = INP(5), *p14 = INP(14), *p17 = INP(17);
    for (int it = gw; it < NI; it += NGW) {
        int r = it;
        if (r < I2) { const int rp = r >> 4, kb = r & 15; tr_item(p5, 1024, rp * 64, rp * 64 + 32, WSP(bf16_t, WS_WEVO), 1024, (size_t)rp * 64, kb * 64, scr, C.lane); continue; } r -= I2;
        if (r < I3) { const int rp = r >> 3, kb = r & 7; tr_item(p14, 512, rp * 64, rp * 64 + 32, WSP(bf16_t, WS_WGLU), 512, (size_t)rp * 64, kb * 64, scr, C.lane); continue; } r -= I3;
        { const int rp = r / 12, kb = r % 12; tr_item(p17, 1024, rp * 64, rp * 64 + 32, WSP(bf16_t, WS_WODO), 768, (size_t)rp * 64, kb * 64, scr, C.lane); }
    }
}
constexpr int CONV_BLK_ITEMS = 1536;
template <bool GK, int NCOL = 64>
__device__ __forceinline__ void wq_block_core(const Ctx& C, const float* src, size_t ldw, const float* gk, signed char* dst, float* sc, float scmul = 1.0f) {
    const int kb = C.tid / NCOL, cl = C.tid & (NCOL - 1);
    LAS float* red = (LAS float*)C.lds;
    float v[128]; float mx = 0.f;
#pragma unroll
    for (int bt = 0; bt < 4; ++bt) {
#pragma unroll
        for (int i = 0; i < 32; ++i) v[bt * 32 + i] = __builtin_nontemporal_load(src + (size_t)(bt * 32 + i) * ldw);
#pragma unroll
        for (int i = 0; i < 32; ++i) { if (GK) v[bt * 32 + i] *= gk[bt * 32 + i]; mx = fmaxf(mx, fabsf(v[bt * 32 + i])); }
    }
    __syncthreads();
    red[kb * NCOL + cl] = mx;
    __syncthreads();
    float cm = 0.f;
#pragma unroll
    for (int k = 0; k < 512 / NCOL; ++k) cm = fmaxf(cm, red[k * NCOL + cl]);
    const float inv = cm > 0.f ? 127.0f / cm : 0.f;
    if (kb == 0) *sc = cm * (1.0f / 127.0f) * scmul;
#pragma unroll
    for (int c = 0; c < 8; ++c) { u32x4 w;
#pragma unroll
        for (int d = 0; d < 4; ++d) { const int b0 = c * 16 + d * 4; w[d] = q4i8((f32x4){v[b0], v[b0 + 1], v[b0 + 2], v[b0 + 3]}, inv); }
        *(u32x4*)(dst + c * 16) = w; }
}
__device__ __forceinline__ void w13q_block_item(const Ctx& C, int layer, int it) {
    const int e = it >> 6, half = (it >> 5) & 1, cg = it & 31, col = cg * 64 + (C.tid & 63), kb = C.tid >> 6;
    const float* src = (half ? INP(22) : INP(21)) + (size_t)layer * NE * DM * FF + (size_t)e * DM * FF + (size_t)(kb * 128) * FF + col;
    const float* gk = INP(2) + layer * DM + kb * 128;
    const int nrow = (col >> 7) * 256 + half * 128 + (col & 127);
    wq_block_core<true>(C, src, FF, gk, (signed char*)(C.ws + WS_W13) + (size_t)layer * (64 * MiB) + ((size_t)e * 4096 + nrow) * 1024 + kb * 128,
                        WSP(float, WS_WSC) + (size_t)(layer * 16 + e) * 4096 + nrow, half ? 0.6931471805599453f : 1.4426950408889634f);
}
constexpr int WIN_BLK_ITEMS = 108;
__device__ __forceinline__ void winq_block_item(const Ctx& C, int it) {
    const bool od = it >= 40; const int rp = od ? it - 40 : it, cl = C.tid & 63, kb = C.tid >> 6;
    const int rg = 2 * rp + (cl >> 5), colg = od ? col_od_main(rg) : col_ev_main(rg); const size_t ldw = od ? 4368 : 2560;
    const float* src = (od ? INP(16) : INP(4)) + (size_t)(kb * 128) * ldw + colg + (cl & 31);
    const int row = rp * 64 + cl;
    wq_block_core<false>(C, src, ldw, nullptr, (signed char*)(C.ws + (od ? WS_WOD_MAIN : WS_WEV_MAIN)) + (size_t)row * 1024 + kb * 128, WSP(float, WS_WINSC) + (od ? 2560 : 0) + row);
}
__device__ __forceinline__ void w2q_block_item(const Ctx& C, int layer, int it) {
    const int e = it >> 5, cgp = it & 31, n = cgp * 32 + (C.tid & 31), kb = C.tid >> 5;
    const float* src = INP(23) + (size_t)layer * NE * FF * DM + (size_t)e * FF * DM + (size_t)(kb * 128) * DM + n;
    wq_block_core<false, 32>(C, src, DM, nullptr, (signed char*)(C.ws + WS_W2) + ((size_t)e * 1024 + n) * 2048 + kb * 128, WSP(float, WS_W2SC) + e * 1024 + n);
}
__device__ __forceinline__ void conv_moe_weights(const Ctx& C, int layer, int it_lo, int it_hi, int blk_lo) {
    if (C.bid < blk_lo) return;
    for (int it = it_lo + (C.bid - blk_lo); it < it_hi; it += C.G - blk_lo) {
        if (it < 1024) w13q_block_item(C, layer, it);
        else w2q_block_item(C, layer, it - 1024);
    }
    __syncthreads();
}
__device__ __forceinline__ void prep_tables(const Ctx& C) {
    const int gt = C.bid * NTHREADS + C.tid, NGT = C.G * NTHREADS;
    float *c128 = WSP(float, WS_COS128), *s128 = WSP(float, WS_SIN128), *c64 = WSP(float, WS_COS64), *s64 = WSP(float, WS_SIN64);
    for (int idx = gt; idx < SEQ * 64; idx += NGT) {
        const int pos = idx >> 6, i = idx & 63;
        double inv = 1.0; for (int k = 0; k < i; ++k) inv *= 0.8659643233600653;
        const float ang = (float)pos * (float)inv; float s, c; sincos_d((double)ang, s, c);
        c128[idx] = c; s128[idx] = s;
        if (i < 32) { double inv2 = 1.0; for (int k = 0; k < i; ++k) inv2 *= 0.7498942093324559;
            const float ang2 = (float)pos * (float)inv2; sincos_d((double)ang2, s, c); c64[pos * 32 + i] = c; s64[pos * 32 + i] = s; }
    }
    float* wrt = WSP(float, WS_WRT); float* wgt = WSP(float, WS_WGT);
    const float *p1 = INP(1), *p2 = INP(2), *p16 = INP(16), *p20 = INP(20), *p6 = INP(6), *p7 = INP(7), *p8 = INP(8), *p9 = INP(9), *p12 = INP(12);
    for (int idx = gt; idx < 2 * 16 * 1024; idx += NGT) { const int l = idx >> 14, e = (idx >> 10) & 15, k = idx & 1023; wrt[idx] = p2[l * 1024 + k] * p20[(size_t)l * 1024 * 16 + k * 16 + e]; }
    for (int idx = gt; idx < 16 * 1024; idx += NGT) { const int c = idx >> 10, k = idx & 1023; wgt[idx] = p1[1024 + k] * p16[(size_t)k * 4368 + 4352 + c]; }
    float* lam = WSP(float, WS_S5LAM); float* bbar = WSP(float, WS_S5BBAR);
    for (int idx = gt; idx < 2 * 32 * 64; idx += NGT) {
        const int dg = idx >> 6;
        const float are = p6[idx], aim = p7[idx], step = __expf(p12[dg]);
        const float xr = are * step; const double th = (double)aim * (double)step;
        float s, c, sh, ch; sincos_d(th, s, c); sincos_d(0.5 * th, sh, ch);
        const float em1 = expm1f(xr), mag = em1 + 1.0f;
        const float nr = em1 * c - 2.0f * sh * sh, ni = mag * s;
        const float den = are * are + aim * aim;
        const float fr = (nr * are + ni * aim) / den, fi = (ni * are - nr * aim) / den;
        lam[idx * 2] = xr; lam[idx * 2 + 1] = (float)th;
        for (int ci = 0; ci < 16; ++ci) { const float br = p8[idx * 16 + ci], bi = p9[idx * 16 + ci];
            bbar[(idx * 16 + ci) * 2] = fr * br - fi * bi; bbar[(idx * 16 + ci) * 2 + 1] = fr * bi + fi * br; }
    }
}
__device__ __forceinline__ void apow(const float* lam, int idx, int m, float& re, float& im) {
    const float xr = lam[idx * 2], th = lam[idx * 2 + 1]; float s, c; sincos_d((double)m * (double)th, s, c);
    const float mag = __expf((float)m * xr); re = mag * c; im = mag * s;
}
__device__ __forceinline__ void rmsnorm_rows(const Ctx& C, const float* x, const float* g, unsigned* hq, float* hsc) {
    const int gw = C.bid * NWAVES + C.wave, NGW = C.G * NWAVES;
    f32x4 gv[4];
#pragma unroll
    for (int j = 0; j < 4; ++j) gv[j] = *(const f32x4*)(g + j * 256 + C.lane * 4);
    for (int r = gw; r < T; r += 2 * NGW) {
        const int r2 = (r + NGW < T) ? r + NGW : r; f32x4 v[4], u[4]; float s = 0.f, s2 = 0.f, m = 0.f, m2 = 0.f;
#pragma unroll
        for (int j = 0; j < 4; ++j) { v[j] = __builtin_nontemporal_load((const f32x4*)(x + (size_t)r * DM + j * 256 + C.lane * 4)); u[j] = __builtin_nontemporal_load((const f32x4*)(x + (size_t)r2 * DM + j * 256 + C.lane * 4)); }
#pragma unroll
        for (int j = 0; j < 4; ++j) { s += v[j][0] * v[j][0] + v[j][1] * v[j][1] + v[j][2] * v[j][2] + v[j][3] * v[j][3]; s2 += u[j][0] * u[j][0] + u[j][1] * u[j][1] + u[j][2] * u[j][2] + u[j][3] * u[j][3];
            v[j] *= gv[j]; u[j] *= gv[j]; m = fmaxf(m, amax4(v[j])); m2 = fmaxf(m2, amax4(u[j])); }
        const float rstd = rsqrtf(wave_sum(s) * (1.0f / DM) + 1e-6f), rstd2 = rsqrtf(wave_sum(s2) * (1.0f / DM) + 1e-6f);
        m = wave_max(m); m2 = wave_max(m2);
        const float inv = m > 0.f ? 127.0f / m : 0.f, inv2 = m2 > 0.f ? 127.0f / m2 : 0.f;
#pragma unroll
        for (int j = 0; j < 4; ++j) { hq[(size_t)r * 256 + j * 64 + C.lane] = q4i8(v[j], inv); hq[(size_t)r2 * 256 + j * 64 + C.lane] = q4i8(u[j], inv2); }
        if (C.lane == 0) { hsc[r] = m * rstd * (1.0f / 127.0f); hsc[r2] = m2 * rstd2 * (1.0f / 127.0f); }
    }
}
constexpr int SC = 32, SCL = 5, SK = SC * 16, SLD = SK + 256, NCH = SEQ / SC, SROWS = 2 * NCH;
__device__ __forceinline__ void s5_ktab(const Ctx& C) {
    LAS float* W = (LAS float*)C.lds;
    const float* lam = WSP(float, WS_S5LAM); const float* bbar = WSP(float, WS_S5BBAR); float* kt = WSP(float, WS_S5KTAB);
    const float *p10 = INP(10), *p11 = INP(11);
    for (int it = C.bid; it < 2 * 32 * SC; it += C.G) {
        const int dg = it >> SCL, d = it & (SC - 1), dir = dg >> 5, g = dg & 31;
        __syncthreads();
        if (C.tid < 64) { float re, im; apow(lam, dg * 64 + C.tid, d, re, im); W[C.tid * 2] = re; W[C.tid * 2 + 1] = im; }
        __syncthreads();
        if (C.tid < 256) { const int co = C.tid >> 4, ci = C.tid & 15; float acc = 0.f;
            const float* cr = p10 + (size_t)(dg * 16 + co) * 64; const float* cim = p11 + (size_t)(dg * 16 + co) * 64;
            for (int p = 0; p < 64; ++p) { const float wr = W[p * 2], wi = W[p * 2 + 1]; const float br = bbar[((dg * 64 + p) * 16 + ci) * 2], bi = bbar[((dg * 64 + p) * 16 + ci) * 2 + 1];
                const float xr = wr * br - wi * bi, xi = wr * bi + wi * br; acc += cr[p] * xr - cim[p] * xi; }
            kt[((size_t)(g * 2 + dir) * SC + d) * 256 + C.tid] = acc; }
    }
}
__device__ __forceinline__ void s5_gmat(const Ctx& C) {
    const int gt = C.bid * NTHREADS + C.tid, NGT = C.G * NTHREADS;
    const float* lam = WSP(float, WS_S5LAM); const float* bbar = WSP(float, WS_S5BBAR); bf16_t* gm = WSP(bf16_t, BG_GM);
    for (int idx = gt; idx < 32 * 2 * 64 * SC; idx += NGT) {
        const int j = idx & (SC - 1), p = (idx >> SCL) & 63, dir = (idx >> (SCL + 6)) & 1, g = idx >> (SCL + 7), dgp = (dir * 32 + g) * 64 + p;
        float wr, wi; apow(lam, dgp, dir == 0 ? SC - 1 - j : j, wr, wi);
        float xr[16], xi[16];
#pragma unroll
        for (int ci = 0; ci < 16; ++ci) { const float br = bbar[(dgp * 16 + ci) * 2], bi = bbar[(dgp * 16 + ci) * 2 + 1]; xr[ci] = wr * br - wi * bi; xi[ci] = wr * bi + wi * br; }
        bf16_t* r0 = gm + ((size_t)(g * 256 + dir * 128 + p)) * SK + j * 16; bf16_t* r1 = r0 + (size_t)64 * SK;
        st_bf16x8(r0, (f32x4){xr[0], xr[1], xr[2], xr[3]}, (f32x4){xr[4], xr[5], xr[6], xr[7]}); st_bf16x8(r0 + 8, (f32x4){xr[8], xr[9], xr[10], xr[11]}, (f32x4){xr[12], xr[13], xr[14], xr[15]});
        st_bf16x8(r1, (f32x4){xi[0], xi[1], xi[2], xi[3]}, (f32x4){xi[4], xi[5], xi[6], xi[7]}); st_bf16x8(r1 + 8, (f32x4){xi[8], xi[9], xi[10], xi[11]}, (f32x4){xi[12], xi[13], xi[14], xi[15]});
    }
}
__device__ __forceinline__ void s5_b2mat(const Ctx& C) {
    const int gt = C.bid * NTHREADS + C.tid, NGT = C.G * NTHREADS;
    const float* lam = WSP(float, WS_S5LAM); const float* kt = WSP(float, WS_S5KTAB); bf16_t* b2 = WSP(bf16_t, BG_B2);
    const float *p10 = INP(10), *p11 = INP(11);
    for (int idx = gt; idx < 32 * SC * 16 * 2 * 8; idx += NGT) {
        const int pc = idx & 7, dir = (idx >> 3) & 1, co = (idx >> 4) & 15, i = (idx >> 8) & (SC - 1), g = idx >> (8 + SCL), dg = dir * 32 + g;
        const float* cr = p10 + (size_t)(dg * 16 + co) * 64 + pc * 8; const float* cim = p11 + (size_t)(dg * 16 + co) * 64 + pc * 8;
        float hr[8], hi[8];
#pragma unroll
        for (int k = 0; k < 8; ++k) { float wr, wi; apow(lam, dg * 64 + pc * 8 + k, dir == 0 ? i + 1 : SC - i, wr, wi); hr[k] = cr[k] * wr - cim[k] * wi; hi[k] = -(cr[k] * wi + cim[k] * wr); }
        bf16_t* row = b2 + ((size_t)(g * SK + i * 16 + co)) * SLD + SK + dir * 128 + pc * 8;
        st_bf16x8(row, (f32x4){hr[0], hr[1], hr[2], hr[3]}, (f32x4){hr[4], hr[5], hr[6], hr[7]});
        st_bf16x8(row + 64, (f32x4){hi[0], hi[1], hi[2], hi[3]}, (f32x4){hi[4], hi[5], hi[6], hi[7]});
    }
    for (int idx = gt; idx < 32 * SC * 16 * SC; idx += NGT) {
        const int j = idx & (SC - 1), co = (idx >> SCL) & 15, i = (idx >> (SCL + 4)) & (SC - 1), g = idx >> (2 * SCL + 4);
        f32x4 v[4];
        if (j < i) { const float* s = kt + ((size_t)(g * 2 + 0) * SC + (i - j)) * 256 + co * 16;
#pragma unroll
            for (int k = 0; k < 4; ++k) v[k] = *(const f32x4*)(s + 4 * k);
        } else if (j > i) { const float* s = kt + ((size_t)(g * 2 + 1) * SC + (j - i)) * 256 + co * 16;
#pragma unroll
            for (int k = 0; k < 4; ++k) v[k] = *(const f32x4*)(s + 4 * k);
        } else { const float* s0 = kt + ((size_t)(g * 2 + 0) * SC) * 256 + co * 16; const float* s1 = kt + ((size_t)(g * 2 + 1) * SC) * 256 + co * 16;
#pragma unroll
            for (int k = 0; k < 4; ++k) v[k] = *(const f32x4*)(s0 + 4 * k) + *(const f32x4*)(s1 + 4 * k);
        }
        bf16_t* row = b2 + ((size_t)(g * SK + i * 16 + co)) * SLD + j * 16;
        st_bf16x8(row, v[0], v[1]); st_bf16x8(row + 8, v[2], v[3]);
    }
}
__device__ __forceinline__ void s5_scan(const Ctx& C) {
    const int gt = C.bid * NTHREADS + C.tid;
    if (gt >= 2 * 32 * 2 * 64) return;
    const int p = gt & 63, dir = (gt >> 6) & 1, g = (gt >> 7) & 31, b = gt >> 12;
    const float* lam = WSP(float, WS_S5LAM); const float* xraw = WSP(float, BG_XRAW); bf16_t* a2 = WSP(bf16_t, BG_A2);
    float ar, ai; apow(lam, (dir * 32 + g) * 64 + p, SC, ar, ai);
    float sr = 0.f, si = 0.f;
    const size_t rowbase = (size_t)g * SROWS + b * NCH; const int q = dir * 128 + p;
    for (int n0 = 0; n0 < NCH; n0 += 64) {
        float xr[64], xi[64];
#pragma unroll
        for (int k = 0; k < 64; ++k) { const int n = dir == 0 ? n0 + k : NCH - 1 - n0 - k; xr[k] = xraw[(rowbase + n) * 256 + q]; xi[k] = xraw[(rowbase + n) * 256 + q + 64]; }
#pragma unroll
        for (int k = 0; k < 64; ++k) { const int n = dir == 0 ? n0 + k : NCH - 1 - n0 - k;
            a2[(rowbase + n) * SLD + SK + q] = f2bf(sr); a2[(rowbase + n) * SLD + SK + q + 64] = f2bf(si);
            const float nr = ar * sr - ai * si + xr[k], ni = ar * si + ai * sr + xi[k]; sr = nr; si = ni; }
    }
}

constexpr int TS = 136;
constexpr int TILE_B = 128 * TS * 2;
constexpr int VEC_OFF = 3 * TILE_B;
__device__ __forceinline__ void load_tile(LAS bf16_t* dst, const bf16_t* src, size_t ld, int tid) {
#pragma unroll
    for (int jj = 0; jj < 4; ++jj) { const int p = tid + 512 * jj, row = p >> 4, c16 = p & 15; *(LAS u32x4*)(dst + row * TS + c16 * 8) = *(const u32x4*)(src + (size_t)row * ld + c16 * 8); }
}
__device__ __forceinline__ void load_tile_colscale(LAS bf16_t* dst, const bf16_t* src, size_t ld, const LAS float* w, int tid) {
#pragma unroll
    for (int jj = 0; jj < 4; ++jj) { const int p = tid + 512 * jj, row = p >> 4, c16 = p & 15; const u32x4 v = *(const u32x4*)(src + (size_t)row * ld + c16 * 8);
        const f32x4 w0 = *(const LAS f32x4*)(w + c16 * 8), w1 = *(const LAS f32x4*)(w + c16 * 8 + 4);
        u32x4 o; o.x = pk2(lo_bf(v.x) * w0[0], hi_bf(v.x) * w0[1]); o.y = pk2(lo_bf(v.y) * w0[2], hi_bf(v.y) * w0[3]); o.z = pk2(lo_bf(v.z) * w1[0], hi_bf(v.z) * w1[1]); o.w = pk2(lo_bf(v.w) * w1[2], hi_bf(v.w) * w1[3]);
        *(LAS u32x4*)(dst + row * TS + c16 * 8) = o; }
}
__device__ __forceinline__ void mma_nt(f32x4 (&acc)[2][4], const LAS bf16_t* A, const LAS bf16_t* B, int wr, int wc, int lane) {
    const int fr = lane & 15, fq = lane >> 4;
#pragma unroll
    for (int ks = 0; ks < 4; ++ks) {
        bf16x8 a[2], b[4];
#pragma unroll
        for (int mi = 0; mi < 2; ++mi) a[mi] = *(const LAS bf16x8*)(A + (32 * wr + 16 * mi + fr) * TS + ks * 32 + fq * 8);
#pragma unroll
        for (int ni = 0; ni < 4; ++ni) b[ni] = *(const LAS bf16x8*)(B + (64 * wc + 16 * ni + fr) * TS + ks * 32 + fq * 8);
#pragma unroll
        for (int mi = 0; mi < 2; ++mi)
#pragma unroll
            for (int ni = 0; ni < 4; ++ni) acc[mi][ni] = __builtin_amdgcn_mfma_f32_16x16x32_bf16(b[ni], a[mi], acc[mi][ni], 0, 0, 0);
    }
}
__device__ __forceinline__ void zero_acc(f32x4 (&acc)[2][4]) {
#pragma unroll
    for (int mi = 0; mi < 2; ++mi)
#pragma unroll
        for (int ni = 0; ni < 4; ++ni) acc[mi][ni] = (f32x4){0.f, 0.f, 0.f, 0.f};
}

struct MixA { const bf16_t *Q, *K, *KT, *VT; bf16_t *O1, *O2, *KV; };
constexpr int VEC_OFF4 = 4 * TILE_B;
template <bool ML>
__device__ __forceinline__ void chunk_phaseA(const Ctx& C, const MixA& M) {
    LAS bf16_t* buf0 = (LAS bf16_t*)C.lds; LAS bf16_t* buf1 = (LAS bf16_t*)(C.lds + TILE_B); LAS bf16_t* buf2 = (LAS bf16_t*)(C.lds + 2 * TILE_B);
    LAS float* vec = (LAS float*)(C.lds + VEC_OFF);
    LAS float *bc = vec, *cf = vec + 128, *rc = vec + 256, *cb = vec + 384, *wf = vec + 512, *wb = vec + 640, *denp = vec + 768  , *wtot = vec + 1280  ;
    const int wr = C.wave >> 1, wc = C.wave & 1, fr = C.lane & 15, fq = C.lane >> 4;
    const int prow = C.tid >> 4, pc = (C.tid & 15) * 8;
    const float* mlg = WSP(float, WS_MLG);
    u32x4 rq[4], rk[4]; float pg0 = 0.f, pg1 = 0.f, pg2 = 0.f, pg3 = 0.f;
#define CHA_ISSUE(it_) do { const int b_ = (it_) >> 9, h_ = ((it_) >> 7) & 3, n_ = (it_) & 127; const size_t t0_ = (size_t)b_ * SEQ + n_ * 128; \
        _Pragma("unroll") for (int jj = 0; jj < 4; ++jj) { const int row = prow + 32 * jj; \
            rq[jj] = *(const u32x4*)(M.Q + (t0_ + row) * 512 + h_ * 128 + pc); rk[jj] = *(const u32x4*)(M.K + (t0_ + row) * 512 + h_ * 128 + pc); } \
        if (ML && C.tid < 128) { const size_t gi_ = (size_t)(b_ * 4 + h_) * SEQ + n_ * 128 + C.tid; pg0 = mlg[gi_]; pg1 = mlg[8 * SEQ + gi_]; pg2 = mlg[16 * SEQ + gi_]; pg3 = mlg[24 * SEQ + gi_]; } } while (0)
    constexpr int NIT = 1024 * REP_CHA;
    if (C.bid < NIT) CHA_ISSUE(C.bid & 1023);
    for (int item_ = C.bid; item_ < NIT; item_ += C.G) { const int item = item_ & 1023;
        const int b = item >> 9, h = (item >> 7) & 3, n = item & 127; const size_t t0 = (size_t)b * SEQ + n * 128;
        const size_t gi = (size_t)(b * 4 + h) * SEQ + n * 128 + (C.tid & 127);
        const float l2g = log2f(1.0f - exp2f(-5.0f - (float)h));
#pragma unroll
        for (int jj = 0; jj < 4; ++jj) { const int o = (prow + 32 * jj) * TS + pc; *(LAS u32x4*)(buf0 + o) = rq[jj]; *(LAS u32x4*)(buf1 + o) = rk[jj]; }
        float igf = pg0, igb = pg1, lfb = pg3, sf = pg2, sb = pg3;
        u32x4 rv[4];
#pragma unroll
        for (int jj = 0; jj < 4; ++jj) rv[jj] = *(const u32x4*)(M.VT + (size_t)(h * 128 + prow + 32 * jj) * T + t0 + pc);
        if (item_ + C.G < NIT) CHA_ISSUE((item_ + C.G) & 1023);
        if (ML && C.tid < 128) {
#pragma unroll
            for (int o = 1; o < 64; o <<= 1) { const float uf = __shfl_up(sf, o), ub = __shfl_up(sb, o); if (C.lane >= o) { sf += uf; sb += ub; } }
            if (C.lane == 63) { wtot[C.wave * 2] = sf; wtot[C.wave * 2 + 1] = sb; }
        }
        __syncthreads();
        if (C.tid < 128) {
            if (ML) {
                const float totf = wtot[0] + wtot[2], totb = wtot[1] + wtot[3];
                if (C.wave == 1) { sf += wtot[0]; sb += wtot[1]; }
                const float bcum = sf, rcum = totb - (sb - lfb);
                bc[C.tid] = bcum; cf[C.tid] = igf - bcum; rc[C.tid] = rcum; cb[C.tid] = igb - rcum;
                wf[C.tid] = __expf(totf + igf - bcum); wb[C.tid] = __expf(totb - rcum + igb);
                float* mlef = WSP(float, WS_MLEF); mlef[gi] = __expf(bcum); mlef[8 * SEQ + gi] = __expf(rcum);
                if (C.tid == 0) { float* mla = WSP(float, WS_MLA); mla[item * 2] = __expf(totf); mla[item * 2 + 1] = __expf(totb); }
            } else { wf[C.tid] = exp2f((float)(127 - C.tid) * l2g); wb[C.tid] = exp2f((float)C.tid * l2g); }
        }
        __syncthreads();
        f32x4 S[2][4]; zero_acc(S);
        mma_nt(S, buf0, buf1, wr, wc, C.lane);
        if (ML && C.tid < 256) {
            const int dir = C.tid >> 7, d = C.tid & 127; const LAS float* w = dir ? wb : wf; float a = 0.f;
#pragma unroll 8
            for (int j = 0; j < 128; ++j) a += w[j] * bf2f(buf1[j * TS + d]);
            WSP(float, WS_MLN)[(size_t)(item * 2 + dir) * 128 + d] = a;
        }
#pragma unroll
        for (int jj = 0; jj < 4; ++jj) *(LAS u32x4*)(buf2 + (prow + 32 * jj) * TS + pc) = rv[jj];
        __syncthreads();
        int frm = fr, fqm = fq; asm volatile("" : "+v"(frm), "+v"(fqm));
#pragma unroll
        for (int mi = 0; mi < 2; ++mi) {
            const int i = 32 * wr + 16 * mi + frm; float dsf = 0.f, dsb = 0.f;
            const float bci = ML ? bc[i] : 0.f, rci = ML ? rc[i] : 0.f;
#pragma unroll
            for (int ni = 0; ni < 4; ++ni) {
                const int j0 = 64 * wc + 16 * ni + 4 * fqm;
                if (ML) {
                    f32x4 pf, pb;
#pragma unroll
                    for (int r = 0; r < 4; ++r) { const int j = j0 + r;
                        pf[r] = (j <= i) ? S[mi][ni][r] * __expf(bci + cf[j]) : 0.f; pb[r] = (j >= i) ? S[mi][ni][r] * __expf(rci + cb[j]) : 0.f;
                        dsf += pf[r]; dsb += pb[r]; }
                    u32x2 w; w.x = pk2(pf[0], pf[1]); w.y = pk2(pf[2], pf[3]); *(LAS u32x2*)(buf0 + i * TS + j0) = w;
                    w.x = pk2(pb[0], pb[1]); w.y = pk2(pb[2], pb[3]); *(LAS u32x2*)(buf1 + i * TS + j0) = w;
                } else {
                    f32x4 pv;
#pragma unroll
                    for (int r = 0; r < 4; ++r) { const int j = j0 + r, dd = i > j ? i - j : j - i; pv[r] = S[mi][ni][r] * exp2f((float)dd * l2g); }
                    u32x2 w; w.x = pk2(pv[0], pv[1]); w.y = pk2(pv[2], pv[3]); *(LAS u32x2*)(buf0 + i * TS + j0) = w;
                }
            }
            if (ML) { dsf += __shfl_xor(dsf, 16); dsf += __shfl_xor(dsf, 32); dsb += __shfl_xor(dsb, 16); dsb += __shfl_xor(dsb, 32);
                if (fqm == 0) { denp[(0 * 2 + wc) * 128 + i] = dsf; denp[(1 * 2 + wc) * 128 + i] = dsb; } }
        }
        __syncthreads();
        if (ML && C.tid < 256) { const int dir = C.tid >> 7, i = C.tid & 127;
            WSP(float, WS_MLDEN)[(size_t)dir * 8 * SEQ + (size_t)(b * 4 + h) * SEQ + n * 128 + i] = denp[(dir * 2 + 0) * 128 + i] + denp[(dir * 2 + 1) * 128 + i]; }
        u32x4 rt[4];
#pragma unroll
        for (int jj = 0; jj < 4; ++jj) rt[jj] = *(const u32x4*)(M.KT + (size_t)(h * 128 + prow + 32 * jj) * T + t0 + pc);
        {
            f32x4 O[2][4]; zero_acc(O); mma_nt(O, buf0, buf2, wr, wc, C.lane);
#pragma unroll
            for (int mi = 0; mi < 2; ++mi)
#pragma unroll
                for (int ni = 0; ni < 4; ++ni) st4bf(M.O1 + (t0 + 32 * wr + 16 * mi + fr) * 512 + h * 128 + 64 * wc + 16 * ni + 4 * fq, O[mi][ni]);
            if (ML) { zero_acc(O); mma_nt(O, buf1, buf2, wr, wc, C.lane);
#pragma unroll
                for (int mi = 0; mi < 2; ++mi)
#pragma unroll
                    for (int ni = 0; ni < 4; ++ni) st4bf(M.O2 + (t0 + 32 * wr + 16 * mi + fr) * 512 + h * 128 + 64 * wc + 16 * ni + 4 * fq, O[mi][ni]); }
        }
        __syncthreads();
#pragma unroll
        for (int jj = 0; jj < 4; ++jj) { const int o = (prow + 32 * jj) * TS + pc; const u32x4 v = rt[jj];
            const f32x4 a0 = *(const LAS f32x4*)(wf + pc), a1 = *(const LAS f32x4*)(wf + pc + 4), c0 = *(const LAS f32x4*)(wb + pc), c1 = *(const LAS f32x4*)(wb + pc + 4);
            u32x4 x; x.x = pk2(lo_bf(v.x) * a0[0], hi_bf(v.x) * a0[1]); x.y = pk2(lo_bf(v.y) * a0[2], hi_bf(v.y) * a0[3]); x.z = pk2(lo_bf(v.z) * a1[0], hi_bf(v.z) * a1[1]); x.w = pk2(lo_bf(v.w) * a1[2], hi_bf(v.w) * a1[3]);
            *(LAS u32x4*)(buf0 + o) = x;
            x.x = pk2(lo_bf(v.x) * c0[0], hi_bf(v.x) * c0[1]); x.y = pk2(lo_bf(v.y) * c0[2], hi_bf(v.y) * c0[3]); x.z = pk2(lo_bf(v.z) * c1[0], hi_bf(v.z) * c1[1]); x.w = pk2(lo_bf(v.w) * c1[2], hi_bf(v.w) * c1[3]);
            *(LAS u32x4*)(buf1 + o) = x; }
        __syncthreads();
        {
            f32x4 A[2][4]; zero_acc(A); mma_nt(A, buf2, buf0, wr, wc, C.lane);
            bf16_t* kv = M.KV + (size_t)item * 2 * 16384;
#pragma unroll
            for (int mi = 0; mi < 2; ++mi)
#pragma unroll
                for (int ni = 0; ni < 4; ++ni) st4bf(kv + (32 * wr + 16 * mi + fr) * 128 + 64 * wc + 16 * ni + 4 * fq, A[mi][ni]);
            zero_acc(A); mma_nt(A, buf2, buf1, wr, wc, C.lane);
#pragma unroll
            for (int mi = 0; mi < 2; ++mi)
#pragma unroll
                for (int ni = 0; ni < 4; ++ni) st4bf(kv + 16384 + (32 * wr + 16 * mi + fr) * 128 + 64 * wc + 16 * ni + 4 * fq, A[mi][ni]);
        }
        __syncthreads();
    }
#undef CHA_ISSUE
}
template <bool ML>
__device__ __forceinline__ void chunk_scan(const Ctx& C, bf16_t* KV) {
    const int gt = C.bid * NTHREADS + C.tid, NGT = C.G * NTHREADS;
    const float* mla = WSP(float, WS_MLA);
    for (int idx = gt; idx < 8 * 2 * 8192; idx += NGT) {
        const int e2 = idx & 8191, dir = (idx >> 13) & 1, bh = idx >> 14;
        const float aconst = exp2f(128.0f * log2f(1.0f - exp2f(-5.0f - (float)(bh & 3))));
        float s0 = 0.f, s1 = 0.f;
        for (int n0 = 0; n0 < 128; n0 += 32) {
            unsigned raw[32]; float a[32];
#pragma unroll
            for (int k = 0; k < 32; ++k) { const int n = dir == 0 ? n0 + k : 127 - n0 - k; const int item = bh * 128 + n;
                raw[k] = *(const unsigned*)(KV + ((size_t)item * 2 + dir) * 16384 + e2 * 2); a[k] = ML ? mla[item * 2 + dir] : aconst; }
#pragma unroll
            for (int k = 0; k < 32; ++k) { const int n = dir == 0 ? n0 + k : 127 - n0 - k; const int item = bh * 128 + n;
                *(unsigned*)(KV + ((size_t)item * 2 + dir) * 16384 + e2 * 2) = pk2(s0, s1);
                s0 = a[k] * s0 + lo_bf(raw[k]); s1 = a[k] * s1 + hi_bf(raw[k]); }
        }
    }
    if (ML) {
        float* mln = WSP(float, WS_MLN);
        for (int idx = gt; idx < 8 * 2 * 128; idx += NGT) {
            const int d = idx & 127, dir = (idx >> 7) & 1, bh = idx >> 8; float s = 0.f;
            for (int k0 = 0; k0 < 128; k0 += 32) { float raw[32], a[32];
#pragma unroll
                for (int k = 0; k < 32; ++k) { const int n = dir == 0 ? k0 + k : 127 - k0 - k; const int item = bh * 128 + n; raw[k] = mln[(size_t)(item * 2 + dir) * 128 + d]; a[k] = mla[item * 2 + dir]; }
#pragma unroll
                for (int k = 0; k < 32; ++k) { const int n = dir == 0 ? k0 + k : 127 - k0 - k; const int item = bh * 128 + n; mln[(size_t)(item * 2 + dir) * 128 + d] = s; s = a[k] * s + raw[k]; } }
        }
    }
}
struct MixC { const bf16_t *Q, *KV, *O1, *O2, *GS; bf16_t* dst; int ldd, col0; };
template <bool ML>
__device__ __forceinline__ void chunk_phaseC(const Ctx& C, const MixC& M) {
    LAS bf16_t* buf0 = (LAS bf16_t*)C.lds; LAS bf16_t* buf1 = (LAS bf16_t*)(C.lds + TILE_B); LAS bf16_t* buf2 = (LAS bf16_t*)(C.lds + 2 * TILE_B);
    LAS float* vec = (LAS float*)(C.lds + VEC_OFF);
    LAS float *nf = vec, *nb = vec + 128, *qn = vec + 256  , *st = vec + 512  , *st2 = vec + 768  ;
    const int wr = C.wave >> 1, wc = C.wave & 1, fr = C.lane & 15, fq = C.lane >> 4;
    const int prow = C.tid >> 4, pc = (C.tid & 15) * 8;
    const float* mln = WSP(float, WS_MLN); const float* mlef = WSP(float, WS_MLEF); const float* mlden = WSP(float, WS_MLDEN);
    u32x4 rq[4], rf[4]; float pn = 0.f;
#define CHC_ISSUE(it_) do { const int b_ = (it_) >> 9, h_ = ((it_) >> 7) & 3, n_ = (it_) & 127; const size_t t0_ = (size_t)b_ * SEQ + n_ * 128; const bf16_t* kv_ = M.KV + (size_t)(it_) * 2 * 16384; \
        _Pragma("unroll") for (int jj = 0; jj < 4; ++jj) { const int row = prow + 32 * jj; \
            rq[jj] = *(const u32x4*)(M.Q + (t0_ + row) * 512 + h_ * 128 + pc); rf[jj] = *(const u32x4*)(kv_ + row * 128 + pc); } \
        if (ML && C.tid < 256) pn = mln[(size_t)((it_) * 2 + (C.tid >> 7)) * 128 + (C.tid & 127)]; } while (0)
    constexpr int NIT = 1024 * REP_CHC;
    if (C.bid < NIT) CHC_ISSUE(C.bid & 1023);
    for (int item_ = C.bid; item_ < NIT; item_ += C.G) { const int item = item_ & 1023;
        const int b = item >> 9, h = (item >> 7) & 3, n = item & 127; const size_t t0 = (size_t)b * SEQ + n * 128;
        const float l2g = log2f(1.0f - exp2f(-5.0f - (float)h));
#pragma unroll
        for (int jj = 0; jj < 4; ++jj) { const int o = (prow + 32 * jj) * TS + pc; *(LAS u32x4*)(buf0 + o) = rq[jj]; *(LAS u32x4*)(buf1 + o) = rf[jj]; }
        if (ML && C.tid < 256) ((C.tid >> 7) ? nb : nf)[C.tid & 127] = pn;
        u32x4 rb[4];
#pragma unroll
        for (int jj = 0; jj < 4; ++jj) rb[jj] = *(const u32x4*)(M.KV + (size_t)item * 2 * 16384 + 16384 + (prow + 32 * jj) * 128 + pc);
        u32x2 e1[2][4], e2[2][4]; float cfw[2], cbw[2], dfi[2], dbi[2];
#pragma unroll
        for (int mi = 0; mi < 2; ++mi) { const int i = 32 * wr + 16 * mi + fr; const size_t t = t0 + i;
#pragma unroll
            for (int ni = 0; ni < 4; ++ni) { const size_t off = t * 512 + h * 128 + 64 * wc + 16 * ni + 4 * fq;
                e1[mi][ni] = *(const u32x2*)(M.O1 + off); if (ML) e2[mi][ni] = *(const u32x2*)(M.O2 + off); }
            if (ML) { const size_t gi = (size_t)(b * 4 + h) * SEQ + n * 128 + i; cfw[mi] = mlef[gi]; cbw[mi] = mlef[8 * SEQ + gi]; dfi[mi] = mlden[gi]; dbi[mi] = mlden[8 * SEQ + gi]; }
            else { cfw[mi] = exp2f((float)(i + 1) * l2g); cbw[mi] = exp2f((float)(128 - i) * l2g); dfi[mi] = 0.f; dbi[mi] = 0.f; } }
        if (item_ + C.G < NIT) CHC_ISSUE((item_ + C.G) & 1023);
        __syncthreads();
        if (ML) { const int i = C.tid >> 2, part = C.tid & 3; float a0 = 0.f, a1 = 0.f;
#pragma unroll 1
            for (int c = 0; c < 4; ++c) { const int d0 = part * 32 + c * 8; const u32x4 qw = *(const LAS u32x4*)(buf0 + i * TS + d0);
                const f32x4 f0 = *(const LAS f32x4*)(nf + d0), f1 = *(const LAS f32x4*)(nf + d0 + 4), g0 = *(const LAS f32x4*)(nb + d0), g1 = *(const LAS f32x4*)(nb + d0 + 4);
                const float q0 = lo_bf(qw.x), q1 = hi_bf(qw.x), q2 = lo_bf(qw.y), q3 = hi_bf(qw.y), q4 = lo_bf(qw.z), q5 = hi_bf(qw.z), q6 = lo_bf(qw.w), q7 = hi_bf(qw.w);
                a0 += q0 * f0[0] + q1 * f0[1] + q2 * f0[2] + q3 * f0[3] + q4 * f1[0] + q5 * f1[1] + q6 * f1[2] + q7 * f1[3];
                a1 += q0 * g0[0] + q1 * g0[1] + q2 * g0[2] + q3 * g0[3] + q4 * g1[0] + q5 * g1[1] + q6 * g1[2] + q7 * g1[3]; }
            a0 += __shfl_xor(a0, 1); a0 += __shfl_xor(a0, 2); a1 += __shfl_xor(a1, 1); a1 += __shfl_xor(a1, 2);
            if (part == 0) { qn[i] = a0; qn[128 + i] = a1; } }
        __builtin_amdgcn_sched_barrier(0);
        f32x4 Xf[2][4], Xb[2][4]; zero_acc(Xf); zero_acc(Xb);
        mma_nt(Xf, buf0, buf1, wr, wc, C.lane);
        __builtin_amdgcn_sched_barrier(0);
#pragma unroll
        for (int jj = 0; jj < 4; ++jj) *(LAS u32x4*)(buf2 + (prow + 32 * jj) * TS + pc) = rb[jj];
        __syncthreads();
        mma_nt(Xb, buf0, buf2, wr, wc, C.lane);
        __builtin_amdgcn_sched_barrier(0);
#pragma unroll
        for (int mi = 0; mi < 2; ++mi)
#pragma unroll
            for (int ni = 0; ni < 4; ++ni) { const f32x4 o1 = (f32x4){lo_bf(e1[mi][ni].x), hi_bf(e1[mi][ni].x), lo_bf(e1[mi][ni].y), hi_bf(e1[mi][ni].y)};
                if (ML) { const f32x4 o2 = (f32x4){lo_bf(e2[mi][ni].x), hi_bf(e2[mi][ni].x), lo_bf(e2[mi][ni].y), hi_bf(e2[mi][ni].y)}; Xf[mi][ni] = o1 + cfw[mi] * Xf[mi][ni]; Xb[mi][ni] = o2 + cbw[mi] * Xb[mi][ni]; }
                else Xf[mi][ni] = o1 + cfw[mi] * Xf[mi][ni] + cbw[mi] * Xb[mi][ni]; }
        u32x2 eg[2][4];
#pragma unroll
        for (int mi = 0; mi < 2; ++mi)
#pragma unroll
            for (int ni = 0; ni < 4; ++ni) eg[mi][ni] = *(const u32x2*)(M.GS + (t0 + 32 * wr + 16 * mi + fr) * 512 + h * 128 + 64 * wc + 16 * ni + 4 * fq);
        __syncthreads();
        float rs[2] = {0.f, 0.f};
#pragma unroll
        for (int mi = 0; mi < 2; ++mi) {
            const int i = 32 * wr + 16 * mi + fr;
            float dnf = 0.f, dnb = 0.f;
            if (ML) { dnf = 1.0f / fmaxf(fabsf(dfi[mi] + cfw[mi] * qn[i]), 1.0f); dnb = 1.0f / fmaxf(fabsf(dbi[mi] + cbw[mi] * qn[128 + i]), 1.0f); }
#pragma unroll
            for (int ni = 0; ni < 4; ++ni) {
                f32x4 o;
                if (ML) o = Xf[mi][ni] * dnf + Xb[mi][ni] * dnb; else o = Xf[mi][ni];
                Xf[mi][ni] = o; rs[mi] += (o[0] + o[1]) + (o[2] + o[3]);
            }
            rs[mi] += __shfl_xor(rs[mi], 16); rs[mi] += __shfl_xor(rs[mi], 32);
            if (fq == 0) st[wc * 128 + i] = rs[mi];
        }
        __syncthreads();
        float mu[2];
#pragma unroll
        for (int mi = 0; mi < 2; ++mi) { const int i = 32 * wr + 16 * mi + fr; mu[mi] = (st[i] + st[128 + i]) * (1.0f / 128.0f); float q2 = 0.f;
#pragma unroll
            for (int ni = 0; ni < 4; ++ni) { const f32x4 d = Xf[mi][ni] - mu[mi]; q2 += (d[0] * d[0] + d[1] * d[1]) + (d[2] * d[2] + d[3] * d[3]); }
            q2 += __shfl_xor(q2, 16); q2 += __shfl_xor(q2, 32);
            if (fq == 0) st2[wc * 128 + i] = q2; }
        __syncthreads();
#pragma unroll
        for (int mi = 0; mi < 2; ++mi) { const int i = 32 * wr + 16 * mi + fr; const size_t t = t0 + i;
            const float rstd = rsqrtf((st2[i] + st2[128 + i]) * (1.0f / 128.0f) + 1e-6f);
#pragma unroll
            for (int ni = 0; ni < 4; ++ni) { const int e0 = 64 * wc + 16 * ni + 4 * fq; const f32x4 gv = (f32x4){lo_bf(eg[mi][ni].x), hi_bf(eg[mi][ni].x), lo_bf(eg[mi][ni].y), hi_bf(eg[mi][ni].y)}; f32x4 o;
#pragma unroll
                for (int r = 0; r < 4; ++r) o[r] = (Xf[mi][ni][r] - mu[mi]) * rstd * (ML ? sigmoidf_(gv[r]) : siluf_(gv[r]));
                st4bf(M.dst + t * M.ldd + M.col0 + h * 128 + e0, o); } }
        __syncthreads();
    }
#undef CHC_ISSUE
}

constexpr int DKS = 72, DVS = 392;
constexpr int DK_OFF = 0, DV_OFF = 384 * DKS * 2;
__device__ __forceinline__ void dilated_attn(const Ctx& C) {
    LAS bf16_t* Ks = (LAS bf16_t*)(C.lds + DK_OFF); LAS bf16_t* Vt = (LAS bf16_t*)(C.lds + DV_OFF);
    const bf16_t* cq = WSP(bf16_t, BO_CQ); const bf16_t* ck = WSP(bf16_t, BO_CK); const bf16_t* cvT = WSP(bf16_t, BO_CVT);
    bf16_t* odil = WSP(bf16_t, BO_ODIL); float* lse = WSP(float, WS_LSE);
    const int w = C.wave, fr = C.lane & 15, fq = C.lane >> 4, qbl = w >> 1;
    u32x4 pk_[6], pv_[6]; bf16x8 pq_[2][2];
#define DIL_ISSUE(it_) do { const int run_ = (it_) & 63, hh_ = ((it_) >> 6) & 3, g_ = ((it_) >> 8) % 3, b_ = (it_) / 768, sh_ = 2 * g_; \
        const int NBk_ = 256 >> sh_, qb0_ = run_ * 4, nb0_ = qb0_ & (NBk_ - 1); const size_t hrow_ = (size_t)(g_ * 4 + hh_) * T + (size_t)b_ * SEQ; const int kp0_ = qb0_ * 64 - 64; \
        _Pragma("unroll") for (int jj = 0; jj < 6; ++jj) { const int p = C.tid + 512 * jj, row = p >> 3, c16 = p & 7; const int nbk = nb0_ - 1 + (row >> 6); const bool ok = nbk >= 0 && nbk < NBk_; \
            pk_[jj] = (u32x4){0u, 0u, 0u, 0u}; if (ok) pk_[jj] = *(const u32x4*)(ck + (hrow_ + kp0_ + row) * 64 + c16 * 8); } \
        _Pragma("unroll") for (int jj = 0; jj < 6; ++jj) { const int p = C.tid + 512 * jj, e = p / 48, c = p % 48, t8 = c * 8; const int nbk = nb0_ - 1 + (t8 >> 6); const bool ok = nbk >= 0 && nbk < NBk_; \
            pv_[jj] = (u32x4){0u, 0u, 0u, 0u}; if (ok) pv_[jj] = *(const u32x4*)(cvT + (size_t)((g_ * 4 + hh_) * 64 + e) * T + (size_t)b_ * SEQ + kp0_ + t8); } \
        _Pragma("unroll") for (int mt = 0; mt < 2; ++mt) _Pragma("unroll") for (int ks = 0; ks < 2; ++ks) pq_[mt][ks] = *(const bf16x8*)(cq + (hrow_ + qb0_ * 64 + 32 * w + 16 * mt + fr) * 64 + ks * 32 + fq * 8); } while (0)
    constexpr int NITD = 1536 * REP_DIL;
    if (C.bid < NITD) DIL_ISSUE(C.bid % 1536);
    for (int item_ = C.bid; item_ < NITD; item_ += C.G) { const int item = item_ % 1536;
        const int run = item & 63, hh = (item >> 6) & 3, g = (item >> 8) % 3, b = item / 768, sh = 2 * g;
        const int NBk = 256 >> sh, qb0 = run * 4, nb0 = qb0 & (NBk - 1), cls = qb0 >> (8 - sh);
#pragma unroll
        for (int jj = 0; jj < 6; ++jj) { const int p = C.tid + 512 * jj, row = p >> 3, c16 = p & 7; *(LAS u32x4*)(Ks + row * DKS + c16 * 8) = pk_[jj]; }
#pragma unroll
        for (int jj = 0; jj < 6; ++jj) { const int p = C.tid + 512 * jj, e = p / 48, c = p % 48; *(LAS u32x4*)(Vt + e * DVS + c * 8) = pv_[jj]; }
        bf16x8 qf[2][2];
#pragma unroll
        for (int mt = 0; mt < 2; ++mt)
#pragma unroll
            for (int ks = 0; ks < 2; ++ks) qf[mt][ks] = pq_[mt][ks];
        if (item_ + C.G < NITD) DIL_ISSUE((item_ + C.G) % 1536);
        __syncthreads();
        const int kl0 = 64 * qbl;
#pragma unroll
        for (int mt = 0; mt < 2; ++mt) {
            __builtin_amdgcn_sched_barrier(0);
            unsigned pk[12][2]; float rden, mrow;
            {
                f32x4 acc[12];
#pragma unroll
                for (int ni = 0; ni < 12; ++ni) acc[ni] = (f32x4){0.f, 0.f, 0.f, 0.f};
                const bf16x8 q0 = qf[mt][0], q1 = qf[mt][1];
#pragma unroll
                for (int ni = 0; ni < 12; ++ni) { const bf16x8 kf0 = *(const LAS bf16x8*)(Ks + (kl0 + 16 * ni + fr) * DKS + fq * 8), kf1 = *(const LAS bf16x8*)(Ks + (kl0 + 16 * ni + fr) * DKS + 32 + fq * 8);
                    acc[ni] = __builtin_amdgcn_mfma_f32_16x16x32_bf16(kf0, q0, acc[ni], 0, 0, 0); acc[ni] = __builtin_amdgcn_mfma_f32_16x16x32_bf16(kf1, q1, acc[ni], 0, 0, 0); }
                int frm = fr, fqm = fq; asm volatile("" : "+v"(frm), "+v"(fqm));
                const int ib = 32 * (w & 1) + 16 * mt + frm;
                float mx = -3e38f;
#pragma unroll
                for (int ni = 0; ni < 12; ++ni) { const int nbk = nb0 + qbl - 1 + (ni >> 2); const bool bok = nbk >= 0 && nbk < NBk;
#pragma unroll
                    for (int r = 0; r < 4; ++r) { const int rel = 16 * ni + 4 * fqm + r - 64 - ib; const bool ok = bok && rel <= 64 && rel >= -64;
                        const float sv = ok ? acc[ni][r] * 0.125f : -1e30f; acc[ni][r] = sv; mx = fmaxf(mx, sv); } }
                mx = fmaxf(mx, __shfl_xor(mx, 16)); mx = fmaxf(mx, __shfl_xor(mx, 32));
                float sm = 0.f;
#pragma unroll
                for (int ni = 0; ni < 12; ++ni) { f32x4 p;
#pragma unroll
                    for (int r = 0; r < 4; ++r) { p[r] = __expf(acc[ni][r] - mx); sm += p[r]; }
                    pk[ni][0] = pk2(p[0], p[1]); pk[ni][1] = pk2(p[2], p[3]); }
                sm += __shfl_xor(sm, 16); sm += __shfl_xor(sm, 32);
                rden = 1.0f / sm; mrow = mx + __logf(sm);
            }
            f32x4 o[4];
#pragma unroll
            for (int ne = 0; ne < 4; ++ne) o[ne] = (f32x4){0.f, 0.f, 0.f, 0.f};
#pragma unroll
            for (int ks2 = 0; ks2 < 6; ++ks2) {
                const u32x4 t4 = (u32x4){pk[2 * ks2][0], pk[2 * ks2][1], pk[2 * ks2 + 1][0], pk[2 * ks2 + 1][1]}; const bf16x8 pf = __builtin_bit_cast(bf16x8, t4);
#pragma unroll
                for (int ne = 0; ne < 4; ++ne) { const LAS bf16_t* vp = Vt + (16 * ne + fr) * DVS + kl0 + 32 * ks2 + 4 * fq;
                    const u32x2 v0 = *(const LAS u32x2*)vp, v1 = *(const LAS u32x2*)(vp + 16);
                    const u32x4 v4 = (u32x4){v0.x, v0.y, v1.x, v1.y}; const bf16x8 vf = __builtin_bit_cast(bf16x8, v4);
                    o[ne] = __builtin_amdgcn_mfma_f32_16x16x32_bf16(vf, pf, o[ne], 0, 0, 0); }
            }
            const int ib = 32 * (w & 1) + 16 * mt + fr, p = (((nb0 + qbl) * 64 + ib) << sh) + cls; const size_t trow = (size_t)g * T + (size_t)b * SEQ + p;
#pragma unroll
            for (int ne = 0; ne < 4; ++ne) st4bf(odil + trow * 256 + hh * 64 + 16 * ne + 4 * fq, o[ne] * rden);
            if (fq == 0) lse[trow * 4 + hh] = mrow;
        }
        __syncthreads();
    }
#undef DIL_ISSUE
}
__device__ __forceinline__ void dilated_merge(const Ctx& C) {
    const int gt = C.bid * NTHREADS + C.tid, NGT = C.G * NTHREADS;
    const bf16_t* odil = WSP(bf16_t, BO_ODIL); const float* lse = WSP(float, WS_LSE); bf16_t* aout = WSP(bf16_t, BO_AOUT);
    for (int idx = gt; idx < T * 32; idx += NGT) {
        const int t = idx >> 5, c8 = idx & 31, hh = c8 >> 3;
        const float l0 = lse[(size_t)t * 4 + hh], l1 = lse[((size_t)T + t) * 4 + hh], l2 = lse[((size_t)2 * T + t) * 4 + hh];
        const float mx = fmaxf(l0, fmaxf(l1, l2)); const float e0 = __expf(l0 - mx), e1 = __expf(l1 - mx), e2 = __expf(l2 - mx), rs = 1.0f / (e0 + e1 + e2);
        const float w0 = e0 * rs, w1 = e1 * rs, w2 = e2 * rs;
        const u32x4 a = *(const u32x4*)(odil + (size_t)t * 256 + c8 * 8), bq = *(const u32x4*)(odil + ((size_t)T + t) * 256 + c8 * 8), cc = *(const u32x4*)(odil + ((size_t)2 * T + t) * 256 + c8 * 8);
        u32x4 o;
        o.x = pk2(w0 * lo_bf(a.x) + w1 * lo_bf(bq.x) + w2 * lo_bf(cc.x), w0 * hi_bf(a.x) + w1 * hi_bf(bq.x) + w2 * hi_bf(cc.x));
        o.y = pk2(w0 * lo_bf(a.y) + w1 * lo_bf(bq.y) + w2 * lo_bf(cc.y), w0 * hi_bf(a.y) + w1 * hi_bf(bq.y) + w2 * hi_bf(cc.y));
        o.z = pk2(w0 * lo_bf(a.z) + w1 * lo_bf(bq.z) + w2 * lo_bf(cc.z), w0 * hi_bf(a.z) + w1 * hi_bf(bq.z) + w2 * hi_bf(cc.z));
        o.w = pk2(w0 * lo_bf(a.w) + w1 * lo_bf(bq.w) + w2 * lo_bf(cc.w), w0 * hi_bf(a.w) + w1 * hi_bf(bq.w) + w2 * hi_bf(cc.w));
        *(u32x4*)(aout + (size_t)t * 768 + c8 * 8) = o;
    }
}

template <int MODE, int TSTR = 1>
__device__ __forceinline__ void skinny16_tile(const Ctx& C, const bf16_t* x, const float* wT, const float* bias_i, const float* bias_f, int tile) {
    const int l15 = C.lane & 15, q = C.lane >> 4;
    {
        const bf16_t* xr = x + (size_t)(TSTR == 1 ? tile * 16 + l15 : l15 * TSTR + tile) * DM + 8 * q; const float* wr = wT + (size_t)l15 * DM + 8 * q;
        f32x4 acc = (f32x4){0.f, 0.f, 0.f, 0.f}, acc2 = (f32x4){0.f, 0.f, 0.f, 0.f}; float ss = 0.f;
        for (int s0 = 0; s0 < 32; s0 += 8) {
            u32x4 xw[8]; f32x4 w0[8], w1[8];
#pragma unroll
            for (int s = 0; s < 8; ++s) { xw[s] = *(const u32x4*)(xr + 32 * (s0 + s)); w0[s] = *(const f32x4*)(wr + 32 * (s0 + s)); w1[s] = *(const f32x4*)(wr + 32 * (s0 + s) + 4); }
#pragma unroll
            for (int s = 0; s < 8; ++s) {
                const float x0 = lo_bf(xw[s].x), x1 = hi_bf(xw[s].x), x2 = lo_bf(xw[s].y), x3 = hi_bf(xw[s].y), x4 = lo_bf(xw[s].z), x5 = hi_bf(xw[s].z), x6 = lo_bf(xw[s].w), x7 = hi_bf(xw[s].w);
                ss += (x0 * x0 + x1 * x1) + (x2 * x2 + x3 * x3) + (x4 * x4 + x5 * x5) + (x6 * x6 + x7 * x7);
                acc = __builtin_amdgcn_mfma_f32_16x16x4f32(x0, w0[s][0], acc, 0, 0, 0); acc2 = __builtin_amdgcn_mfma_f32_16x16x4f32(x1, w0[s][1], acc2, 0, 0, 0);
                acc = __builtin_amdgcn_mfma_f32_16x16x4f32(x2, w0[s][2], acc, 0, 0, 0); acc2 = __builtin_amdgcn_mfma_f32_16x16x4f32(x3, w0[s][3], acc2, 0, 0, 0);
                acc = __builtin_amdgcn_mfma_f32_16x16x4f32(x4, w1[s][0], acc, 0, 0, 0); acc2 = __builtin_amdgcn_mfma_f32_16x16x4f32(x5, w1[s][1], acc2, 0, 0, 0);
                acc = __builtin_amdgcn_mfma_f32_16x16x4f32(x6, w1[s][2], acc, 0, 0, 0); acc2 = __builtin_amdgcn_mfma_f32_16x16x4f32(x7, w1[s][3], acc2, 0, 0, 0); }
        }
        acc += acc2;
        ss += __shfl_xor(ss, 16); ss += __shfl_xor(ss, 32);
        const float rstd = rsqrtf(ss * (1.0f / DM) + 1e-6f);
        f32x4 lg;
#pragma unroll
        for (int r = 0; r < 4; ++r) lg[r] = acc[r] * __shfl(rstd, 4 * q + r);
        const int tok0 = tile * 16 + 4 * q, b = tok0 >> 14, pos0 = tok0 & (SEQ - 1);
        if (MODE == 0) {
            if (q == 0) WSP(float, WS_RSTD)[tile * 16 + l15] = rstd;
            f32x4 mx = lg;
#pragma unroll
            for (int o = 1; o < 16; o <<= 1)
#pragma unroll
                for (int r = 0; r < 4; ++r) mx[r] = fmaxf(mx[r], __shfl_xor(mx[r], o));
            f32x4 p, sm;
#pragma unroll
            for (int r = 0; r < 4; ++r) { p[r] = __expf(lg[r] - mx[r]); sm[r] = p[r]; }
#pragma unroll
            for (int o = 1; o < 16; o <<= 1)
#pragma unroll
                for (int r = 0; r < 4; ++r) sm[r] += __shfl_xor(sm[r], o);
#pragma unroll
            for (int r = 0; r < 4; ++r) p[r] = p[r] / sm[r];
            *(f32x4*)(WSP(float, WS_AFF) + (size_t)(b * 16 + l15) * SEQ + pos0) = p;
        } else {
            const int type = l15 >> 2, head = l15 & 3; f32x4 o;
            if (type < 2) { const float bi = bias_i[type * 4 + head];
#pragma unroll
                for (int r = 0; r < 4; ++r) o[r] = lg[r] + bi;
            } else { const float bf = bias_f[(type - 2) * 4 + head];
#pragma unroll
                for (int r = 0; r < 4; ++r) { const float z = lg[r] + bf; o[r] = fminf(z, 0.f) - log1pf(__expf(-fabsf(z))); } }
            if (TSTR == 1) *(f32x4*)(WSP(float, WS_MLG) + (size_t)type * 8 * SEQ + (size_t)(b * 4 + head) * SEQ + pos0) = o;
            else {
#pragma unroll
                for (int r = 0; r < 4; ++r) { const int t = (4 * q + r) * TSTR + tile; WSP(float, WS_MLG)[(size_t)type * 8 * SEQ + (size_t)((t >> 14) * 4 + head) * SEQ + (t & (SEQ - 1))] = o[r]; } }
        }
    }
}
template <int MODE>
__device__ __forceinline__ void skinny16(const Ctx& C, const bf16_t* x, const float* wT, const float* bias_i, const float* bias_f) {
    const int gw = C.bid * NWAVES + C.wave, NGW = C.G * NWAVES;
    for (int tile = gw; tile < T / 16; tile += NGW) skinny16_tile<MODE>(C, x, wT, bias_i, bias_f, tile);
}

__device__ __forceinline__ void router_quant(const Ctx& C, const float* wT) {
    const int gw = C.bid * NWAVES + C.wave, NGW = C.G * NWAVES;
    const bf16_t* x = WSP(bf16_t, WS_XB); unsigned* xq = WSP(unsigned, WS_HBUF); float* xsc = WSP(float, WS_XSC);
    for (int tile = gw; tile < T / 16; tile += NGW) {
        skinny16_tile<0>(C, x, wT, nullptr, nullptr, tile);
#pragma unroll 1
        for (int i0 = 0; i0 < 16; i0 += 4) {
            f32x4 v[4][4]; float mx[4];
#pragma unroll
            for (int i = 0; i < 4; ++i)
#pragma unroll
                for (int j = 0; j < 4; ++j) v[i][j] = ld4bf(x + (size_t)(tile * 16 + i0 + i) * DM + j * 256 + C.lane * 4);
#pragma unroll
            for (int i = 0; i < 4; ++i) { mx[i] = fmaxf(fmaxf(amax4(v[i][0]), amax4(v[i][1])), fmaxf(amax4(v[i][2]), amax4(v[i][3]))); }
#pragma unroll
            for (int o = 1; o < 64; o <<= 1)
#pragma unroll
                for (int i = 0; i < 4; ++i) mx[i] = fmaxf(mx[i], __shfl_xor(mx[i], o));
#pragma unroll
            for (int i = 0; i < 4; ++i) { const int t = tile * 16 + i0 + i; const float inv = mx[i] > 0.f ? 127.0f / mx[i] : 0.f;
#pragma unroll
                for (int j = 0; j < 4; ++j) xq[(size_t)t * 256 + j * 64 + C.lane] = q4i8(v[i][j], inv);
                if (C.lane == 0) xsc[t] = mx[i] * (1.0f / 127.0f); }
        }
    }
}

__device__ __forceinline__ void topk_select(const Ctx& C) {
    LAS unsigned* cnt = (LAS unsigned*)C.lds;
    const float* aff = WSP(float, WS_AFF); int* tok = WSP(int, WS_TOK); float* gatel = WSP(float, WS_GATEL); int* inv = WSP(int, WS_INV); float* rstdl = WSP(float, WS_RSTDL); const float* rstdv = WSP(float, WS_RSTD); const float* xscv = WSP(float, WS_XSC);
    for (int item = C.bid; item < NB * NE; item += C.G) {
        const int b = item >> 4, e = item & 15; const float* a = aff + (size_t)item * SEQ + C.tid * 32;
        unsigned key[32];
#pragma unroll
        for (int k = 0; k < 8; ++k) { const f32x4 v = *(const f32x4*)(a + 4 * k); key[4 * k] = __float_as_uint(v[0]); key[4 * k + 1] = __float_as_uint(v[1]); key[4 * k + 2] = __float_as_uint(v[2]); key[4 * k + 3] = __float_as_uint(v[3]); }
        unsigned prefix = 0u;
        for (int bit = 30; bit >= 0; --bit) {
            const unsigned cand = prefix | (1u << bit); unsigned c = 0;
#pragma unroll
            for (int k = 0; k < 32; ++k) c += (key[k] >= cand) ? 1u : 0u;
#pragma unroll
            for (int o = 1; o < 64; o <<= 1) c += __shfl_xor(c, o);
            LAS unsigned* slot = cnt + (bit & 1) * 8;
            if (C.lane == 0) slot[C.wave] = c;
            __syncthreads();
            unsigned tot = 0;
#pragma unroll
            for (int w = 0; w < 8; ++w) tot += slot[w];
            if (tot >= (unsigned)CAP) prefix = cand;
        }
        __syncthreads();
        unsigned cg_ = 0, ce = 0;
#pragma unroll
        for (int k = 0; k < 32; ++k) { cg_ += (key[k] > prefix) ? 1u : 0u; ce += (key[k] == prefix) ? 1u : 0u; }
        unsigned pkd = cg_ | (ce << 16), inc = pkd;
#pragma unroll
        for (int o = 1; o < 64; o <<= 1) { const unsigned u = __shfl_up(inc, o); if (C.lane >= o) inc += u; }
        if (C.lane == 63) cnt[16 + C.wave] = inc;
        __syncthreads();
        unsigned base = 0, total = 0;
#pragma unroll
        for (int w = 0; w < 8; ++w) { const unsigned v = cnt[16 + w]; if (w < C.wave) base += v; total += v; }
        const unsigned excl = base + inc - pkd;
        const unsigned gt_before = excl & 0xffffu, eq_before = excl >> 16, gt_total = total & 0xffffu;
        const unsigned need_eq = (unsigned)CAP - gt_total;
        unsigned eq_taken_before = eq_before < need_eq ? eq_before : need_eq;
        unsigned slot = gt_before + eq_taken_before, eqr = eq_before;
        const int rowbase = e * 4096 + b * 2048;
#pragma unroll
        for (int k = 0; k < 32; ++k) {
            const int pos = C.tid * 32 + k; int sl = -1;
            if (key[k] > prefix) sl = (int)slot++;
            else if (key[k] == prefix) { if (eqr < need_eq) sl = (int)slot++; ++eqr; }
            inv[((size_t)b * SEQ + pos) * 16 + e] = sl;
            if (sl >= 0) { tok[rowbase + sl] = b * SEQ + pos; gatel[rowbase + sl] = __uint_as_float(key[k]); rstdl[rowbase + sl] = rstdv[b * SEQ + pos] * xscv[b * SEQ + pos]; }
        }
        __syncthreads();
    }
}
template <bool FINAL>
__device__ __forceinline__ void moe_combine(const Ctx& C, const float* g, unsigned* hq, float* hsc, float* out, const float* wgt = nullptr, const float* bias_i = nullptr, const float* bias_f = nullptr) {
    const int gw = C.bid * NWAVES + C.wave, NGW = C.G * NWAVES;
    bf16_t* x = WSP(bf16_t, WS_XB); const int* inv = WSP(int, WS_INV); const bf16_t* ye = WSP(bf16_t, BG_YE);
    f32x4 gv[4];
#pragma unroll
    for (int j = 0; j < 4; ++j) gv[j] = *(const f32x4*)(g + j * 256 + C.lane * 4);
    for (int tile = gw; tile < T / 16; tile += NGW) {
#pragma unroll 1
    for (int ti = 0; ti < 16; ++ti) { const int t = ti * (T / 16) + tile;
        const int b = t >> 14; f32x4 v[4];
#pragma unroll
        for (int j = 0; j < 4; ++j) v[j] = ld4bf(x + (size_t)t * DM + j * 256 + C.lane * 4);
        const int myinv = inv[(size_t)t * 16 + (C.lane & 15)];
        unsigned msk = (unsigned)__ballot(myinv >= 0) & 0xffffu;
        while (msk) {
            const bf16_t* yr[4]; float wk[4];
#pragma unroll
            for (int k = 0; k < 4; ++k) { wk[k] = 0.f; yr[k] = ye;
                if (msk) { const int e = __builtin_ctz(msk); msk &= msk - 1; const int sl = __shfl(myinv, e); wk[k] = 1.f; yr[k] = ye + (size_t)(e * 4096 + b * 2048 + sl) * DM + C.lane * 4; } }
            u32x2 r[4][4];
#pragma unroll
            for (int k = 0; k < 4; ++k)
#pragma unroll
                for (int j = 0; j < 4; ++j) r[k][j] = __builtin_nontemporal_load((const u32x2*)(yr[k] + j * 256));
#pragma unroll
            for (int k = 0; k < 4; ++k)
#pragma unroll
                for (int j = 0; j < 4; ++j) v[j] += wk[k] * (f32x4){lo_bf(r[k][j].x), hi_bf(r[k][j].x), lo_bf(r[k][j].y), hi_bf(r[k][j].y)};
        }
        if (!FINAL) {
#pragma unroll
            for (int j = 0; j < 4; ++j) { u32x2 w; w.x = pk2(v[j][0], v[j][1]); w.y = pk2(v[j][2], v[j][3]); *(u32x2*)(x + (size_t)t * DM + j * 256 + C.lane * 4) = w;
                v[j] = (f32x4){lo_bf(w.x), hi_bf(w.x), lo_bf(w.y), hi_bf(w.y)}; } }
        float s = 0.f;
#pragma unroll
        for (int j = 0; j < 4; ++j) s += (v[j][0] * v[j][0] + v[j][1] * v[j][1]) + (v[j][2] * v[j][2] + v[j][3] * v[j][3]);
        const float rstd = rsqrtf(wave_sum(s) * (1.0f / DM) + 1e-6f);
        if (FINAL) {
#pragma unroll
            for (int j = 0; j < 4; ++j) *(f32x4*)(out + (size_t)t * DM + j * 256 + C.lane * 4) = v[j] * rstd * gv[j];
        } else {
            float m = 0.f;
#pragma unroll
            for (int j = 0; j < 4; ++j) { v[j] *= gv[j]; m = fmaxf(m, amax4(v[j])); }
            m = wave_max(m); const float inv = m > 0.f ? 127.0f / m : 0.f;
#pragma unroll
            for (int j = 0; j < 4; ++j) hq[(size_t)t * 256 + j * 64 + C.lane] = q4i8(v[j], inv);
            if (C.lane == 0) hsc[t] = m * rstd * (1.0f / 127.0f);
        }
    }
        if (!FINAL) {
            __builtin_amdgcn_fence(__ATOMIC_RELEASE, "workgroup"); __builtin_amdgcn_fence(__ATOMIC_ACQUIRE, "workgroup");
            skinny16_tile<1, T / 16>(C, x, wgt, bias_i, bias_f, tile);
        }
    }
}

#define XB_TMO      128
#define XB_XCNT(j)  (256  + 64 * (j))
#define XB_XSUB(j)  (1280 + 64 * (j))
#define XB_XGEN(j)  (2304 + 64 * (j))
#define XB_TOP      3328
#define XB_TOPGEN   3392
#define XCD_BAR_WORDS 3456
#define XB_SPIN_CAP (1u << 22)
__device__ __forceinline__ unsigned xb_ld(unsigned* p)              { return __hip_atomic_load(p, __ATOMIC_RELAXED, __HIP_MEMORY_SCOPE_AGENT); }
__device__ __forceinline__ unsigned xb_add(unsigned* p, unsigned v) { return __hip_atomic_fetch_add(p, v, __ATOMIC_RELAXED, __HIP_MEMORY_SCOPE_AGENT); }
__device__ __forceinline__ unsigned xb_xcc_id() { return (unsigned)__builtin_amdgcn_s_getreg((3 << 11) | 20) & 0xFu; }
#define XB_SPIN(cond, bar) do { unsigned _sp = 0; while (cond) { __builtin_amdgcn_s_sleep(1); \
    if ((++_sp & 255u) == 0u) { if (xb_ld(&(bar)[XB_TMO])) break; if (_sp > XB_SPIN_CAP) { atomicAdd(&(bar)[XB_TMO], 1u); break; } } } } while (0)
struct XcdBarrier { unsigned* bar; unsigned x; volatile LAS unsigned* st; int wave; };
__device__ __forceinline__ XcdBarrier xcd_barrier_post(unsigned* bar, volatile LAS unsigned* st, int wave) {
    XcdBarrier b; b.bar = bar; b.x = xb_xcc_id(); b.st = st; b.wave = wave;
    if (wave == 0 && lane_fresh() == 0) (void)xb_add(&bar[XB_XCNT(b.x)], 1u);
    return b;
}
__device__ __forceinline__ void xcd_barrier_complete(unsigned* bar, unsigned x, unsigned& nloc, unsigned& nx) {
    const unsigned G = gridDim.x * gridDim.y * gridDim.z;
    unsigned sum, cnt, mine, sp = 0u;
    for (;;) {
        sum = 0u; cnt = 0u; mine = 0u;
#pragma unroll
        for (unsigned j = 0; j < 16; ++j) { const unsigned c = xb_ld(&bar[XB_XCNT(j)]); sum += c; cnt += (c > 0u) ? 1u : 0u; mine = (j == x) ? c : mine; }
        if (sum == G) break;
        __builtin_amdgcn_s_sleep(1);
        if ((++sp & 255u) == 0u) { if (xb_ld(&bar[XB_TMO])) break; if (sp > XB_SPIN_CAP) { atomicAdd(&bar[XB_TMO], 1u); break; } }
    }
    nloc = mine > 0u ? mine : 1u; nx = cnt > 0u ? cnt : 1u;
}
__device__ __forceinline__ void xcd_barrier(const XcdBarrier& b) {
    asm volatile("s_waitcnt vmcnt(0)" ::: "memory");
    __syncthreads();
    if (b.wave == 0 && lane_fresh() == 0) {
        unsigned* bar = b.bar;
        __builtin_amdgcn_s_waitcnt(0);
        unsigned nloc = b.st[0], nx = b.st[1];
        if (nloc == 0u) { xcd_barrier_complete(bar, b.x, nloc, nx); b.st[0] = nloc; b.st[1] = nx; }
        const unsigned old = xb_add(&bar[XB_XSUB(b.x)], 1u);
        const unsigned gen = old / nloc;
        if (old + 1u == (gen + 1u) * nloc) {
            __builtin_amdgcn_fence(__ATOMIC_RELEASE, "agent");
            asm volatile("s_waitcnt vmcnt(0)" ::: "memory");
            const unsigned og = xb_add(&bar[XB_TOP], 1u);
            const unsigned tg = og / nx;
            if (og + 1u == (tg + 1u) * nx) xb_add(&bar[XB_TOPGEN], 1u);
            else XB_SPIN(xb_ld(&bar[XB_TOPGEN]) == tg, bar);
            __builtin_amdgcn_fence(__ATOMIC_ACQUIRE, "agent");
            xb_add(&bar[XB_XGEN(b.x)], 1u);
            asm volatile("s_waitcnt vmcnt(0)" ::: "memory");
        } else {
            XB_SPIN(xb_ld(&bar[XB_XGEN(b.x)]) == gen, bar);
            __builtin_amdgcn_fence(__ATOMIC_ACQUIRE, "agent");
            asm volatile("s_waitcnt vmcnt(0)" ::: "memory");
        }
    }
    __syncthreads();
}

constexpr int LDS_BYTES = 148480;
constexpr int NPHASE = 24;

__device__ __forceinline__ void moe_gemms1(const Ctx& C, int layer) {
    pg8::Gemm g{WSP(bf16_t, WS_HBUF), (const bf16_t*)(C.ws + WS_W13 + (size_t)layer * (64 * MiB)), 512, 512, 512, WSP(int, WS_TOK)}; pg8::TileOrder S; S.init(16, 16, 16, C.G, C.bid, REP_MOE1);
    EpiMoe1 E{WSP(signed char, BG_ACT), WSP(unsigned short, WS_ACTSC), WSP(float, WS_RSTDL), WSP(float, WS_WSC) + (size_t)layer * 16 * 4096, C.lds}; pg8::gemm_phase<EpiMoe1, true, true, true>(C.lds, g, S, E, C.wave);
}
__device__ __forceinline__ void moe_gemms2(const Ctx& C) {
    pg8::Gemm g{WSP(bf16_t, BG_ACT), WSP(bf16_t, WS_W2), 1024, 1024, 1024, nullptr, WSP(unsigned short, WS_ACTSC)}; pg8::TileOrder S; S.init(16, 16, 4, C.G, C.bid, REP_MOE2);
    EpiMoe2 E{WSP(bf16_t, BG_YE), WSP(float, WS_GATEL), WSP(float, WS_W2SC)}; pg8::gemm_phase<EpiMoe2, true, false, true, true>(C.lds, g, S, E, C.wave);
}

__global__ void __launch_bounds__(NTHREADS, 2) mega(Args args) {
    extern __shared__ __attribute__((aligned(16))) unsigned char lds_raw[];
    Ctx C0; C0.kp = (KargP)__builtin_amdgcn_kernarg_segment_ptr(); C0.out = (GAS float*)ldarg_ptr<192>(C0.kp); C0.ws = (GAS unsigned char*)ldarg_ptr<200>(C0.kp); C0.lds = (LAS unsigned char*)lds_raw;
    C0.tid = threadIdx.x; C0.lane = C0.tid & 63; C0.wave = __builtin_amdgcn_readfirstlane(C0.tid >> 6); C0.bid = blockIdx.x; C0.G = gridDim.x;
    const unsigned long long phw = (unsigned long long)ldarg_ptr<208>(C0.kp); const int lo = (int)(unsigned)phw, hi = (int)(unsigned)(phw >> 32);
#ifndef PHMASK
#define PHMASK 0xFFFFFFu
#endif
#define IN(k) (((PHMASK >> (k)) & 1u) && lo <= (k) && (k) < hi)
#ifndef REPMASK
#define REPMASK 0u
#endif
    volatile LAS unsigned* bst = (volatile LAS unsigned*)(C0.lds + LDS_BYTES - 64);
    if (C0.tid < 2) bst[C0.tid] = 0u;
    __syncthreads();
    XcdBarrier gbar; gbar.bar = (unsigned*)(C0.ws + WS_BAR); gbar.x = 0; gbar.st = bst; gbar.wave = C0.wave;
    if (hi - lo > 1 || REPMASK != 0u) gbar = xcd_barrier_post((unsigned*)(C0.ws + WS_BAR), bst, C0.wave);
    if (lo == 0x7fffffff) cg::this_grid().sync();
#define GRID_BAR() xcd_barrier(gbar)
#define SEAM(k) do { if (IN(k) && IN((k) + 1)) GRID_BAR(); } while (0)
#define PH_BEGIN(k) if (IN(k)) { Ctx C = C0; C.lane = lane_fresh(); C.tid = C.wave * 64 + C.lane; for (int rep_ = 0; rep_ <= (int)((REPMASK >> (k)) & 1u); ++rep_) { if (rep_) GRID_BAR();
#define PH_END(k) } } SEAM(k);

    PH_BEGIN(0) { prep_tables(C); conv_small_weights(C); for (int i = C.G - 1 - C.bid; i < WIN_BLK_ITEMS; i += C.G) winq_block_item(C, i);
        conv_moe_weights(C, 0, 0, CONV_A0, 0); rmsnorm_rows(C, INP(0), INP(1), WSP(unsigned, WS_HBUF), WSP(float, WS_XSC)); }
    PH_END(0)
    PH_BEGIN(1) {
        s5_ktab(C); s5_gmat(C); __syncthreads();
        { pg8::Gemm g{WSP(bf16_t, WS_HBUF), WSP(bf16_t, WS_WEV_MAIN), 512, 512, 512, nullptr}; pg8::TileOrder S; S.init(1, 128, 10, C.G, C.bid, REP_WIN);
          EpiEvenMain E{WSP(bf16_t, BG_Q), WSP(bf16_t, BG_K), WSP(bf16_t, BG_G), WSP(bf16_t, BG_A2), WSP(bf16_t, BG_KT), WSP(bf16_t, BG_VT), WSP(float, WS_COS128), WSP(float, WS_SIN128), C.lds, WSP(float, WS_XSC), WSP(float, WS_WINSC)}; pg8::gemm_phase<EpiEvenMain, true, false, true>(C.lds, g, S, E, C.wave); }
    }
    PH_END(1)
    PH_BEGIN(2) {
        s5_b2mat(C); __syncthreads();
        { MixA M{WSP(bf16_t, BG_Q), WSP(bf16_t, BG_K), WSP(bf16_t, BG_KT), WSP(bf16_t, BG_VT), WSP(bf16_t, BG_OINTRA), nullptr, WSP(bf16_t, BG_KV)}; chunk_phaseA<false>(C, M); }
        conv_moe_weights(C, 0, CONV_A0, CONV_A1, 128); __syncthreads();
        { pg8::Gemm g{WSP(bf16_t, BG_A2), WSP(bf16_t, BG_GM), 512, 768, 512, nullptr}; pg8::TileOrder S; S.init(32, 4, 1, C.G, C.bid, REP_S5);
          EpiS5A E{WSP(float, BG_XRAW)}; pg8::gemm_phase<EpiS5A>(C.lds, g, S, E, C.wave); }
    }
    PH_END(2)
    PH_BEGIN(3) { chunk_scan<false>(C, WSP(bf16_t, BG_KV)); s5_scan(C); conv_moe_weights(C, 0, CONV_A1, CONV_A2, 16); }
    PH_END(3)
    PH_BEGIN(4) {
        { MixC M{WSP(bf16_t, BG_Q), WSP(bf16_t, BG_KV), WSP(bf16_t, BG_OINTRA), nullptr, WSP(bf16_t, BG_G), WSP(bf16_t, BG_AOUT), 1024, 0}; chunk_phaseC<false>(C, M); }
        { pg8::Gemm g{WSP(bf16_t, BG_A2), WSP(bf16_t, BG_B2), 768, 768, 768, nullptr}; pg8::TileOrder S; S.init(32, 4, 2, C.G, C.bid, REP_S5);
          EpiS5B E{WSP(bf16_t, BG_A2), INP(13), WSP(bf16_t, BG_YG)}; pg8::gemm_phase<EpiS5B>(C.lds, g, S, E, C.wave); }
    }
    PH_END(4)
    PH_BEGIN(5) { pg8::Gemm g{WSP(bf16_t, BG_YG), WSP(bf16_t, WS_WGLU), 512, 512, 512, nullptr}; pg8::TileOrder S; S.init(1, 128, 2, C.G, C.bid, REP_WOUT);
        EpiGlu E{WSP(bf16_t, BG_YG), INP(15), WSP(bf16_t, BG_AOUT)}; pg8::gemm_phase<EpiGlu>(C.lds, g, S, E, C.wave); }
    PH_END(5)
    PH_BEGIN(6) { pg8::Gemm g{WSP(bf16_t, BG_AOUT), WSP(bf16_t, WS_WEVO), 1024, 1024, 1024, nullptr}; pg8::TileOrder S; S.init(1, 128, 4, C.G, C.bid, REP_WOUT);
        EpiResid<false> E{INP(0), WSP(bf16_t, WS_XB)}; pg8::gemm_phase<EpiResid<false>>(C.lds, g, S, E, C.wave); }
    PH_END(6)
    PH_BEGIN(7) router_quant(C, WSP(float, WS_WRT));
    PH_END(7)
    PH_BEGIN(8) { topk_select(C); conv_moe_weights(C, 0, CONV_A2, CONV_BLK_ITEMS, 32); }
    PH_END(8)
    PH_BEGIN(10) moe_gemms1(C, 0);
    PH_END(10)
    PH_BEGIN(11) moe_gemms2(C);
    PH_END(11)
    PH_BEGIN(12) { moe_combine<false>(C, INP(1) + 1024, WSP(unsigned, WS_HBUF), WSP(float, WS_XSC), nullptr, WSP(float, WS_WGT), INP(18), INP(19)); conv_moe_weights(C, 1, 0, CONV_B0, 0); }
    PH_END(12)
    PH_BEGIN(13) {
        { pg8::Gemm g{WSP(bf16_t, WS_HBUF), WSP(bf16_t, WS_WOD_MAIN), 512, 512, 512, nullptr}; pg8::TileOrder S; S.init(1, 128, 17, C.G, C.bid, REP_WIN);
          EpiOddMain E{(unsigned char*)C.ws, WSP(float, WS_COS64), WSP(float, WS_SIN64), C.lds, WSP(float, WS_XSC), WSP(float, WS_WINSC) + 2560}; pg8::gemm_phase<EpiOddMain, true, false, true>(C.lds, g, S, E, C.wave); }
        conv_moe_weights(C, 1, CONV_B0, CONV_B1, 128);
    }
    PH_END(13)
    PH_BEGIN(14) {
        dilated_attn(C);
        { MixA M{WSP(bf16_t, BO_MQ), WSP(bf16_t, BO_MK), WSP(bf16_t, BO_MKT), WSP(bf16_t, BO_MVT), WSP(bf16_t, BO_NUMF), WSP(bf16_t, BO_NUMB), WSP(bf16_t, BO_KV)}; chunk_phaseA<true>(C, M); }
    }
    PH_END(14)
    PH_BEGIN(15) chunk_scan<true>(C, WSP(bf16_t, BO_KV));
    PH_END(15)
    PH_BEGIN(16) {
        dilated_merge(C);
        { MixC M{WSP(bf16_t, BO_MQ), WSP(bf16_t, BO_KV), WSP(bf16_t, BO_NUMF), WSP(bf16_t, BO_NUMB), WSP(bf16_t, BO_MO), WSP(bf16_t, BO_AOUT), 768, 256}; chunk_phaseC<true>(C, M); }
    }
    PH_END(16)
    PH_BEGIN(17) { pg8::Gemm g{WSP(bf16_t, BO_AOUT), WSP(bf16_t, WS_WODO), 768, 768, 768, nullptr}; pg8::TileOrder S; S.init(1, 128, 4, C.G, C.bid);
        EpiResid<true> E{nullptr, WSP(bf16_t, WS_XB)}; pg8::gemm_phase<EpiResid<true>>(C.lds, g, S, E, C.wave); }
    PH_END(17)
    PH_BEGIN(18) router_quant(C, WSP(float, WS_WRT) + 16 * 1024);
    PH_END(18)
    PH_BEGIN(19) { topk_select(C); conv_moe_weights(C, 1, CONV_B1, CONV_BLK_ITEMS, 32); }
    PH_END(19)
    PH_BEGIN(21) moe_gemms1(C, 1);
    PH_END(21)
    PH_BEGIN(22) moe_gemms2(C);
    PH_END(22)
    PH_BEGIN(23) moe_combine<true>(C, INP(3), nullptr, nullptr, (float*)C.out);
    PH_END(23)
#ifdef DBG_STOP
    if (lo == 100) {
        const Ctx& C = C0;
        const size_t gt = (size_t)C.bid * NTHREADS + C.tid, NGT = (size_t)C.G * NTHREADS;
        for (size_t i = gt; i < (size_t)T * DM; i += NGT) { float v = 0.f; if (i < (size_t)DBG_N) v = DBG_F32 ? ((const float*)(C.ws + DBG_OFF))[i] : bf2f(((const bf16_t*)(C.ws + DBG_OFF))[i]); C.out[i] = v; }
    }
#endif
#undef IN
#undef SEAM
#undef PH_BEGIN
#undef PH_END
}

extern "C" void kernel_launch(void* const* d_in, const int* in_sizes, int n_in, void* d_out, int out_size, void* d_ws, size_t ws_size, hipStream_t stream) {
    static int grid = 0;
    if (grid == 0) {
        if (n_in != 24 || out_size != T * DM || ws_size < WS_END) { fprintf(stderr, "kernel_launch: unexpected shapes (n_in %d out %d ws %zu need %zu)\n", n_in, out_size, ws_size, (size_t)WS_END); grid = -1; return; }
        int dev = 0, cus = 0, per_cu = 0;
        hipGetDevice(&dev); hipDeviceGetAttribute(&cus, hipDeviceAttributeMultiprocessorCount, dev);
        hipFuncSetAttribute((const void*)mega, hipFuncAttributeMaxDynamicSharedMemorySize, LDS_BYTES);
        hipOccupancyMaxActiveBlocksPerMultiprocessor(&per_cu, (const void*)mega, NTHREADS, LDS_BYTES);
        if (per_cu < 1) { fprintf(stderr, "kernel_launch: occupancy query says %d blocks per CU\n", per_cu); per_cu = 1; }
        grid = cus * (per_cu > 1 ? 1 : per_cu);
        (void)hipGetLastError();
    }
    if (grid < 0) return;
    Args a{};
    for (int i = 0; i < 24; ++i) a.in[i] = (const float*)d_in[i];
    a.out = (float*)d_out; a.ws = (unsigned char*)d_ws;
    (void)hipMemsetAsync((unsigned char*)d_ws + WS_BAR, 0, XCD_BAR_WORDS * 4, stream);
#if ONE_LAUNCH
    a.ph_lo = 0; a.ph_hi = NPHASE;
    void* kargs[] = {&a};
    hipError_t e = hipLaunchCooperativeKernel((const void*)mega, dim3(grid), dim3(NTHREADS), kargs, LDS_BYTES, stream);
    if (e != hipSuccess) fprintf(stderr, "cooperative launch failed: %s (grid %d)\n", hipGetErrorString(e), grid);
#else
#ifdef DBG_STOP
    for (int p = 0; p <= DBG_STOP; ++p) { a.ph_lo = p; a.ph_hi = p + 1; hipLaunchKernelGGL(mega, dim3(grid), dim3(NTHREADS), LDS_BYTES, stream, a); }
    a.ph_lo = 100; a.ph_hi = 101; hipLaunchKernelGGL(mega, dim3(grid), dim3(NTHREADS), LDS_BYTES, stream, a);
#else
    for (int p = 0; p < NPHASE; ++p) { a.ph_lo = p; a.ph_hi = p + 1; hipLaunchKernelGGL(mega, dim3(grid), dim3(NTHREADS), LDS_BYTES, stream, a); }
#endif
#endif
}
```

```cpp
#include <hip/hip_runtime.h>
#include <hip/hip_cooperative_groups.h>
#include <cstdio>
#include <cstdint>
namespace cg = cooperative_groups;

#define LAS __attribute__((address_space(3)))
#define GAS __attribute__((address_space(1)))
typedef unsigned short bf16_t;
typedef short bf16x8 __attribute__((ext_vector_type(8)));
typedef float f32x4 __attribute__((ext_vector_type(4)));
typedef float f32x2 __attribute__((ext_vector_type(2)));
typedef unsigned u32x4 __attribute__((ext_vector_type(4)));
typedef unsigned u32x2 __attribute__((ext_vector_type(2)));
typedef int i32x4 __attribute__((ext_vector_type(4)));

#ifndef CONV_A0
#define CONV_A0 0
#endif
#ifndef CONV_A1
#define CONV_A1 128
#endif
#ifndef CONV_A2
#define CONV_A2 608
#endif
#ifndef CONV_B0
#define CONV_B0 96
#endif
#ifndef CONV_B1
#define CONV_B1 416
#endif
#ifndef REP_CHA
#define REP_CHA 1
#endif
#ifndef REP_CHC
#define REP_CHC 1
#endif
#ifndef REP_DIL
#define REP_DIL 1
#endif
#ifndef REP_MOE1
#define REP_MOE1 1
#endif
#ifndef REP_MOE2
#define REP_MOE2 1
#endif
#ifndef REP_WIN
#define REP_WIN 1
#endif
#ifndef REP_WOUT
#define REP_WOUT 1
#endif
#ifndef REP_S5
#define REP_S5 1
#endif
#ifndef ONE_LAUNCH
#define ONE_LAUNCH 1
#endif

constexpr int NB = 2, SEQ = 16384, T = NB * SEQ, DM = 1024;
constexpr int NE = 16, FF = 2048, CAP = 2048;
constexpr int NTHREADS = 512, NWAVES = 8;

__device__ __forceinline__ float bf2f(bf16_t b) { return __uint_as_float(((unsigned)b) << 16); }
typedef __bf16 bf16x2_t __attribute__((ext_vector_type(2)));
__device__ __forceinline__ unsigned pk2(float lo, float hi) { const f32x2 v = {lo, hi}; const bf16x2_t b = __builtin_convertvector(v, bf16x2_t); return __builtin_bit_cast(unsigned, b); }
__device__ __forceinline__ bf16_t f2bf(float f) { return (bf16_t)(pk2(f, 0.f) & 0xffffu); }
__device__ __forceinline__ float lo_bf(unsigned w) { return __uint_as_float(w << 16); }
__device__ __forceinline__ float hi_bf(unsigned w) { return __uint_as_float(w & 0xffff0000u); }
template <int CTRL> __device__ __forceinline__ float dppf(float v) { return __int_as_float(__builtin_amdgcn_update_dpp(0, __float_as_int(v), CTRL, 0xf, 0xf, false)); }
template <int CTRL> __device__ __forceinline__ unsigned dppu(unsigned v) { return (unsigned)__builtin_amdgcn_update_dpp(0, (int)v, CTRL, 0xf, 0xf, false); }
__device__ __forceinline__ void xpair16(float x, float& a, float& b) { const auto r = __builtin_amdgcn_permlane16_swap(__float_as_uint(x), __float_as_uint(x), false, false); a = __uint_as_float(r[0]); b = __uint_as_float(r[1]); }
__device__ __forceinline__ void xpair32(float x, float& a, float& b) { const auto r = __builtin_amdgcn_permlane32_swap(__float_as_uint(x), __float_as_uint(x), false, false); a = __uint_as_float(r[0]); b = __uint_as_float(r[1]); }
__device__ __forceinline__ float xsum16(float x) { float a, b; xpair16(x, a, b); return a + b; }
__device__ __forceinline__ float xsum32(float x) { float a, b; xpair32(x, a, b); return a + b; }
__device__ __forceinline__ float xmax16(float x) { float a, b; xpair16(x, a, b); return fmaxf(a, b); }
__device__ __forceinline__ float xmax32(float x) { float a, b; xpair32(x, a, b); return fmaxf(a, b); }
__device__ __forceinline__ float xsum_rows(float x) { return xsum32(xsum16(x)); }
__device__ __forceinline__ float xmax_rows(float x) { return xmax32(xmax16(x)); }
__device__ __forceinline__ float row_sum(float v) { v += dppf<0x128>(v); v += dppf<0x124>(v); v += dppf<0x122>(v); v += dppf<0x121>(v); return v; }
__device__ __forceinline__ float row_max(float v) { v = fmaxf(v, dppf<0x128>(v)); v = fmaxf(v, dppf<0x124>(v)); v = fmaxf(v, dppf<0x122>(v)); v = fmaxf(v, dppf<0x121>(v)); return v; }
__device__ __forceinline__ float wave_sum(float v) { return xsum_rows(row_sum(v)); }
__device__ __forceinline__ unsigned wave_sum_u(unsigned v) {
    v += dppu<0x128>(v); v += dppu<0x124>(v); v += dppu<0x122>(v); v += dppu<0x121>(v);
    auto r = __builtin_amdgcn_permlane16_swap(v, v, false, false); v = r[0] + r[1];
    r = __builtin_amdgcn_permlane32_swap(v, v, false, false); return r[0] + r[1];
}
__device__ __forceinline__ float sigmoidf_(float x) { return __builtin_amdgcn_rcpf(1.0f + __expf(-x)); }
__device__ __forceinline__ float siluf_(float x) { return x * __builtin_amdgcn_rcpf(1.0f + __expf(-x)); }
__device__ __forceinline__ float gelu_tanh(float x) {
    const float z = 0.7978845608028654f * (x + 0.044715f * x * x * x);
    const float e = __expf(2.0f * z);
    const float th = 1.0f - 2.0f * __builtin_amdgcn_rcpf(e + 1.0f);
    return 0.5f * x * (1.0f + th);
}
__device__ __forceinline__ void sincos_d(double ang, float& s, float& c) {
    const double rev = ang * 0.15915494309189535;
    const double fr = rev - __builtin_rint(rev);
    const float f = (float)fr;
    s = __builtin_amdgcn_sinf(f); c = __builtin_amdgcn_cosf(f);
}
#define LDS_WAIT() asm volatile("s_waitcnt lgkmcnt(0)" ::: "memory")
__device__ __forceinline__ int lane_fresh() { int l; asm volatile("v_mbcnt_lo_u32_b32 %0, -1, 0\n\tv_mbcnt_hi_u32_b32 %0, -1, %0" : "=v"(l)); return l; }

namespace pg8 {
constexpr int BM = 256, BK = 64, HALF = 128, HTB = HALF * BK * 2, STAGE_BYTES = 8 * HTB, NXCD = 8, WGM = 8, SCQ_OFF = STAGE_BYTES;
__host__ __device__ __forceinline__ int lds_byte(int r, int c) { const int st = (r >> 4) * 2 + (c >> 5), rr = r & 15, cc = c & 31, ob = rr * 64 + cc * 2; return st * 1024 + (ob ^ (((ob >> 9) & 1) << 5)); }
__host__ __device__ __forceinline__ void stage_rc(int b, int& R, int& C) { const int st = b / 1024, sb = b % 1024, swz = sb ^ (((sb >> 9) & 1) << 5); R = (st >> 1) * 16 + swz / 64; C = (st & 1) * 32 + (swz % 64) / 2; }
__host__ __device__ __forceinline__ int perm32(int rho) { const int n = rho >> 4, i = rho & 15; return 8 * (i >> 2) + 4 * n + (i & 3); }

struct Unit { int pm, pn; };
struct Gemm { const bf16_t* A; const bf16_t* Bt; int K, lda, ldb; const int* gather; const unsigned short* ksc = nullptr; };

struct TileOrder {
    int nM, nN, per, total, G, c, rep;
    __device__ void init(int ngroups, int nM_, int nN_, int G_, int c_, int rep_ = 1) { nM = nM_; nN = nN_; per = nM * nN; total = ngroups * per; G = G_; c = c_; rep = rep_; }
    __device__ bool next(int i, Unit& u) const {
        long L = (long)i * G + c; if (L >= (long)total * rep) return false;
        L %= total;
        const int g = (int)(L / per); int wgid = (int)(L % per);
        { const int q = per / NXCD, r = per % NXCD, xcd = wgid % NXCD, off = wgid / NXCD; wgid = (xcd < r ? xcd * (q + 1) : r * (q + 1) + (xcd - r) * q) + off; }
        const int nig = WGM * nN, gid = wgid / nig, fm = gid * WGM, gsz = (nM - fm) < WGM ? (nM - fm) : WGM;
        u.pm = g * nM + fm + ((wgid % nig) % gsz); u.pn = g * nN + (wgid % nig) / gsz; return true;
    }
};

template <class Epi, bool ALIGN_EPI = true, bool GATHER = false, bool I8 = false, bool KQ = false>
__device__ __forceinline__ void gemm_phase(LAS unsigned char* lds, const Gemm g, const TileOrder& S, const Epi& E, int wave_) {
    const int wid = __builtin_amdgcn_readfirstlane(wave_), lane = lane_fresh(), tid = wid * 64 + lane, wr = wid >> 2, wc = wid & 3, fr = lane & 15, fq = lane >> 4;
    const int K = g.K, nt = K / BK;
    unsigned voffA[2], voffB[2]; int stR[2], stC[2];
#pragma unroll
    for (int i = 0; i < 2; ++i) { int R, C; stage_rc(tid * 16 + i * 8192, R, C); const int Rb = Epi::PERM ? ((R & ~31) + perm32(R & 31)) : R; stR[i] = R; stC[i] = C;
        voffA[i] = (unsigned)(R * g.lda + C) * 2u; voffB[i] = (unsigned)(Rb * g.ldb + C) * 2u; }
    const size_t kstep = (size_t)(BK * 2);
    const size_t hstepA = GATHER ? 0 : (size_t)HALF * g.lda * 2, hstepB = (size_t)HALF * g.ldb * 2;
    const size_t tstepA = GATHER ? 0 : 2 * (size_t)HALF * g.lda * 2, tstepB = 2 * hstepB;
    unsigned vAc[2][2], vAn[2][2];
#define PG8_GOFF(dst, pm_) do { _Pragma("unroll") for (int _h = 0; _h < 2; ++_h) _Pragma("unroll") for (int _i = 0; _i < 2; ++_i) \
        dst[_h][_i] = (unsigned)(g.gather[(pm_) * 256 + _h * 128 + stR[_i]] * g.lda + stC[_i]) * 2u; } while (0)
    const unsigned ldsw = (unsigned)wid * 1024u;
    const int aoff = lds_byte(wr * 64 + fr, fq * 8), boff = lds_byte(wc * 32 + fr, fq * 8);
#define PG8_SA(b, h) (((b) * 2 + (h)) * HTB)
#define PG8_SB(b, h) ((4 + (b) * 2 + (h)) * HTB)
#define PG8_STAGE(bufoff, gbase, voff) do { _Pragma("unroll") for (int _i = 0; _i < 2; ++_i) \
        __builtin_amdgcn_global_load_lds((const unsigned*)((const char*)(gbase) + (voff)[_i]), (LAS unsigned*)(lds + (bufoff) + ldsw + _i * 8192), 16, 0, 0); } while (0)
#define PG8_LDA(dst, b, h) do { _Pragma("unroll") for (int m = 0; m < 4; ++m) _Pragma("unroll") for (int k = 0; k < 2; ++k) dst[m][k] = *(const LAS bf16x8*)(lds + PG8_SA(b, h) + aoff + m * 2048 + k * 1024); } while (0)
#define PG8_LDB(dst, b, h) do { _Pragma("unroll") for (int n = 0; n < 2; ++n) _Pragma("unroll") for (int k = 0; k < 2; ++k) dst[n][k] = *(const LAS bf16x8*)(lds + PG8_SB(b, h) + boff + n * 2048 + k * 1024); } while (0)
#define PG8_MMA(ai, bj, At, Bt) do { __builtin_amdgcn_s_setprio(1); _Pragma("unroll") for (int m = 0; m < 4; ++m) _Pragma("unroll") for (int n = 0; n < 2; ++n) _Pragma("unroll") for (int k = 0; k < 2; ++k) \
        acc[ai][bj][m][n] = I8 ? __builtin_bit_cast(f32x4, __builtin_amdgcn_mfma_i32_16x16x64_i8(__builtin_bit_cast(i32x4, Bt[n][k]), __builtin_bit_cast(i32x4, At[m][k]), __builtin_bit_cast(i32x4, acc[ai][bj][m][n]), 0, 0, 0)) \
                                : __builtin_amdgcn_mfma_f32_16x16x32_bf16(Bt[n][k], At[m][k], acc[ai][bj][m][n], 0, 0, 0); __builtin_amdgcn_s_setprio(0); } while (0)
    float sc[4]; int scbuf = 0;
#define PG8_LDSC(ai, kb) do { if constexpr (KQ) { const u32x2 w_ = *(const LAS u32x2*)(lds + SCQ_OFF + scbuf * 8192 + ((((kb) * 2 + ai) * 2 + wr) * 64 + fr * 4) * 2); \
        sc[0] = (float)__builtin_bit_cast(_Float16, (unsigned short)(w_.x & 0xffffu)); sc[1] = (float)__builtin_bit_cast(_Float16, (unsigned short)(w_.x >> 16)); \
        sc[2] = (float)__builtin_bit_cast(_Float16, (unsigned short)(w_.y & 0xffffu)); sc[3] = (float)__builtin_bit_cast(_Float16, (unsigned short)(w_.y >> 16)); } } while (0)
#define PG8_SCDMA(buf, pm_) do { int t16_ = lane * 16; asm volatile("" : "+v"(t16_));     \
        __builtin_amdgcn_global_load_lds((const unsigned*)((const char*)g.ksc + (size_t)(pm_) * 8192 + wid * 1024 + t16_), (LAS unsigned*)(lds + SCQ_OFF + (buf) * 8192 + ldsw), 16, 0, 0); } while (0)
    const i32x4 magicq = {0x4B400000, 0x4B400000, 0x4B400000, 0x4B400000};
#define PG8_MFQ(dst, Bt_, n_, m_) do { dst = __builtin_amdgcn_mfma_i32_16x16x64_i8(__builtin_bit_cast(i32x4, Bt_[n_][0]), __builtin_bit_cast(i32x4, At[m_][0]), magicq, 0, 0, 0); \
        dst = __builtin_amdgcn_mfma_i32_16x16x64_i8(__builtin_bit_cast(i32x4, Bt_[n_][1]), __builtin_bit_cast(i32x4, At[m_][1]), dst, 0, 0, 0); } while (0)
#define PG8_MMAQ2(ai) do { __builtin_amdgcn_s_setprio(1); i32x4 tq_[3]; _Pragma("unroll") for (int p_ = 0; p_ < 18; ++p_) { \
        if (p_ < 16) { const int m_ = (p_ >> 1) & 3, n_ = p_ & 1; if (p_ < 8) { PG8_MFQ(tq_[p_ % 3], B0, n_, m_); } else { PG8_MFQ(tq_[p_ % 3], B1, n_, m_); } } \
        if (p_ >= 2) { const int q_ = p_ - 2, m_ = (q_ >> 1) & 3, n_ = q_ & 1; acc[ai][q_ >> 3][m_][n_] += __builtin_bit_cast(f32x4, tq_[q_ % 3]) * sc[m_]; } \
        __builtin_amdgcn_sched_barrier(0); } \
        __builtin_amdgcn_s_setprio(0); } while (0)
#define PG8_MM(ai, bj, At, Bt) do { if constexpr (KQ) { if (bj == 0) { PG8_MMAQ2(ai); } } else { PG8_MMA(ai, bj, At, Bt); } } while (0)
#define PG8_WAIT_V(n) asm volatile("s_waitcnt vmcnt(" #n ")" ::: "memory")
#define PG8_WAIT_L(n) asm volatile("s_waitcnt lgkmcnt(" #n ")" ::: "memory")
#define PG8_BAR __builtin_amdgcn_s_barrier()
#define PG8_SCHED __builtin_amdgcn_sched_barrier(0)
#define PG8_STAGE_A(bufoff, gbase, h_, usenext) do { if constexpr (GATHER) { _Pragma("unroll") for (int _i = 0; _i < 2; ++_i) { const unsigned _v = (usenext) ? vAn[h_][_i] : vAc[h_][_i]; \
        __builtin_amdgcn_global_load_lds((const unsigned*)((const char*)(gbase) + _v), (LAS unsigned*)(lds + (bufoff) + ldsw + _i * 8192), 16, 0, 0); } } else { PG8_STAGE(bufoff, gbase, voffA); } } while (0)
    Unit cur, nxt; int ui = 0;
    if (!S.next(0, cur)) return;
    if constexpr (GATHER) { PG8_GOFF(vAc, cur.pm); }
    typename Epi::Pre pre; E.prefetch(pre, cur, wr, wc, fr, fq);
    f32x4 acc[2][2][4][2];
#pragma unroll
    for (int a = 0; a < 2; ++a)
#pragma unroll
        for (int b = 0; b < 2; ++b)
#pragma unroll
            for (int m = 0; m < 4; ++m)
#pragma unroll
                for (int n = 0; n < 2; ++n) acc[a][b][m][n] = (f32x4){0.f, 0.f, 0.f, 0.f};
    bf16x8 At[4][2], B0[2][2], B1[2][2];
    const char* cA = (const char*)g.A + (size_t)cur.pm * tstepA; const char* cB = (const char*)g.Bt + (size_t)cur.pn * tstepB;
    if constexpr (KQ) { PG8_SCDMA(0, cur.pm); }
    PG8_STAGE(PG8_SB(0, 0), cB, voffB); PG8_STAGE(PG8_SB(0, 1), cB + hstepB, voffB); PG8_STAGE_A(PG8_SA(0, 0), cA, 0, false); PG8_STAGE_A(PG8_SA(0, 1), cA + hstepA, 1, false);
    if (wr == 1) PG8_BAR;
    PG8_WAIT_V(2); PG8_BAR;
    PG8_STAGE(PG8_SB(1, 0), cB + kstep, voffB); PG8_STAGE_A(PG8_SA(1, 0), cA + kstep, 0, false); PG8_STAGE(PG8_SB(1, 1), cB + hstepB + kstep, voffB);
    PG8_WAIT_V(6); PG8_BAR;
    for (;;) {
        const bool has_next = S.next(ui + 1, nxt);
        if constexpr (GATHER) { if (has_next) { PG8_GOFF(vAn, nxt.pm); } else {
#pragma unroll
            for (int _h = 0; _h < 2; ++_h)
#pragma unroll
                for (int _i = 0; _i < 2; ++_i) vAn[_h][_i] = vAc[_h][_i]; } }
        const char* nA = has_next ? (const char*)g.A + (size_t)nxt.pm * tstepA : cA; const char* nB = has_next ? (const char*)g.Bt + (size_t)nxt.pn * tstepB : cB;
        if constexpr (KQ) { PG8_BAR;     if (has_next) { PG8_SCDMA(scbuf ^ 1, nxt.pm); } }
        for (int t = 0; t < nt; t += 2) {
            const bool last = (t == nt - 2);
            const char* a1 = cA + (size_t)(t + 1) * kstep;
            const char* a2 = last ? nA : cA + (size_t)(t + 2) * kstep; const char* b2 = last ? nB : cB + (size_t)(t + 2) * kstep;
            const char* a3 = a2 + kstep; const char* b3 = b2 + kstep;
            PG8_LDB(B0, 0, 0); PG8_LDB(B1, 0, 1); PG8_SCHED; PG8_LDA(At, 0, 0); PG8_LDSC(0, t); PG8_STAGE_A(PG8_SA(1, 1), a1 + hstepA, 1, false);
            PG8_WAIT_V(8); PG8_WAIT_L(0); PG8_BAR; PG8_MM(0, 0, At, B0); PG8_MM(0, 1, At, B1); PG8_BAR; PG8_SCHED;
            PG8_LDA(At, 0, 1); PG8_LDSC(1, t); PG8_STAGE(PG8_SB(0, 0), b2, voffB); PG8_STAGE(PG8_SB(0, 1), b2 + hstepB, voffB); PG8_STAGE_A(PG8_SA(0, 0), a2, 0, last);
            PG8_WAIT_V(8); PG8_WAIT_L(0); PG8_BAR; PG8_MM(1, 0, At, B0); PG8_MM(1, 1, At, B1); PG8_BAR; PG8_SCHED;
            PG8_LDB(B0, 1, 0); PG8_LDB(B1, 1, 1); PG8_SCHED; PG8_LDA(At, 1, 0); PG8_LDSC(0, t + 1); PG8_STAGE_A(PG8_SA(0, 1), a2 + hstepA, 1, last);
            PG8_WAIT_V(8); PG8_WAIT_L(0); PG8_BAR; PG8_MM(0, 0, At, B0); PG8_MM(0, 1, At, B1); PG8_BAR; PG8_SCHED;
            PG8_LDA(At, 1, 1); PG8_LDSC(1, t + 1); PG8_STAGE(PG8_SB(1, 0), b3, voffB); PG8_STAGE(PG8_SB(1, 1), b3 + hstepB, voffB); PG8_STAGE_A(PG8_SA(1, 0), a3, 0, last);
            PG8_WAIT_V(8); PG8_WAIT_L(0); PG8_BAR; PG8_MM(1, 0, At, B0); PG8_MM(1, 1, At, B1); PG8_BAR; PG8_SCHED;
        }
        if constexpr (ALIGN_EPI) { if (wr == 0) PG8_BAR; }
        if constexpr (KQ) {
#pragma unroll
            for (int ai = 0; ai < 2; ++ai) { float ss[4] = {0.f, 0.f, 0.f, 0.f};
#pragma unroll 2
                for (int k = 0; k < 16; ++k) { const u32x2 w_ = *(const LAS u32x2*)(lds + SCQ_OFF + scbuf * 8192 + (((k * 2 + ai) * 2 + wr) * 64 + fr * 4) * 2);
                    ss[0] += (float)__builtin_bit_cast(_Float16, (unsigned short)(w_.x & 0xffffu)); ss[1] += (float)__builtin_bit_cast(_Float16, (unsigned short)(w_.x >> 16));
                    ss[2] += (float)__builtin_bit_cast(_Float16, (unsigned short)(w_.y & 0xffffu)); ss[3] += (float)__builtin_bit_cast(_Float16, (unsigned short)(w_.y >> 16)); }
#pragma unroll
                for (int m = 0; m < 4; ++m) { const float corr = 12582912.0f * ss[m];
#pragma unroll
                    for (int bj = 0; bj < 2; ++bj)
#pragma unroll
                        for (int n = 0; n < 2; ++n) acc[ai][bj][m][n] -= corr; } }
        }
        E(acc, cur, wr, wc, fr, fq, pre);
        if (!has_next) break;
#pragma unroll
        for (int a = 0; a < 2; ++a)
#pragma unroll
            for (int b = 0; b < 2; ++b)
#pragma unroll
                for (int m = 0; m < 4; ++m)
#pragma unroll
                    for (int n = 0; n < 2; ++n) acc[a][b][m][n] = (f32x4){0.f, 0.f, 0.f, 0.f};
        cur = nxt; cA = nA; cB = nB; ++ui; scbuf ^= 1;
        E.prefetch(pre, cur, wr, wc, fr, fq);
        if constexpr (GATHER) {
#pragma unroll
            for (int _h = 0; _h < 2; ++_h)
#pragma unroll
                for (int _i = 0; _i < 2; ++_i) vAc[_h][_i] = vAn[_h][_i]; }
        if constexpr (ALIGN_EPI) { if (wr == 1) PG8_BAR; }
    }
    PG8_WAIT_V(0);
    if constexpr (!ALIGN_EPI) { if (wr == 0) PG8_BAR; }
    PG8_BAR;
#undef PG8_SA
#undef PG8_SB
#undef PG8_STAGE
#undef PG8_STAGE_A
#undef PG8_GOFF
#undef PG8_LDA
#undef PG8_LDB
#undef PG8_MMA
#undef PG8_MMAQ2
#undef PG8_MFQ
#undef PG8_MM
#undef PG8_LDSC
#undef PG8_SCDMA
#undef PG8_WAIT_V
#undef PG8_WAIT_L
#undef PG8_BAR
#undef PG8_SCHED
}
}
using pg8::Unit;

constexpr size_t MiB = 1024ull * 1024ull;
constexpr size_t al256(size_t x) { return (x + 255) & ~(size_t)255; }
constexpr size_t WS_COS128 = 0;
constexpr size_t WS_SIN128 = WS_COS128 + 4 * MiB;
constexpr size_t WS_COS128T = WS_SIN128 + 4 * MiB;
constexpr size_t WS_SIN128T = WS_COS128T + 4 * MiB;
constexpr size_t WS_COS64 = WS_SIN128T + 4 * MiB;
constexpr size_t WS_SIN64 = WS_COS64 + 2 * MiB;
constexpr size_t WS_WEV_MAIN = WS_SIN64 + 2 * MiB;
constexpr size_t WS_WEV_SW = WS_WEV_MAIN + 4 * MiB;
constexpr size_t WS_WEVO = WS_WEV_SW + 2 * MiB;
constexpr size_t WS_WGLU = WS_WEVO + 2 * MiB;
constexpr size_t WS_WOD_MAIN = WS_WGLU + 1 * MiB;
constexpr size_t WS_WOD_SW = WS_WOD_MAIN + 6 * MiB;
constexpr size_t WS_WODO = WS_WOD_SW + 4 * MiB;
constexpr size_t WS_WRT = WS_WODO + 2 * MiB;
constexpr size_t WS_WGT = WS_WRT + 128 * 1024;
constexpr size_t WS_S5LAM = WS_WGT + 64 * 1024;
constexpr size_t WS_S5BBAR = WS_S5LAM + 64 * 1024;
constexpr size_t WS_S5KTAB = WS_S5BBAR + 1 * MiB;
constexpr size_t WS_RSTD = WS_S5KTAB + 4 * MiB;
constexpr size_t WS_AFF = WS_RSTD + 128 * 1024;
constexpr size_t WS_TOK = WS_AFF + 2 * MiB;
constexpr size_t WS_GATEL = WS_TOK + 256 * 1024;
constexpr size_t WS_RSTDL = WS_GATEL + 256 * 1024;
constexpr size_t WS_INV = WS_RSTDL + 256 * 1024;
constexpr size_t WS_MLG = WS_INV + 2 * MiB;
constexpr size_t WS_MLEF = WS_MLG + 2 * MiB;
constexpr size_t WS_MLDEN = WS_MLEF + 1 * MiB;
constexpr size_t WS_MLA = WS_MLDEN + 1 * MiB;
constexpr size_t WS_MLN = WS_MLA + 64 * 1024;
constexpr size_t WS_LSE = WS_MLN + 1 * MiB;
constexpr size_t WS_BAR = WS_LSE + 2 * MiB;
constexpr size_t WS_XSC = WS_BAR + 64 * 1024;
constexpr size_t WS_WSC = WS_XSC + 128 * 1024;
constexpr size_t WS_WINSC = WS_WSC + 512 * 1024;
constexpr size_t WS_ACTSC = WS_WINSC + 32 * 1024;
constexpr size_t WS_W2SC = WS_ACTSC + 2 * MiB;
constexpr size_t WS_SMALL_END = WS_W2SC + 64 * 1024;
constexpr size_t WS_XB = al256(WS_SMALL_END);
constexpr size_t WS_HBUF = WS_XB + 64 * MiB;
constexpr size_t WS_W13 = WS_HBUF + 64 * MiB;
constexpr size_t WS_W2 = WS_W13 + 128 * MiB;
constexpr size_t WS_BIG = WS_W2 + 64 * MiB;
constexpr size_t WS_END = WS_BIG + 512 * MiB;
constexpr size_t BG_AXE = WS_BIG;
constexpr size_t BG_ACT = WS_BIG + 128 * MiB;
constexpr size_t BG_YE = WS_BIG + 384 * MiB;
constexpr size_t BG_Q = WS_BIG;
constexpr size_t BG_K = BG_Q + 32 * MiB;
constexpr size_t BG_KT = BG_K + 32 * MiB;
constexpr size_t BG_VT = BG_KT + 32 * MiB;
constexpr size_t BG_G = BG_VT + 32 * MiB;
constexpr size_t BG_A2 = BG_G + 32 * MiB;
constexpr size_t BG_B2 = BG_A2 + 48 * MiB;
constexpr size_t BG_GM = BG_B2 + 24 * MiB;
constexpr size_t BG_XRAW = BG_GM + 8 * MiB;
constexpr size_t BG_OINTRA = BG_XRAW + 32 * MiB;
constexpr size_t BG_KV = BG_OINTRA + 32 * MiB;
constexpr size_t BG_YG = BG_KV + 64 * MiB;
constexpr size_t BG_AOUT = BG_YG + 32 * MiB;
static_assert(BG_AOUT + 64 * MiB <= WS_END, "even scratch");
constexpr size_t BO_CQ = WS_BIG;
constexpr size_t BO_CK = BO_CQ + 48 * MiB;
constexpr size_t BO_CVT = BO_CK + 48 * MiB;
constexpr size_t BO_MQ = BO_CVT + 48 * MiB;
constexpr size_t BO_MK = BO_MQ + 32 * MiB;
constexpr size_t BO_MO = BO_MK + 32 * MiB;
constexpr size_t BO_MKT = BO_MO + 32 * MiB;
constexpr size_t BO_MVT = BO_MKT + 32 * MiB;
constexpr size_t BO_ODIL = BO_MVT + 32 * MiB;
constexpr size_t BO_NUMF = BO_ODIL + 48 * MiB;
constexpr size_t BO_NUMB = BO_NUMF + 32 * MiB;
constexpr size_t BO_KV = BO_NUMB + 32 * MiB;
constexpr size_t BO_AOUT = BO_CQ;
static_assert(BO_KV + 64 * MiB <= WS_END, "odd scratch");

struct Args { const float* in[24]; float* out; unsigned char* ws; int ph_lo, ph_hi; };

__device__ __forceinline__ unsigned q4i8(f32x4 v, float inv) {
    const f32x4 t = v * inv + 12582912.0f;
    const unsigned p01 = __builtin_amdgcn_perm(__float_as_uint(t[1]), __float_as_uint(t[0]), 0x0c0c0400u), p23 = __builtin_amdgcn_perm(__float_as_uint(t[3]), __float_as_uint(t[2]), 0x0c0c0400u);
    return __builtin_amdgcn_perm(p23, p01, 0x05040100u);
}
__device__ __forceinline__ float amax4(f32x4 v) { return fmaxf(fmaxf(fabsf(v[0]), fabsf(v[1])), fmaxf(fabsf(v[2]), fabsf(v[3]))); }
__device__ __forceinline__ float wave_max(float v) { return xmax_rows(row_max(v)); }
typedef f32x4 (&AccT)[2][2][4][2];
#define EPI_NOPRE struct Pre {}; __device__ __forceinline__ void prefetch(Pre&, const Unit&, int, int, int, int) const {}
__device__ __forceinline__ void st4bf(bf16_t* p, f32x4 v) { u32x2 w; w.x = pk2(v[0], v[1]); w.y = pk2(v[2], v[3]); *(u32x2*)p = w; }
__device__ __forceinline__ u32x4 ld8_x2_raw(const bf16_t* pa, const bf16_t* pb, int fq) { return *(const u32x4*)((fq & 1) ? pb - 4 : pa); }
__device__ __forceinline__ void ld8_x2_split(u32x4 L, u32x2& a, u32x2& b) {
    const auto rx = __builtin_amdgcn_permlane16_swap(L.x, L.z, false, false), ry = __builtin_amdgcn_permlane16_swap(L.y, L.w, false, false);
    a = (u32x2){rx[0], ry[0]}; b = (u32x2){rx[1], ry[1]};
}
__device__ __forceinline__ void st4bf_x2(bf16_t* pa, f32x4 va, bf16_t* pb, f32x4 vb, int fq) {
    const auto rx = __builtin_amdgcn_permlane16_swap(pk2(va[0], va[1]), pk2(vb[0], vb[1]), false, false), ry = __builtin_amdgcn_permlane16_swap(pk2(va[2], va[3]), pk2(vb[2], vb[3]), false, false);
    *(u32x4*)((fq & 1) ? pb - 4 : pa) = (u32x4){rx[0], ry[0], rx[1], ry[1]};
}
__device__ __forceinline__ f32x4 ld4bf(const bf16_t* p) { const u32x2 w = *(const u32x2*)p; return (f32x4){lo_bf(w.x), hi_bf(w.x), lo_bf(w.y), hi_bf(w.y)}; }
__device__ __forceinline__ void st_bf16x8(bf16_t* p, f32x4 a, f32x4 b) {
    u32x4 w; w.x = pk2(a[0], a[1]); w.y = pk2(a[2], a[3]); w.z = pk2(b[0], b[1]); w.w = pk2(b[2], b[3]); *(u32x4*)p = w;
}

__device__ __forceinline__ void st_t8(bf16_t* dst, size_t ld, int f0, size_t col, f32x4 a, f32x4 b) {
    const unsigned w0 = pk2(a[0], a[1]), w1 = pk2(a[2], a[3]), w2 = pk2(b[0], b[1]), w3 = pk2(b[2], b[3]);
    bf16_t* p = dst + (size_t)f0 * ld + col;
    p[0] = (bf16_t)(w0 & 0xffffu); p[ld] = (bf16_t)(w0 >> 16); p[2 * ld] = (bf16_t)(w1 & 0xffffu); p[3 * ld] = (bf16_t)(w1 >> 16);
    p[4 * ld] = (bf16_t)(w2 & 0xffffu); p[5 * ld] = (bf16_t)(w2 >> 16); p[6 * ld] = (bf16_t)(w3 & 0xffffu); p[7 * ld] = (bf16_t)(w3 >> 16);
}
constexpr int TSCR_OFF = 131072, TSCR_WAVE = 32 * 24 * 2;
__device__ __forceinline__ void tstage(LAS bf16_t* scr, int fq, int tslot, f32x4 a, f32x4 b) {
    const unsigned w0 = pk2(a[0], a[1]), w1 = pk2(a[2], a[3]), w2 = pk2(b[0], b[1]), w3 = pk2(b[2], b[3]);
    LAS bf16_t* p = scr + (8 * fq) * 24 + tslot;
    p[0] = (bf16_t)(w0 & 0xffffu); p[24] = (bf16_t)(w0 >> 16); p[48] = (bf16_t)(w1 & 0xffffu); p[72] = (bf16_t)(w1 >> 16);
    p[96] = (bf16_t)(w2 & 0xffffu); p[120] = (bf16_t)(w2 >> 16); p[144] = (bf16_t)(w3 & 0xffffu); p[168] = (bf16_t)(w3 >> 16);
}
__device__ __forceinline__ void tdrain16(LAS bf16_t* scr, int lane, bf16_t* dst, size_t ld, int fbase, size_t col0) {
    LDS_WAIT();
    const u32x4 v = *(const LAS u32x4*)(scr + (lane >> 1) * 24 + 8 * (lane & 1));
    *(u32x4*)(dst + (size_t)(fbase + (lane >> 1)) * ld + col0 + 8 * (lane & 1)) = v;
    LDS_WAIT();
}
__device__ __forceinline__ void dequant_acc(AccT acc, const float* rs, const float* cs) {
    f32x4 c[2][2];
#pragma unroll
    for (int bj = 0; bj < 2; ++bj)
#pragma unroll
        for (int n = 0; n < 2; ++n) c[bj][n] = *(const f32x4*)(cs + bj * 128 + n * 4);
#pragma unroll
    for (int ai = 0; ai < 2; ++ai)
#pragma unroll
        for (int m = 0; m < 4; ++m) { const float r = rs[ai * 128 + m * 16];
#pragma unroll
            for (int bj = 0; bj < 2; ++bj)
#pragma unroll
                for (int n = 0; n < 2; ++n)
#pragma unroll
                    for (int j = 0; j < 4; ++j) acc[ai][bj][m][n][j] = (float)__float_as_int(acc[ai][bj][m][n][j]) * (r * c[bj][n][j]); }
}
struct EpiEvenMain {
    static constexpr bool PERM = true; EPI_NOPRE
    bf16_t *q, *k, *g, *a2, *kT, *vT; const float *cosT, *sinT; LAS unsigned char* lds; const float *rsc, *csc;
    __device__ __forceinline__ void operator()(AccT acc, const Unit& u, int wr, int wc, int fr, int fq, const Pre& pre) const {
        const int pn = u.pn, cc0 = wc * 32 + fq * 8;
        dequant_acc(acc, rsc + u.pm * 256 + wr * 64 + fr, csc + pn * 256 + cc0);
        if (pn < 4) {
            bf16_t* dst = (pn < 2) ? q : k; const float sc = (pn < 2) ? 1.0f : 0.08838834764831845f;
            const int head = 2 * (pn & 1) + (cc0 >> 6), i0 = cc0 & 63;
#pragma unroll
            for (int ai = 0; ai < 2; ++ai)
#pragma unroll
                for (int m = 0; m < 4; ++m) {
                    const int t = u.pm * 256 + ai * 128 + wr * 64 + m * 16 + fr, pos = t & (SEQ - 1);
                    const f32x4 c0 = *(const f32x4*)(cosT + pos * 64 + i0), c1 = *(const f32x4*)(cosT + pos * 64 + i0 + 4);
                    const f32x4 s0 = *(const f32x4*)(sinT + pos * 64 + i0), s1 = *(const f32x4*)(sinT + pos * 64 + i0 + 4);
                    const f32x4 x10 = acc[ai][0][m][0], x11 = acc[ai][0][m][1], x20 = acc[ai][1][m][0], x21 = acc[ai][1][m][1];
                    const f32x4 a0 = (x10 * c0 - x20 * s0) * sc, a1 = (x11 * c1 - x21 * s1) * sc, b0 = (x10 * s0 + x20 * c0) * sc, b1 = (x11 * s1 + x21 * c1) * sc;
                    bf16_t* o = dst + (size_t)t * 512 + head * 128 + i0;
                    st_bf16x8(o, a0, a1); st_bf16x8(o + 64, b0, b1);
                    if (pn >= 2) { LAS bf16_t* scr = (LAS bf16_t*)(lds + TSCR_OFF + (wr * 4 + wc) * TSCR_WAVE); const int lane = fq * 16 + fr; const size_t tb = (size_t)(t - fr);
                        const int fb = (2 * (pn & 1) + (wc >> 1)) * 128 + ((wc & 1) * 32);
                        tstage(scr, fq, fr, a0, a1); tdrain16(scr, lane, kT, T, fb, tb);
                        tstage(scr, fq, fr, b0, b1); tdrain16(scr, lane, kT, T, fb + 64, tb); }
                }
        } else if (pn < 6) {
#pragma unroll
            for (int ai = 0; ai < 2; ++ai)
#pragma unroll
                for (int m = 0; m < 4; ++m) {
                    const int t = u.pm * 256 + ai * 128 + wr * 64 + m * 16 + fr;
#pragma unroll
                    for (int bj = 0; bj < 2; ++bj) st_bf16x8(g + (size_t)t * 512 + (pn - 4) * 256 + bj * 128 + cc0, acc[ai][bj][m][0], acc[ai][bj][m][1]);
                }
        } else if (pn < 8) {
#pragma unroll
            for (int ai = 0; ai < 2; ++ai)
#pragma unroll
                for (int m = 0; m < 4; ++m) {
                    const int t = u.pm * 256 + ai * 128 + wr * 64 + m * 16 + fr, mrow = t >> 5, i = t & 31;
#pragma unroll
                    for (int bj = 0; bj < 2; ++bj) { const int ch0 = (pn - 6) * 256 + bj * 128 + cc0, grp = ch0 >> 4, co0 = ch0 & 15;
                        st_bf16x8(a2 + ((size_t)(grp * 1024 + mrow) * 768 + i * 16 + co0), acc[ai][bj][m][0], acc[ai][bj][m][1]); }
                }
        } else {
#pragma unroll
            for (int ai = 0; ai < 2; ++ai)
#pragma unroll
                for (int m = 0; m < 4; ++m) {
                    const int t = u.pm * 256 + ai * 128 + wr * 64 + m * 16 + fr;
#pragma unroll
                    for (int bj = 0; bj < 2; ++bj) { LAS bf16_t* scr = (LAS bf16_t*)(lds + TSCR_OFF + (wr * 4 + wc) * TSCR_WAVE);
                        tstage(scr, fq, fr, acc[ai][bj][m][0], acc[ai][bj][m][1]); tdrain16(scr, fq * 16 + fr, vT, T, (pn - 8) * 256 + bj * 128 + wc * 32, (size_t)(t - fr)); }
                }
        }
    }
};
struct EpiS5A {
    static constexpr bool PERM = false; EPI_NOPRE
    float* xraw;
    __device__ __forceinline__ void operator()(AccT acc, const Unit& u, int wr, int wc, int fr, int fq, const Pre& pre) const {
#pragma unroll
        for (int ai = 0; ai < 2; ++ai)
#pragma unroll
            for (int m = 0; m < 4; ++m) { float* rowp = xraw + (size_t)(u.pm * 256 + ai * 128 + wr * 64 + m * 16 + fr) * 256 + wc * 32 + 4 * fq;
#pragma unroll
                for (int bj = 0; bj < 2; ++bj)
#pragma unroll
                    for (int n = 0; n < 2; ++n) *(f32x4*)(rowp + bj * 128 + n * 16) = acc[ai][bj][m][n]; }
    }
};
struct EpiS5B {
    static constexpr bool PERM = true; EPI_NOPRE
    const bf16_t* a2; const float* dskip; bf16_t* yg;
    __device__ __forceinline__ void operator()(AccT acc, const Unit& u, int wr, int wc, int fr, int fq, const Pre& pre) const {
        const int grp = u.pn >> 1, pnl = u.pn & 1, cc0 = wc * 32 + fq * 8;
#pragma unroll
        for (int ai = 0; ai < 2; ++ai)
#pragma unroll
            for (int m = 0; m < 4; ++m) {
                const int row = u.pm * 256 + ai * 128 + wr * 64 + m * 16 + fr, mr = row & 1023;
#pragma unroll
                for (int bj = 0; bj < 2; ++bj) {
                    const int col = pnl * 256 + bj * 128 + cc0, i = col >> 4, co0 = col & 15;
                    const int t = (mr >> 9) * SEQ + (mr & 511) * 32 + i, ch = grp * 16 + co0;
                    const u32x4 uw = *(const u32x4*)(a2 + (size_t)row * 768 + col);
                    const f32x4 d0 = *(const f32x4*)(dskip + ch), d1 = *(const f32x4*)(dskip + ch + 4);
                    f32x4 y0 = acc[ai][bj][m][0], y1 = acc[ai][bj][m][1];
                    y0[0] += d0[0] * lo_bf(uw.x); y0[1] += d0[1] * hi_bf(uw.x); y0[2] += d0[2] * lo_bf(uw.y); y0[3] += d0[3] * hi_bf(uw.y);
                    y1[0] += d1[0] * lo_bf(uw.z); y1[1] += d1[1] * hi_bf(uw.z); y1[2] += d1[2] * lo_bf(uw.w); y1[3] += d1[3] * hi_bf(uw.w);
#pragma unroll
                    for (int j = 0; j < 4; ++j) { y0[j] = gelu_tanh(y0[j]); y1[j] = gelu_tanh(y1[j]); }
                    st_bf16x8(yg + (size_t)t * 512 + ch, y0, y1);
                }
            }
    }
};
struct EpiGlu {
    static constexpr bool PERM = true; EPI_NOPRE
    const bf16_t* yg; const float* bias; bf16_t* aout;
    __device__ __forceinline__ void operator()(AccT acc, const Unit& u, int wr, int wc, int fr, int fq, const Pre& pre) const {
        const int cc0 = wc * 32 + fq * 8;
#pragma unroll
        for (int ai = 0; ai < 2; ++ai)
#pragma unroll
            for (int m = 0; m < 4; ++m) {
                const int t = u.pm * 256 + ai * 128 + wr * 64 + m * 16 + fr;
#pragma unroll
                for (int bj = 0; bj < 2; ++bj) {
                    const int c = u.pn * 256 + bj * 128 + cc0;
                    const u32x4 yw = *(const u32x4*)(yg + (size_t)t * 512 + c);
                    const f32x4 b0 = *(const f32x4*)(bias + c), b1 = *(const f32x4*)(bias + c + 4);
                    const f32x4 z0 = acc[ai][bj][m][0] + b0, z1 = acc[ai][bj][m][1] + b1;
                    f32x4 o0, o1;
                    o0[0] = lo_bf(yw.x) * sigmoidf_(z0[0]); o0[1] = hi_bf(yw.x) * sigmoidf_(z0[1]); o0[2] = lo_bf(yw.y) * sigmoidf_(z0[2]); o0[3] = hi_bf(yw.y) * sigmoidf_(z0[3]);
                    o1[0] = lo_bf(yw.z) * sigmoidf_(z1[0]); o1[1] = hi_bf(yw.z) * sigmoidf_(z1[1]); o1[2] = lo_bf(yw.w) * sigmoidf_(z1[2]); o1[3] = hi_bf(yw.w) * sigmoidf_(z1[3]);
                    st_bf16x8(aout + (size_t)t * 1024 + 512 + c, o0, o1);
                }
            }
    }
};
template <bool XIN_BF16> struct EpiResid {
    static constexpr bool PERM = true; EPI_NOPRE
    const float* xin32; bf16_t* xb;
    __device__ __forceinline__ void operator()(AccT acc, const Unit& u, int wr, int wc, int fr, int fq, const Pre& pre) const {
        const int c0 = u.pn * 256 + wc * 32 + 8 * fq;
#pragma unroll
        for (int ai = 0; ai < 2; ++ai)
#pragma unroll
            for (int m = 0; m < 4; ++m) { const size_t off = (size_t)(u.pm * 256 + ai * 128 + wr * 64 + m * 16 + fr) * 1024 + c0;
#pragma unroll
                for (int bj = 0; bj < 2; ++bj) { f32x4 x0, x1;
                    if (XIN_BF16) { const u32x4 w = *(const u32x4*)(xb + off + bj * 128); x0 = (f32x4){lo_bf(w.x), hi_bf(w.x), lo_bf(w.y), hi_bf(w.y)}; x1 = (f32x4){lo_bf(w.z), hi_bf(w.z), lo_bf(w.w), hi_bf(w.w)}; }
                    else { x0 = __builtin_nontemporal_load((const f32x4*)(xin32 + off + bj * 128)); x1 = __builtin_nontemporal_load((const f32x4*)(xin32 + off + bj * 128 + 4)); }
                    st_bf16x8(xb + off + bj * 128, x0 + acc[ai][bj][m][0], x1 + acc[ai][bj][m][1]); }
                asm volatile("" ::: "memory"); }
    }
};
struct EpiOddMain {
    static constexpr bool PERM = true; EPI_NOPRE
    unsigned char* ws; const float *cosT, *sinT; LAS unsigned char* lds; const float *rsc, *csc;
    __device__ __forceinline__ void operator()(AccT acc, const Unit& u, int wr, int wc, int fr, int fq, const Pre& pre) const {
        asm volatile("" : "+v"(fr), "+v"(fq));
        const int pn = u.pn, cc0 = wc * 32 + fq * 8;
        dequant_acc(acc, rsc + u.pm * 256 + wr * 64 + fr, csc + pn * 256 + cc0);
        if (pn < 6) {
            bf16_t* dst = (bf16_t*)(ws + (pn < 3 ? BO_CQ : BO_CK)); const int grp = pn < 3 ? pn : pn - 3, sh = 2 * grp, hh = wc, i0 = fq * 8;
#pragma unroll
            for (int ai = 0; ai < 2; ++ai)
#pragma unroll
                for (int m = 0; m < 4; ++m) {
                    const int t = u.pm * 256 + ai * 128 + wr * 64 + m * 16 + fr, pos = t & (SEQ - 1), b = t >> 14;
                    const int pp = (pos & ((1 << sh) - 1)) * (SEQ >> sh) + (pos >> sh);
                    const f32x4 c0 = *(const f32x4*)(cosT + pos * 32 + i0), c1 = *(const f32x4*)(cosT + pos * 32 + i0 + 4);
                    const f32x4 s0 = *(const f32x4*)(sinT + pos * 32 + i0), s1 = *(const f32x4*)(sinT + pos * 32 + i0 + 4);
                    const f32x4 x10 = acc[ai][0][m][0], x11 = acc[ai][0][m][1], x20 = acc[ai][1][m][0], x21 = acc[ai][1][m][1];
                    bf16_t* o = dst + ((size_t)(grp * 4 + hh) * T + b * SEQ + pp) * 64 + i0;
                    st_bf16x8(o, x10 * c0 - x20 * s0, x11 * c1 - x21 * s1);
                    st_bf16x8(o + 32, x10 * s0 + x20 * c0, x11 * s1 + x21 * c1);
                }
        } else if (pn < 12) {
            const size_t boff = (pn < 8) ? BO_MQ : (pn < 10 ? BO_MK : BO_MO);
            bf16_t* dst = (bf16_t*)(ws + boff); bf16_t* mkT = (bf16_t*)(ws + BO_MKT); const bool isk = (pn >= 8 && pn < 10); const float sc = isk ? 0.08838834764831845f : 1.0f;
            const int cb = (pn & 1) * 256;
#pragma unroll
            for (int ai = 0; ai < 2; ++ai)
#pragma unroll
                for (int m = 0; m < 4; ++m) {
                    const int t = u.pm * 256 + ai * 128 + wr * 64 + m * 16 + fr;
#pragma unroll
                    for (int bj = 0; bj < 2; ++bj) { const f32x4 v0 = acc[ai][bj][m][0] * sc, v1 = acc[ai][bj][m][1] * sc;
                        st_bf16x8(dst + (size_t)t * 512 + cb + bj * 128 + cc0, v0, v1);
                        if (isk) { LAS bf16_t* scr = (LAS bf16_t*)(lds + TSCR_OFF + (wr * 4 + wc) * TSCR_WAVE); tstage(scr, fq, fr, v0, v1); tdrain16(scr, fq * 16 + fr, mkT, T, cb + bj * 128 + wc * 32, (size_t)(t - fr)); } }
                }
        } else if (pn < 14) {
            bf16_t* mvT = (bf16_t*)(ws + BO_MVT); const int cb = (pn - 12) * 256;
#pragma unroll
            for (int ai = 0; ai < 2; ++ai)
#pragma unroll
                for (int m = 0; m < 4; ++m) {
                    const int t = u.pm * 256 + ai * 128 + wr * 64 + m * 16 + fr;
#pragma unroll
                    for (int bj = 0; bj < 2; ++bj) { LAS bf16_t* scr = (LAS bf16_t*)(lds + TSCR_OFF + (wr * 4 + wc) * TSCR_WAVE);
                        tstage(scr, fq, fr, acc[ai][bj][m][0], acc[ai][bj][m][1]); tdrain16(scr, fq * 16 + fr, mvT, T, cb + bj * 128 + wc * 32, (size_t)(t - fr)); }
                }
        } else {
            bf16_t* cvT = (bf16_t*)(ws + BO_CVT); const int grp = pn - 14, sh = 2 * grp;
            if (grp == 2) {
#pragma unroll
                for (int ai = 0; ai < 2; ++ai) {
                    const int t0 = u.pm * 256 + ai * 128 + wr * 64 + fr, pos = t0 & (SEQ - 1), b = t0 >> 14;
                    const size_t colb = (size_t)b * SEQ + (size_t)(pos & 15) * (SEQ >> 4) + (pos >> 4);
#pragma unroll
                    for (int bj = 0; bj < 2; ++bj)
#pragma unroll
                        for (int n = 0; n < 2; ++n)
#pragma unroll
                            for (int j = 0; j < 4; ++j) { u32x2 w; w.x = pk2(acc[ai][bj][0][n][j], acc[ai][bj][1][n][j]); w.y = pk2(acc[ai][bj][2][n][j], acc[ai][bj][3][n][j]);
                                *(u32x2*)(cvT + (size_t)(512 + bj * 128 + cc0 + 4 * n + j) * T + colb) = w; }
                }
            } else { u32x4 ve[2];
#pragma unroll
            for (int ai = 0; ai < 2; ++ai)
#pragma unroll
                for (int m = 0; m < 4; ++m) {
                    const int t = u.pm * 256 + ai * 128 + wr * 64 + m * 16 + fr, pos = t & (SEQ - 1), b = t >> 14;
                    const int pp = (pos & ((1 << sh) - 1)) * (SEQ >> sh) + (pos >> sh);
#pragma unroll
                    for (int bj = 0; bj < 2; ++bj) {
                        { LAS bf16_t* scr = (LAS bf16_t*)(lds + TSCR_OFF + (wr * 4 + wc) * TSCR_WAVE); const int lane = fq * 16 + fr, fb = grp * 256 + bj * 128 + wc * 32, pos0 = pos - fr;
                            if (grp == 0) { tstage(scr, fq, fr, acc[ai][bj][m][0], acc[ai][bj][m][1]); tdrain16(scr, lane, cvT, T, fb, (size_t)b * SEQ + pos0); }
                            else { tstage(scr, fq, (fr & 3) * 4 + (fr >> 2), acc[ai][bj][m][0], acc[ai][bj][m][1]); LDS_WAIT();
                                const u32x4 v = *(const LAS u32x4*)(scr + (lane >> 1) * 24 + 8 * (lane & 1)); LDS_WAIT();
                                if (!(m & 1)) ve[bj] = v;
                                else { bf16_t* rowp = cvT + (size_t)(fb + (lane >> 1)) * T + (size_t)b * SEQ + ((pos0 - 16) >> 2);
                                    *(u32x4*)(rowp + (size_t)(2 * (lane & 1)) * (SEQ >> 2)) = (u32x4){ve[bj].x, ve[bj].y, v.x, v.y}; *(u32x4*)(rowp + (size_t)(2 * (lane & 1) + 1) * (SEQ >> 2)) = (u32x4){ve[bj].z, ve[bj].w, v.z, v.w}; } } } }
                }
            }
        }
    }
};
constexpr int RED_OFF = 131072;
struct EpiMoe1 {
    static constexpr bool PERM = true;
    signed char* actq; unsigned short* actsc; const float* rowf; const float* wsc; LAS unsigned char* lds;
    struct Pre { float rs[2][4]; };
    __device__ __forceinline__ void prefetch(Pre& p, const Unit& u, int wr, int wc, int fr, int fq) const {
#pragma unroll
        for (int ai = 0; ai < 2; ++ai)
#pragma unroll
            for (int m = 0; m < 4; ++m) p.rs[ai][m] = rowf[u.pm * 256 + ai * 128 + wr * 64 + m * 16 + fr];
    }
    __device__ __forceinline__ void operator()(AccT acc, const Unit& u, int wr, int wc, int fr, int fq, const Pre& pre) const {
        asm volatile("" : "+v"(fr), "+v"(fq));
        const int kb = u.pn & 15;
        const float* w = wsc + (size_t)u.pn * 256 + wc * 32 + fq * 8;
        f32x4 wa[2], wg[2]; wa[0] = *(const f32x4*)w; wa[1] = *(const f32x4*)(w + 4); wg[0] = *(const f32x4*)(w + 128); wg[1] = *(const f32x4*)(w + 132);
        LAS float* red = (LAS float*)(lds + RED_OFF);
#pragma unroll
        for (int ai = 0; ai < 2; ++ai)
#pragma unroll
            for (int m = 0; m < 4; ++m) {
                const float rs = pre.rs[ai][m]; f32x4 o0, o1; float mm = 0.f;
#pragma unroll
                for (int j = 0; j < 4; ++j) {
                    const float a0 = (float)__float_as_int(acc[ai][0][m][0][j]) * (rs * wa[0][j]), g0 = (float)__float_as_int(acc[ai][1][m][0][j]) * (rs * wg[0][j]);
                    const float a1 = (float)__float_as_int(acc[ai][0][m][1][j]) * (rs * wa[1][j]), g1 = (float)__float_as_int(acc[ai][1][m][1][j]) * (rs * wg[1][j]);
                    o0[j] = a0 * g0 * __builtin_amdgcn_rcpf(1.0f + __builtin_amdgcn_exp2f(-a0)); o1[j] = a1 * g1 * __builtin_amdgcn_rcpf(1.0f + __builtin_amdgcn_exp2f(-a1)); mm = fmaxf(mm, fmaxf(fabsf(o0[j]), fabsf(o1[j]))); }
                acc[ai][0][m][0] = o0; acc[ai][0][m][1] = o1;
                mm = xmax_rows(mm);
                if (fq == 0) red[(ai * 128 + wr * 64 + m * 16 + fr) * 4 + wc] = mm;
            }
        LDS_WAIT(); __builtin_amdgcn_s_barrier();
        unsigned short shb[4]; u32x2 qe;
#pragma unroll
        for (int ai = 0; ai < 2; ++ai)
#pragma unroll
            for (int m = 0; m < 4; ++m) {
                const int rl = ai * 128 + wr * 64 + m * 16 + fr; const size_t row = (size_t)u.pm * 256 + rl;
                const f32x4 r4 = *(const LAS f32x4*)(red + rl * 4);
                const _Float16 sh = (_Float16)(fmaxf(fmaxf(r4[0], r4[1]), fmaxf(r4[2], r4[3])) * (1.0f / 127.0f)); const float sf = (float)sh, inv = sf > 0.f ? __builtin_amdgcn_rcpf(sf) : 0.f;
                u32x2 q; q.x = q4i8(acc[ai][0][m][0], inv); q.y = q4i8(acc[ai][0][m][1], inv);
                if (!(m & 1)) qe = q;
                else { const auto rx = __builtin_amdgcn_permlane16_swap(qe.x, q.x, false, false), ry = __builtin_amdgcn_permlane16_swap(qe.y, q.y, false, false);
                    signed char* pa = actq + (row - 16) * FF + kb * 128 + wc * 32 + fq * 8;
                    *(u32x4*)((fq & 1) ? pa + 16 * FF - 8 : pa) = (u32x4){rx[0], ry[0], rx[1], ry[1]}; }
                shb[m] = __builtin_bit_cast(unsigned short, sh);
                if (m == 3 && wc == 0 && fq == 0)
                    *(u32x2*)(actsc + (size_t)u.pm * 4096 + (((kb * 2 + ai) * 2 + wr) * 64 + fr * 4)) = (u32x2){(unsigned)shb[0] | ((unsigned)shb[1] << 16), (unsigned)shb[2] | ((unsigned)shb[3] << 16)};
            }
    }
};
struct EpiMoe2 {
    static constexpr bool PERM = true;
    bf16_t* ye; const float* gate; const float* w2sc;
    EPI_NOPRE
    __device__ __forceinline__ void operator()(AccT acc, const Unit& u, int wr, int wc, int fr, int fq, const Pre& pre) const {
        asm volatile("" : "+v"(fr), "+v"(fq));
        const int c0 = (u.pn & 3) * 256 + wc * 32 + fq * 8;
        const float* cs = w2sc + (size_t)u.pn * 256 + wc * 32 + fq * 8; f32x4 c[2][2];
#pragma unroll
        for (int bj = 0; bj < 2; ++bj) { c[bj][0] = *(const f32x4*)(cs + bj * 128); c[bj][1] = *(const f32x4*)(cs + bj * 128 + 4); }
#pragma unroll
        for (int ai = 0; ai < 2; ++ai)
#pragma unroll
            for (int m = 0; m < 4; ++m) {
                const int row = u.pm * 256 + ai * 128 + wr * 64 + m * 16 + fr; const float gt = gate[row];
#pragma unroll
                for (int bj = 0; bj < 2; ++bj) st_bf16x8(ye + (size_t)row * DM + c0 + bj * 128, acc[ai][bj][m][0] * (c[bj][0] * gt), acc[ai][bj][m][1] * (c[bj][1] * gt));
            }
    }
};

typedef const __attribute__((address_space(4))) void* KargP;
template <int OFF> __device__ __forceinline__ const GAS float* ldarg_ptr(KargP kp) { unsigned long long v; asm volatile("s_load_dwordx2 %0, %1, %2\n\ts_waitcnt lgkmcnt(0)" : "=s"(v) : "s"(kp), "n"(OFF)); return (const GAS float*)v; }
struct Ctx { KargP kp; GAS float* out; GAS unsigned char* ws; LAS unsigned char* lds; int tid, lane, wave, bid, G; };
#define INP(i) ((const float*)ldarg_ptr<8 * (i)>(C.kp))
#define WSP(T_, off) ((T_*)(C.ws + (off)))

constexpr int TR_SCR = 64 * 65 * 4;
__device__ __forceinline__ void tr_item(const float* W, int ldw, int colA, int colB, bf16_t* WT, int ldt, size_t row0, int k0, LAS float* scr, int lane, const float* kscale = nullptr) {
    const float* src = W + (size_t)k0 * ldw + (lane < 32 ? colA : colB) + (lane & 31);
#pragma unroll
    for (int hb = 0; hb < 2; ++hb) {
        float v[32];
#pragma unroll
        for (int i = 0; i < 32; ++i) v[i] = __builtin_nontemporal_load(src + (size_t)(hb * 32 + i) * ldw);
#pragma unroll
        for (int i = 0; i < 32; ++i) scr[(hb * 32 + i) * 65 + lane] = kscale ? v[i] * kscale[k0 + hb * 32 + i] : v[i];
    }
    LDS_WAIT();
    const int c = lane & 7;
#pragma unroll
    for (int j = 0; j < 8; ++j) { const int n = (lane >> 3) + 8 * j; const LAS float* s = scr + (8 * c) * 65 + n;
        u32x4 o; o.x = pk2(s[0 * 65], s[1 * 65]); o.y = pk2(s[2 * 65], s[3 * 65]); o.z = pk2(s[4 * 65], s[5 * 65]); o.w = pk2(s[6 * 65], s[7 * 65]);
        __builtin_nontemporal_store(o, (u32x4*)(WT + (row0 + n) * ldt + k0 + 8 * c)); }
    LDS_WAIT();
}
__device__ __forceinline__ int col_ev_main(int rg) { const int tile = rg >> 3, w = rg & 7;
    if (tile < 4) { const int base = (tile < 2 ? 0 : 512) + (tile & 1) * 256; return base + ((w & 3) >> 1) * 128 + (w >> 2) * 64 + (w & 1) * 32; }
    if (tile < 6) return 1536 + (tile - 4) * 256 + w * 32;
    if (tile < 8) return 2048 + (tile - 6) * 256 + w * 32;
    return 1024 + (tile - 8) * 256 + w * 32; }
__device__ __forceinline__ int col_od_main(int rg) { const int tile = rg >> 3, w = rg & 7;
    if (tile < 6) { const int base = (tile < 3 ? 0 : 768), g = tile % 3; return base + g * 256 + (w & 3) * 64 + (w >> 2) * 32; }
    if (tile < 8) return 2304 + (tile - 6) * 256 + w * 32;
    if (tile < 10) return 2816 + (tile - 8) * 256 + w * 32;
    if (tile < 12) return 3840 + (tile - 10) * 256 + w * 32;
    if (tile < 14) return 3328 + (tile - 12) * 256 + w * 32;
    return 1536 + (tile - 14) * 256 + w * 32; }

__device__ __forceinline__ void conv_small_weights(const Ctx& C) {
    LAS float* scr = (LAS float*)(C.lds + C.wave * TR_SCR);
    const int gw = C.bid * NWAVES + C.wave, NGW = C.G * NWAVES;
    constexpr int I0 = 0, I1 = 0, I2 = 16 * 16, I3 = 8 * 8, I4 = 0, I5 = 0, I6 = 16 * 12;
    constexpr int NI = I0 + I1 + I2 + I3 + I4 + I5 + I6;
    const float *p5 = INP(5), *p14 = INP(14), *p17 = INP(17);
    for (int it = gw; it < NI; it += NGW) {
        int r = it;
        if (r < I2) { const int rp = r >> 4, kb = r & 15; tr_item(p5, 1024, rp * 64, rp * 64 + 32, WSP(bf16_t, WS_WEVO), 1024, (size_t)rp * 64, kb * 64, scr, C.lane); continue; } r -= I2;
        if (r < I3) { const int rp = r >> 3, kb = r & 7; tr_item(p14, 512, rp * 64, rp * 64 + 32, WSP(bf16_t, WS_WGLU), 512, (size_t)rp * 64, kb * 64, scr, C.lane); continue; } r -= I3;
        { const int rp = r / 12, kb = r % 12; tr_item(p17, 1024, rp * 64, rp * 64 + 32, WSP(bf16_t, WS_WODO), 768, (size_t)rp * 64, kb * 64, scr, C.lane); }
    }
}
constexpr int CONV_BLK_ITEMS = 1536;
template <bool GK, int NCOL = 64>
__device__ __forceinline__ void wq_block_core(const Ctx& C, const float* src, size_t ldw, const float* gk, signed char* base, float* sc0, float scmul = 1.0f) {
    constexpr int NC4 = NCOL / 4, RB = (512 / NC4) * 32, CPR = RB / 16;
    const int c4 = C.tid % NC4, kb = C.tid / NC4;
    LAS float* red = (LAS float*)C.lds;
    f32x4 v[32]; f32x4 mx = (f32x4){0.f, 0.f, 0.f, 0.f};
#pragma unroll
    for (int bt = 0; bt < 4; ++bt) {
#pragma unroll
        for (int i = 0; i < 8; ++i) v[bt * 8 + i] = __builtin_nontemporal_load((const f32x4*)(src + (size_t)(bt * 8 + i) * ldw));
        __builtin_amdgcn_sched_barrier(0);
    }
#pragma unroll
    for (int i = 0; i < 32; ++i) { if (GK) v[i] *= gk[i];
#pragma unroll
        for (int c = 0; c < 4; ++c) mx[c] = fmaxf(mx[c], fabsf(v[i][c])); }
#pragma unroll
    for (int c = 0; c < 4; ++c) { if (NC4 == 8) mx[c] = fmaxf(mx[c], dppf<0x128>(mx[c])); mx[c] = xmax_rows(mx[c]); }
    __syncthreads();
    if (C.lane < NC4) *(LAS f32x4*)(red + C.wave * NCOL + c4 * 4) = mx;
    __syncthreads();
    f32x4 cm = (f32x4){0.f, 0.f, 0.f, 0.f};
#pragma unroll
    for (int w = 0; w < 8; ++w) { const f32x4 r = *(const LAS f32x4*)(red + w * NCOL + c4 * 4);
#pragma unroll
        for (int c = 0; c < 4; ++c) cm[c] = fmaxf(cm[c], r[c]); }
    if (kb == 0) *(f32x4*)(sc0 + c4 * 4) = cm * ((1.0f / 127.0f) * scmul);
    LAS unsigned char* img = C.lds + 4096;
#pragma unroll
    for (int c = 0; c < 4; ++c) { const int n = c4 * 4 + c; const float inv = cm[c] > 0.f ? 127.0f / cm[c] : 0.f;
#pragma unroll
        for (int h = 0; h < 2; ++h) { u32x4 w;
#pragma unroll
            for (int d = 0; d < 4; ++d) { const int b0 = h * 16 + d * 4; w[d] = q4i8((f32x4){v[b0][c], v[b0 + 1][c], v[b0 + 2][c], v[b0 + 3][c]}, inv); }
            *(LAS u32x4*)(img + n * RB + (((kb * 2 + h) ^ n) * 16)) = w; } }
    __syncthreads();
#pragma unroll
    for (int i = 0; i < 8; ++i) { const int j = i * 512 + C.tid, n = j / CPR, pch = j % CPR;
        const u32x4 w = *(const LAS u32x4*)(img + j * 16);
        *(u32x4*)(base + (size_t)n * RB + ((pch ^ n) * 16)) = w; }
}
__device__ __forceinline__ void w13q_block_item(const Ctx& C, int layer, int it) {
    const int e = it >> 6, half = (it >> 5) & 1, cg = it & 31, c4 = C.tid & 15, kb = C.tid >> 4;
    const float* src = (half ? INP(22) : INP(21)) + (size_t)layer * NE * DM * FF + (size_t)e * DM * FF + (size_t)(kb * 32) * FF + cg * 64 + c4 * 4;
    const float* gk = INP(2) + layer * DM + kb * 32;
    const int nrow0 = ((cg * 64) >> 7) * 256 + half * 128 + ((cg * 64) & 127);
    wq_block_core<true>(C, src, FF, gk, (signed char*)(C.ws + WS_W13) + (size_t)layer * (64 * MiB) + ((size_t)e * 4096 + nrow0) * 1024,
                        WSP(float, WS_WSC) + (size_t)(layer * 16 + e) * 4096 + nrow0, half ? 0.6931471805599453f : 1.4426950408889634f);
}
constexpr int WIN_BLK_ITEMS = 108;
__device__ __forceinline__ void winq_block_item(const Ctx& C, int it) {
    const bool od = it >= 40; const int rp = od ? it - 40 : it, n0 = (C.tid & 15) * 4, kb = C.tid >> 4;
    const int rg = 2 * rp + (n0 >> 5), colg = od ? col_od_main(rg) : col_ev_main(rg); const size_t ldw = od ? 4368 : 2560;
    const float* src = (od ? INP(16) : INP(4)) + (size_t)(kb * 32) * ldw + colg + (n0 & 31);
    wq_block_core<false>(C, src, ldw, nullptr, (signed char*)(C.ws + (od ? WS_WOD_MAIN : WS_WEV_MAIN)) + (size_t)(rp * 64) * 1024, WSP(float, WS_WINSC) + (od ? 2560 : 0) + rp * 64);
}
__device__ __forceinline__ void w2q_block_item(const Ctx& C, int layer, int it) {
    const int e = it >> 5, cgp = it & 31, kb = C.tid >> 3;
    const float* src = INP(23) + (size_t)layer * NE * FF * DM + (size_t)e * FF * DM + (size_t)(kb * 32) * DM + cgp * 32 + (C.tid & 7) * 4;
    wq_block_core<false, 32>(C, src, DM, nullptr, (signed char*)(C.ws + WS_W2) + ((size_t)e * 1024 + cgp * 32) * 2048, WSP(float, WS_W2SC) + e * 1024 + cgp * 32);
}
__device__ __forceinline__ void conv_moe_weights(const Ctx& C, int layer, int it_lo, int it_hi, int blk_lo) {
    if (C.bid < blk_lo) return;
    for (int it = it_lo + (C.bid - blk_lo); it < it_hi; it += C.G - blk_lo) {
        Ctx Ci = C; asm volatile("" : "+v"(Ci.tid));
        if (it < 1024) w13q_block_item(Ci, layer, it);
        else w2q_block_item(Ci, layer, it - 1024);
    }
    __syncthreads();
}
__device__ __forceinline__ void prep_tables(const Ctx& C) {
    const int gt = C.bid * NTHREADS + C.tid, NGT = C.G * NTHREADS;
    float *c128 = WSP(float, WS_COS128), *s128 = WSP(float, WS_SIN128), *c64 = WSP(float, WS_COS64), *s64 = WSP(float, WS_SIN64);
    for (int idx = gt; idx < SEQ * 64; idx += NGT) {
        const int pos = idx >> 6, i = idx & 63;
        double inv = 1.0; for (int k = 0; k < i; ++k) inv *= 0.8659643233600653;
        const float ang = (float)pos * (float)inv; float s, c; sincos_d((double)ang, s, c);
        c128[idx] = c; s128[idx] = s;
        if (i < 32) { double inv2 = 1.0; for (int k = 0; k < i; ++k) inv2 *= 0.7498942093324559;
            const float ang2 = (float)pos * (float)inv2; sincos_d((double)ang2, s, c); c64[pos * 32 + i] = c; s64[pos * 32 + i] = s; }
    }
    float* wrt = WSP(float, WS_WRT); float* wgt = WSP(float, WS_WGT);
    const float *p1 = INP(1), *p2 = INP(2), *p16 = INP(16), *p20 = INP(20), *p6 = INP(6), *p7 = INP(7), *p8 = INP(8), *p9 = INP(9), *p12 = INP(12);
    for (int idx = gt; idx < 2 * 16 * 1024; idx += NGT) { const int l = idx >> 14, e = (idx >> 10) & 15, k = idx & 1023; wrt[idx] = p2[l * 1024 + k] * p20[(size_t)l * 1024 * 16 + k * 16 + e]; }
    for (int idx = gt; idx < 16 * 1024; idx += NGT) { const int c = idx >> 10, k = idx & 1023; wgt[idx] = p1[1024 + k] * p16[(size_t)k * 4368 + 4352 + c]; }
    float* lam = WSP(float, WS_S5LAM); float* bbar = WSP(float, WS_S5BBAR);
    for (int idx = gt; idx < 2 * 32 * 64; idx += NGT) {
        const int dg = idx >> 6;
        const float are = p6[idx], aim = p7[idx], step = __expf(p12[dg]);
        const float xr = are * step; const double th = (double)aim * (double)step;
        float s, c, sh, ch; sincos_d(th, s, c); sincos_d(0.5 * th, sh, ch);
        const float em1 = expm1f(xr), mag = em1 + 1.0f;
        const float nr = em1 * c - 2.0f * sh * sh, ni = mag * s;
        const float den = are * are + aim * aim;
        const float fr = (nr * are + ni * aim) / den, fi = (ni * are - nr * aim) / den;
        lam[idx * 2] = xr; lam[idx * 2 + 1] = (float)th;
        for (int ci = 0; ci < 16; ++ci) { const float br = p8[idx * 16 + ci], bi = p9[idx * 16 + ci];
            bbar[(idx * 16 + ci) * 2] = fr * br - fi * bi; bbar[(idx * 16 + ci) * 2 + 1] = fr * bi + fi * br; }
    }
}
__device__ __forceinline__ void apow(const float* lam, int idx, int m, float& re, float& im) {
    const float xr = lam[idx * 2], th = lam[idx * 2 + 1]; float s, c; sincos_d((double)m * (double)th, s, c);
    const float mag = __expf((float)m * xr); re = mag * c; im = mag * s;
}
__device__ __forceinline__ void rmsnorm_rows(const Ctx& C, const float* x, const float* g, unsigned* hq, float* hsc) {
    const int gw = C.bid * NWAVES + C.wave, NGW = C.G * NWAVES;
    f32x4 gv[4];
#pragma unroll
    for (int j = 0; j < 4; ++j) gv[j] = *(const f32x4*)(g + j * 256 + C.lane * 4);
    for (int r = gw; r < T; r += 2 * NGW) {
        const int r2 = (r + NGW < T) ? r + NGW : r; f32x4 v[4], u[4]; float s = 0.f, s2 = 0.f, m = 0.f, m2 = 0.f;
#pragma unroll
        for (int j = 0; j < 4; ++j) { v[j] = __builtin_nontemporal_load((const f32x4*)(x + (size_t)r * DM + j * 256 + C.lane * 4)); u[j] = __builtin_nontemporal_load((const f32x4*)(x + (size_t)r2 * DM + j * 256 + C.lane * 4)); }
#pragma unroll
        for (int j = 0; j < 4; ++j) { s += v[j][0] * v[j][0] + v[j][1] * v[j][1] + v[j][2] * v[j][2] + v[j][3] * v[j][3]; s2 += u[j][0] * u[j][0] + u[j][1] * u[j][1] + u[j][2] * u[j][2] + u[j][3] * u[j][3];
            v[j] *= gv[j]; u[j] *= gv[j]; m = fmaxf(m, amax4(v[j])); m2 = fmaxf(m2, amax4(u[j])); }
        const float rstd = rsqrtf(wave_sum(s) * (1.0f / DM) + 1e-6f), rstd2 = rsqrtf(wave_sum(s2) * (1.0f / DM) + 1e-6f);
        m = wave_max(m); m2 = wave_max(m2);
        const float inv = m > 0.f ? 127.0f / m : 0.f, inv2 = m2 > 0.f ? 127.0f / m2 : 0.f;
#pragma unroll
        for (int j = 0; j < 4; ++j) { hq[(size_t)r * 256 + j * 64 + C.lane] = q4i8(v[j], inv); hq[(size_t)r2 * 256 + j * 64 + C.lane] = q4i8(u[j], inv2); }
        if (C.lane == 0) { hsc[r] = m * rstd * (1.0f / 127.0f); hsc[r2] = m2 * rstd2 * (1.0f / 127.0f); }
    }
}
constexpr int SC = 32, SCL = 5, SK = SC * 16, SLD = SK + 256, NCH = SEQ / SC, SROWS = 2 * NCH;
__device__ __forceinline__ void s5_ktab(const Ctx& C) {
    LAS float* W = (LAS float*)C.lds;
    const float* lam = WSP(float, WS_S5LAM); const float* bbar = WSP(float, WS_S5BBAR); float* kt = WSP(float, WS_S5KTAB);
    const float *p10 = INP(10), *p11 = INP(11);
    for (int it = C.bid; it < 2 * 32 * SC; it += C.G) {
        const int dg = it >> SCL, d = it & (SC - 1), dir = dg >> 5, g = dg & 31;
        __syncthreads();
        if (C.tid < 64) { float re, im; apow(lam, dg * 64 + C.tid, d, re, im); W[C.tid * 2] = re; W[C.tid * 2 + 1] = im; }
        __syncthreads();
        if (C.tid < 256) { const int co = C.tid >> 4, ci = C.tid & 15; float acc = 0.f;
            const float* cr = p10 + (size_t)(dg * 16 + co) * 64; const float* cim = p11 + (size_t)(dg * 16 + co) * 64;
#pragma unroll 16
            for (int p = 0; p < 64; ++p) { const float wr = W[p * 2], wi = W[p * 2 + 1]; const float br = bbar[((dg * 64 + p) * 16 + ci) * 2], bi = bbar[((dg * 64 + p) * 16 + ci) * 2 + 1];
                const float xr = wr * br - wi * bi, xi = wr * bi + wi * br; acc += cr[p] * xr - cim[p] * xi; }
            kt[((size_t)(g * 2 + dir) * SC + d) * 256 + C.tid] = acc; }
    }
}
__device__ __forceinline__ void s5_gmat(const Ctx& C) {
    const int gt = C.bid * NTHREADS + C.tid, NGT = C.G * NTHREADS;
    const float* lam = WSP(float, WS_S5LAM); const float* bbar = WSP(float, WS_S5BBAR); bf16_t* gm = WSP(bf16_t, BG_GM);
    for (int idx = gt; idx < 32 * 2 * 64 * SC; idx += NGT) {
        const int j = idx & (SC - 1), p = (idx >> SCL) & 63, dir = (idx >> (SCL + 6)) & 1, g = idx >> (SCL + 7), dgp = (dir * 32 + g) * 64 + p;
        float wr, wi; apow(lam, dgp, dir == 0 ? SC - 1 - j : j, wr, wi);
        float xr[16], xi[16];
#pragma unroll
        for (int ci = 0; ci < 16; ++ci) { const float br = bbar[(dgp * 16 + ci) * 2], bi = bbar[(dgp * 16 + ci) * 2 + 1]; xr[ci] = wr * br - wi * bi; xi[ci] = wr * bi + wi * br; }
        bf16_t* r0 = gm + ((size_t)(g * 256 + dir * 128 + p)) * SK + j * 16; bf16_t* r1 = r0 + (size_t)64 * SK;
        st_bf16x8(r0, (f32x4){xr[0], xr[1], xr[2], xr[3]}, (f32x4){xr[4], xr[5], xr[6], xr[7]}); st_bf16x8(r0 + 8, (f32x4){xr[8], xr[9], xr[10], xr[11]}, (f32x4){xr[12], xr[13], xr[14], xr[15]});
        st_bf16x8(r1, (f32x4){xi[0], xi[1], xi[2], xi[3]}, (f32x4){xi[4], xi[5], xi[6], xi[7]}); st_bf16x8(r1 + 8, (f32x4){xi[8], xi[9], xi[10], xi[11]}, (f32x4){xi[12], xi[13], xi[14], xi[15]});
    }
}
__device__ __forceinline__ void s5_b2mat(const Ctx& C) {
    const int gt = C.bid * NTHREADS + C.tid, NGT = C.G * NTHREADS;
    const float* lam = WSP(float, WS_S5LAM); const float* kt = WSP(float, WS_S5KTAB); bf16_t* b2 = WSP(bf16_t, BG_B2);
    const float *p10 = INP(10), *p11 = INP(11);
    for (int idx = gt; idx < 32 * SC * 16 * 2 * 8; idx += NGT) {
        const int pc = idx & 7, dir = (idx >> 3) & 1, co = (idx >> 4) & 15, i = (idx >> 8) & (SC - 1), g = idx >> (8 + SCL), dg = dir * 32 + g;
        const float* cr = p10 + (size_t)(dg * 16 + co) * 64 + pc * 8; const float* cim = p11 + (size_t)(dg * 16 + co) * 64 + pc * 8;
        float hr[8], hi[8];
#pragma unroll
        for (int k = 0; k < 8; ++k) { float wr, wi; apow(lam, dg * 64 + pc * 8 + k, dir == 0 ? i + 1 : SC - i, wr, wi); hr[k] = cr[k] * wr - cim[k] * wi; hi[k] = -(cr[k] * wi + cim[k] * wr); }
        bf16_t* row = b2 + ((size_t)(g * SK + i * 16 + co)) * SLD + SK + dir * 128 + pc * 8;
        st_bf16x8(row, (f32x4){hr[0], hr[1], hr[2], hr[3]}, (f32x4){hr[4], hr[5], hr[6], hr[7]});
        st_bf16x8(row + 64, (f32x4){hi[0], hi[1], hi[2], hi[3]}, (f32x4){hi[4], hi[5], hi[6], hi[7]});
    }
    for (int idx = gt; idx < 32 * SC * 16 * SC; idx += NGT) {
        const int j = idx & (SC - 1), co = (idx >> SCL) & 15, i = (idx >> (SCL + 4)) & (SC - 1), g = idx >> (2 * SCL + 4);
        f32x4 v[4];
        if (j < i) { const float* s = kt + ((size_t)(g * 2 + 0) * SC + (i - j)) * 256 + co * 16;
#pragma unroll
            for (int k = 0; k < 4; ++k) v[k] = *(const f32x4*)(s + 4 * k);
        } else if (j > i) { const float* s = kt + ((size_t)(g * 2 + 1) * SC + (j - i)) * 256 + co * 16;
#pragma unroll
            for (int k = 0; k < 4; ++k) v[k] = *(const f32x4*)(s + 4 * k);
        } else { const float* s0 = kt + ((size_t)(g * 2 + 0) * SC) * 256 + co * 16; const float* s1 = kt + ((size_t)(g * 2 + 1) * SC) * 256 + co * 16;
#pragma unroll
            for (int k = 0; k < 4; ++k) v[k] = *(const f32x4*)(s0 + 4 * k) + *(const f32x4*)(s1 + 4 * k);
        }
        bf16_t* row = b2 + ((size_t)(g * SK + i * 16 + co)) * SLD + j * 16;
        st_bf16x8(row, v[0], v[1]); st_bf16x8(row + 8, v[2], v[3]);
    }
}
__device__ __forceinline__ void s5_scan(const Ctx& C) {
    const int gt = C.bid * NTHREADS + C.tid;
    if (gt >= 2 * 32 * 2 * 64) return;
    const int p = gt & 63, dir = (gt >> 6) & 1, g = (gt >> 7) & 31, b = gt >> 12;
    const float* lam = WSP(float, WS_S5LAM); const float* xraw = WSP(float, BG_XRAW); bf16_t* a2 = WSP(bf16_t, BG_A2);
    float ar, ai; apow(lam, (dir * 32 + g) * 64 + p, SC, ar, ai);
    float sr = 0.f, si = 0.f;
    const size_t rowbase = (size_t)g * SROWS + b * NCH; const int q = dir * 128 + p;
    for (int n0 = 0; n0 < NCH; n0 += 64) {
        float xr[64], xi[64];
#pragma unroll
        for (int k = 0; k < 64; ++k) { const int n = dir == 0 ? n0 + k : NCH - 1 - n0 - k; xr[k] = xraw[(rowbase + n) * 256 + q]; xi[k] = xraw[(rowbase + n) * 256 + q + 64]; }
#pragma unroll
        for (int k = 0; k < 64; ++k) { const int n = dir == 0 ? n0 + k : NCH - 1 - n0 - k;
            a2[(rowbase + n) * SLD + SK + q] = f2bf(sr); a2[(rowbase + n) * SLD + SK + q + 64] = f2bf(si);
            const float nr = ar * sr - ai * si + xr[k], ni = ar * si + ai * sr + xi[k]; sr = nr; si = ni; }
    }
}

constexpr int TS = 136;
constexpr int TILE_B = 128 * TS * 2;
constexpr int VEC_OFF = 3 * TILE_B;
__device__ __forceinline__ void load_tile(LAS bf16_t* dst, const bf16_t* src, size_t ld, int tid) {
#pragma unroll
    for (int jj = 0; jj < 4; ++jj) { const int p = tid + 512 * jj, row = p >> 4, c16 = p & 15; *(LAS u32x4*)(dst + row * TS + c16 * 8) = *(const u32x4*)(src + (size_t)row * ld + c16 * 8); }
}
__device__ __forceinline__ void load_tile_colscale(LAS bf16_t* dst, const bf16_t* src, size_t ld, const LAS float* w, int tid) {
#pragma unroll
    for (int jj = 0; jj < 4; ++jj) { const int p = tid + 512 * jj, row = p >> 4, c16 = p & 15; const u32x4 v = *(const u32x4*)(src + (size_t)row * ld + c16 * 8);
        const f32x4 w0 = *(const LAS f32x4*)(w + c16 * 8), w1 = *(const LAS f32x4*)(w + c16 * 8 + 4);
        u32x4 o; o.x = pk2(lo_bf(v.x) * w0[0], hi_bf(v.x) * w0[1]); o.y = pk2(lo_bf(v.y) * w0[2], hi_bf(v.y) * w0[3]); o.z = pk2(lo_bf(v.z) * w1[0], hi_bf(v.z) * w1[1]); o.w = pk2(lo_bf(v.w) * w1[2], hi_bf(v.w) * w1[3]);
        *(LAS u32x4*)(dst + row * TS + c16 * 8) = o; }
}
__device__ __forceinline__ void mma_nt(f32x4 (&acc)[2][4], const LAS bf16_t* A, const LAS bf16_t* B, int wr, int wc, int lane) {
    const int fr = lane & 15, fq = lane >> 4;
#pragma unroll
    for (int ks = 0; ks < 4; ++ks) {
        bf16x8 a[2], b[4];
#pragma unroll
        for (int mi = 0; mi < 2; ++mi) a[mi] = *(const LAS bf16x8*)(A + (32 * wr + 16 * mi + fr) * TS + ks * 32 + fq * 8);
#pragma unroll
        for (int ni = 0; ni < 4; ++ni) b[ni] = *(const LAS bf16x8*)(B + (64 * wc + 16 * ni + fr) * TS + ks * 32 + fq * 8);
#pragma unroll
        for (int mi = 0; mi < 2; ++mi)
#pragma unroll
            for (int ni = 0; ni < 4; ++ni) acc[mi][ni] = __builtin_amdgcn_mfma_f32_16x16x32_bf16(b[ni], a[mi], acc[mi][ni], 0, 0, 0);
    }
}
__device__ __forceinline__ void zero_acc(f32x4 (&acc)[2][4]) {
#pragma unroll
    for (int mi = 0; mi < 2; ++mi)
#pragma unroll
        for (int ni = 0; ni < 4; ++ni) acc[mi][ni] = (f32x4){0.f, 0.f, 0.f, 0.f};
}

struct MixA { const bf16_t *Q, *K, *KT, *VT; bf16_t *O1, *O2, *KV; };
constexpr int VEC_OFF4 = 4 * TILE_B;
template <bool ML>
__device__ __forceinline__ void chunk_phaseA(const Ctx& C, const MixA& M) {
    LAS bf16_t* buf0 = (LAS bf16_t*)C.lds; LAS bf16_t* buf1 = (LAS bf16_t*)(C.lds + TILE_B); LAS bf16_t* buf2 = (LAS bf16_t*)(C.lds + 2 * TILE_B);
    LAS float* vec = (LAS float*)(C.lds + VEC_OFF);
    LAS float *bc = vec, *cf = vec + 128, *rc = vec + 256, *cb = vec + 384, *wf = vec + 512, *wb = vec + 640, *denp = vec + 768  , *wtot = vec + 1280  ;
    const int wr = C.wave >> 1, wc = C.wave & 1, fr = C.lane & 15, fq = C.lane >> 4;
    const int prow = C.tid >> 4, pc = (C.tid & 15) * 8;
    const float* mlg = WSP(float, WS_MLG);
    u32x4 rq[4], rk[4]; float pg0 = 0.f, pg1 = 0.f, pg2 = 0.f, pg3 = 0.f;
#define CHA_ISSUE(it_) do { const int b_ = (it_) >> 9, h_ = ((it_) >> 7) & 3, n_ = (it_) & 127; const size_t t0_ = (size_t)b_ * SEQ + n_ * 128; \
        _Pragma("unroll") for (int jj = 0; jj < 4; ++jj) { const int row = prow + 32 * jj; \
            rq[jj] = *(const u32x4*)(M.Q + (t0_ + row) * 512 + h_ * 128 + pc); rk[jj] = *(const u32x4*)(M.K + (t0_ + row) * 512 + h_ * 128 + pc); } \
        if (ML && C.tid < 128) { const size_t gi_ = (size_t)(b_ * 4 + h_) * SEQ + n_ * 128 + C.tid; pg0 = mlg[gi_]; pg1 = mlg[8 * SEQ + gi_]; pg2 = mlg[16 * SEQ + gi_]; pg3 = mlg[24 * SEQ + gi_]; } } while (0)
    constexpr int NIT = 1024 * REP_CHA;
    if (C.bid < NIT) CHA_ISSUE(C.bid & 1023);
    for (int item_ = C.bid; item_ < NIT; item_ += C.G) { const int item = item_ & 1023;
        const int b = item >> 9, h = (item >> 7) & 3, n = item & 127; const size_t t0 = (size_t)b * SEQ + n * 128;
        const size_t gi = (size_t)(b * 4 + h) * SEQ + n * 128 + (C.tid & 127);
        const float l2g = log2f(1.0f - exp2f(-5.0f - (float)h));
#pragma unroll
        for (int jj = 0; jj < 4; ++jj) { const int o = (prow + 32 * jj) * TS + pc; *(LAS u32x4*)(buf0 + o) = rq[jj]; *(LAS u32x4*)(buf1 + o) = rk[jj]; }
        float igf = pg0, igb = pg1, lfb = pg3, sf = pg2, sb = pg3;
        u32x4 rv[4];
#pragma unroll
        for (int jj = 0; jj < 4; ++jj) rv[jj] = *(const u32x4*)(M.VT + (size_t)(h * 128 + prow + 32 * jj) * T + t0 + pc);
        if (item_ + C.G < NIT) CHA_ISSUE((item_ + C.G) & 1023);
        if (ML && C.tid < 128) {
#pragma unroll
            for (int o = 1; o < 64; o <<= 1) { const float uf = __shfl_up(sf, o), ub = __shfl_up(sb, o); if (C.lane >= o) { sf += uf; sb += ub; } }
            if (C.lane == 63) { wtot[C.wave * 2] = sf; wtot[C.wave * 2 + 1] = sb; }
        }
        __syncthreads();
        if (C.tid < 128) {
            if (ML) {
                const float totf = wtot[0] + wtot[2], totb = wtot[1] + wtot[3];
                if (C.wave == 1) { sf += wtot[0]; sb += wtot[1]; }
                const float bcum = sf, rcum = totb - (sb - lfb);
                bc[C.tid] = bcum; cf[C.tid] = igf - bcum; rc[C.tid] = rcum; cb[C.tid] = igb - rcum;
                wf[C.tid] = __expf(totf + igf - bcum); wb[C.tid] = __expf(totb - rcum + igb);
                float* mlef = WSP(float, WS_MLEF); mlef[gi] = __expf(bcum); mlef[8 * SEQ + gi] = __expf(rcum);
                if (C.tid == 0) { float* mla = WSP(float, WS_MLA); mla[item * 2] = __expf(totf); mla[item * 2 + 1] = __expf(totb); }
            } else { wf[C.tid] = exp2f((float)(127 - C.tid) * l2g); wb[C.tid] = exp2f((float)C.tid * l2g); }
        }
        __syncthreads();
        f32x4 S[2][4]; zero_acc(S);
        mma_nt(S, buf0, buf1, wr, wc, C.lane);
        if (ML && C.tid < 256) {
            const int dir = C.tid >> 7, d = C.tid & 127; const LAS float* w = dir ? wb : wf; float a = 0.f;
#pragma unroll 8
            for (int j = 0; j < 128; ++j) a += w[j] * bf2f(buf1[j * TS + d]);
            WSP(float, WS_MLN)[(size_t)(item * 2 + dir) * 128 + d] = a;
        }
#pragma unroll
        for (int jj = 0; jj < 4; ++jj) *(LAS u32x4*)(buf2 + (prow + 32 * jj) * TS + pc) = rv[jj];
        __syncthreads();
        int frm = fr, fqm = fq; asm volatile("" : "+v"(frm), "+v"(fqm));
#pragma unroll
        for (int mi = 0; mi < 2; ++mi) {
            const int i = 32 * wr + 16 * mi + frm; float dsf = 0.f, dsb = 0.f;
            const float bci = ML ? bc[i] : 0.f, rci = ML ? rc[i] : 0.f;
#pragma unroll
            for (int ni = 0; ni < 4; ++ni) {
                const int j0 = 64 * wc + 16 * ni + 4 * fqm;
                if (ML) {
                    f32x4 pf, pb;
#pragma unroll
                    for (int r = 0; r < 4; ++r) { const int j = j0 + r;
                        pf[r] = (j <= i) ? S[mi][ni][r] * __expf(bci + cf[j]) : 0.f; pb[r] = (j >= i) ? S[mi][ni][r] * __expf(rci + cb[j]) : 0.f;
                        dsf += pf[r]; dsb += pb[r]; }
                    u32x2 w; w.x = pk2(pf[0], pf[1]); w.y = pk2(pf[2], pf[3]); *(LAS u32x2*)(buf0 + i * TS + j0) = w;
                    w.x = pk2(pb[0], pb[1]); w.y = pk2(pb[2], pb[3]); *(LAS u32x2*)(buf1 + i * TS + j0) = w;
                } else {
                    f32x4 pv;
#pragma unroll
                    for (int r = 0; r < 4; ++r) { const int j = j0 + r, dd = i > j ? i - j : j - i; pv[r] = S[mi][ni][r] * exp2f((float)dd * l2g); }
                    u32x2 w; w.x = pk2(pv[0], pv[1]); w.y = pk2(pv[2], pv[3]); *(LAS u32x2*)(buf0 + i * TS + j0) = w;
                }
            }
            if (ML) { dsf = xsum_rows(dsf); dsb = xsum_rows(dsb);
                if (fqm == 0) { denp[(0 * 2 + wc) * 128 + i] = dsf; denp[(1 * 2 + wc) * 128 + i] = dsb; } }
        }
        __syncthreads();
        if (ML && C.tid < 256) { const int dir = C.tid >> 7, i = C.tid & 127;
            WSP(float, WS_MLDEN)[(size_t)dir * 8 * SEQ + (size_t)(b * 4 + h) * SEQ + n * 128 + i] = denp[(dir * 2 + 0) * 128 + i] + denp[(dir * 2 + 1) * 128 + i]; }
        u32x4 rt[4];
#pragma unroll
        for (int jj = 0; jj < 4; ++jj) rt[jj] = *(const u32x4*)(M.KT + (size_t)(h * 128 + prow + 32 * jj) * T + t0 + pc);
        {
            f32x4 O[2][4]; zero_acc(O); mma_nt(O, buf0, buf2, wr, wc, C.lane);
#pragma unroll
            for (int mi = 0; mi < 2; ++mi)
#pragma unroll
                for (int np = 0; np < 2; ++np) { bf16_t* o_ = M.O1 + (t0 + 32 * wr + 16 * mi + fr) * 512 + h * 128 + 64 * wc + 32 * np + 4 * fq; st4bf_x2(o_, O[mi][2 * np], o_ + 16, O[mi][2 * np + 1], fq); }
            if (ML) { zero_acc(O); mma_nt(O, buf1, buf2, wr, wc, C.lane);
#pragma unroll
                for (int mi = 0; mi < 2; ++mi)
#pragma unroll
                    for (int np = 0; np < 2; ++np) { bf16_t* o_ = M.O2 + (t0 + 32 * wr + 16 * mi + fr) * 512 + h * 128 + 64 * wc + 32 * np + 4 * fq; st4bf_x2(o_, O[mi][2 * np], o_ + 16, O[mi][2 * np + 1], fq); } }
        }
        __syncthreads();
#pragma unroll
        for (int jj = 0; jj < 4; ++jj) { const int o = (prow + 32 * jj) * TS + pc; const u32x4 v = rt[jj];
            const f32x4 a0 = *(const LAS f32x4*)(wf + pc), a1 = *(const LAS f32x4*)(wf + pc + 4), c0 = *(const LAS f32x4*)(wb + pc), c1 = *(const LAS f32x4*)(wb + pc + 4);
            u32x4 x; x.x = pk2(lo_bf(v.x) * a0[0], hi_bf(v.x) * a0[1]); x.y = pk2(lo_bf(v.y) * a0[2], hi_bf(v.y) * a0[3]); x.z = pk2(lo_bf(v.z) * a1[0], hi_bf(v.z) * a1[1]); x.w = pk2(lo_bf(v.w) * a1[2], hi_bf(v.w) * a1[3]);
            *(LAS u32x4*)(buf0 + o) = x;
            x.x = pk2(lo_bf(v.x) * c0[0], hi_bf(v.x) * c0[1]); x.y = pk2(lo_bf(v.y) * c0[2], hi_bf(v.y) * c0[3]); x.z = pk2(lo_bf(v.z) * c1[0], hi_bf(v.z) * c1[1]); x.w = pk2(lo_bf(v.w) * c1[2], hi_bf(v.w) * c1[3]);
            *(LAS u32x4*)(buf1 + o) = x; }
        __syncthreads();
        {
            f32x4 A[2][4]; zero_acc(A); mma_nt(A, buf2, buf0, wr, wc, C.lane);
            bf16_t* kv = M.KV + (size_t)item * 2 * 16384;
#pragma unroll
            for (int mi = 0; mi < 2; ++mi)
#pragma unroll
                for (int np = 0; np < 2; ++np) { bf16_t* o_ = kv + (32 * wr + 16 * mi + fr) * 128 + 64 * wc + 32 * np + 4 * fq; st4bf_x2(o_, A[mi][2 * np], o_ + 16, A[mi][2 * np + 1], fq); }
            zero_acc(A); mma_nt(A, buf2, buf1, wr, wc, C.lane);
#pragma unroll
            for (int mi = 0; mi < 2; ++mi)
#pragma unroll
                for (int np = 0; np < 2; ++np) { bf16_t* o_ = kv + 16384 + (32 * wr + 16 * mi + fr) * 128 + 64 * wc + 32 * np + 4 * fq; st4bf_x2(o_, A[mi][2 * np], o_ + 16, A[mi][2 * np + 1], fq); }
        }
        __syncthreads();
    }
#undef CHA_ISSUE
}
template <bool ML>
__device__ __forceinline__ void chunk_scan(const Ctx& C, bf16_t* KV) {
    const int gt = C.bid * NTHREADS + C.tid, NGT = C.G * NTHREADS;
    const float* mla = WSP(float, WS_MLA);
    for (int idx = gt; idx < 8 * 2 * 8192; idx += NGT) {
        const int e2 = idx & 8191, dir = (idx >> 13) & 1, bh = idx >> 14;
        const float aconst = exp2f(128.0f * log2f(1.0f - exp2f(-5.0f - (float)(bh & 3))));
        float s0 = 0.f, s1 = 0.f;
        for (int n0 = 0; n0 < 128; n0 += 32) {
            unsigned raw[32]; float a[32];
#pragma unroll
            for (int k = 0; k < 32; ++k) { const int n = dir == 0 ? n0 + k : 127 - n0 - k; const int item = bh * 128 + n;
                raw[k] = *(const unsigned*)(KV + ((size_t)item * 2 + dir) * 16384 + e2 * 2); a[k] = ML ? mla[item * 2 + dir] : aconst; }
#pragma unroll
            for (int k = 0; k < 32; ++k) { const int n = dir == 0 ? n0 + k : 127 - n0 - k; const int item = bh * 128 + n;
                *(unsigned*)(KV + ((size_t)item * 2 + dir) * 16384 + e2 * 2) = pk2(s0, s1);
                s0 = a[k] * s0 + lo_bf(raw[k]); s1 = a[k] * s1 + hi_bf(raw[k]); }
        }
    }
    if (ML) {
        float* mln = WSP(float, WS_MLN);
        for (int idx = gt; idx < 8 * 2 * 128; idx += NGT) {
            const int d = idx & 127, dir = (idx >> 7) & 1, bh = idx >> 8; float s = 0.f;
            for (int k0 = 0; k0 < 128; k0 += 32) { float raw[32], a[32];
#pragma unroll
                for (int k = 0; k < 32; ++k) { const int n = dir == 0 ? k0 + k : 127 - k0 - k; const int item = bh * 128 + n; raw[k] = mln[(size_t)(item * 2 + dir) * 128 + d]; a[k] = mla[item * 2 + dir]; }
#pragma unroll
                for (int k = 0; k < 32; ++k) { const int n = dir == 0 ? k0 + k : 127 - k0 - k; const int item = bh * 128 + n; mln[(size_t)(item * 2 + dir) * 128 + d] = s; s = a[k] * s + raw[k]; } }
        }
    }
}
struct MixC { const bf16_t *Q, *KV, *O1, *O2, *GS; bf16_t* dst; int ldd, col0; };
template <bool ML>
__device__ __forceinline__ void chunk_phaseC(const Ctx& C, const MixC& M) {
    LAS bf16_t* buf0 = (LAS bf16_t*)C.lds; LAS bf16_t* buf1 = (LAS bf16_t*)(C.lds + TILE_B); LAS bf16_t* buf2 = (LAS bf16_t*)(C.lds + 2 * TILE_B);
    LAS float* vec = (LAS float*)(C.lds + VEC_OFF);
    LAS float *nf = vec, *nb = vec + 128, *qn = vec + 256  , *st = vec + 512  , *st2 = vec + 768  ;
    const int wr = C.wave >> 1, wc = C.wave & 1, fr = C.lane & 15, fq = C.lane >> 4;
    const int prow = C.tid >> 4, pc = (C.tid & 15) * 8;
    const float* mln = WSP(float, WS_MLN); const float* mlef = WSP(float, WS_MLEF); const float* mlden = WSP(float, WS_MLDEN);
    u32x4 rq[4], rf[4]; float pn = 0.f;
#define CHC_ISSUE(it_) do { const int b_ = (it_) >> 9, h_ = ((it_) >> 7) & 3, n_ = (it_) & 127; const size_t t0_ = (size_t)b_ * SEQ + n_ * 128; const bf16_t* kv_ = M.KV + (size_t)(it_) * 2 * 16384; \
        _Pragma("unroll") for (int jj = 0; jj < 4; ++jj) { const int row = prow + 32 * jj; \
            rq[jj] = *(const u32x4*)(M.Q + (t0_ + row) * 512 + h_ * 128 + pc); rf[jj] = *(const u32x4*)(kv_ + row * 128 + pc); } \
        if (ML && C.tid < 256) pn = mln[(size_t)((it_) * 2 + (C.tid >> 7)) * 128 + (C.tid & 127)]; } while (0)
    constexpr int NIT = 1024 * REP_CHC;
    if (C.bid < NIT) CHC_ISSUE(C.bid & 1023);
    for (int item_ = C.bid; item_ < NIT; item_ += C.G) { const int item = item_ & 1023;
        const int b = item >> 9, h = (item >> 7) & 3, n = item & 127; const size_t t0 = (size_t)b * SEQ + n * 128;
        const float l2g = log2f(1.0f - exp2f(-5.0f - (float)h));
#pragma unroll
        for (int jj = 0; jj < 4; ++jj) { const int o = (prow + 32 * jj) * TS + pc; *(LAS u32x4*)(buf0 + o) = rq[jj]; *(LAS u32x4*)(buf1 + o) = rf[jj]; }
        if (ML && C.tid < 256) ((C.tid >> 7) ? nb : nf)[C.tid & 127] = pn;
        u32x4 rb[4];
#pragma unroll
        for (int jj = 0; jj < 4; ++jj) rb[jj] = *(const u32x4*)(M.KV + (size_t)item * 2 * 16384 + 16384 + (prow + 32 * jj) * 128 + pc);
        u32x4 l1[2][2], l2[2][2]; float cfw[2], cbw[2], dfi[2], dbi[2];
#pragma unroll
        for (int mi = 0; mi < 2; ++mi) { const int i = 32 * wr + 16 * mi + fr; const size_t t = t0 + i;
#pragma unroll
            for (int np = 0; np < 2; ++np) { const size_t off = t * 512 + h * 128 + 64 * wc + 32 * np + 4 * fq;
                l1[mi][np] = ld8_x2_raw(M.O1 + off, M.O1 + off + 16, fq); if (ML) l2[mi][np] = ld8_x2_raw(M.O2 + off, M.O2 + off + 16, fq); }
            if (ML) { const size_t gi = (size_t)(b * 4 + h) * SEQ + n * 128 + i; cfw[mi] = mlef[gi]; cbw[mi] = mlef[8 * SEQ + gi]; dfi[mi] = mlden[gi]; dbi[mi] = mlden[8 * SEQ + gi]; }
            else { cfw[mi] = exp2f((float)(i + 1) * l2g); cbw[mi] = exp2f((float)(128 - i) * l2g); dfi[mi] = 0.f; dbi[mi] = 0.f; } }
        if (item_ + C.G < NIT) CHC_ISSUE((item_ + C.G) & 1023);
        __syncthreads();
        if (ML) { const int i = C.tid >> 2, part = C.tid & 3; float a0 = 0.f, a1 = 0.f;
#pragma unroll 1
            for (int c = 0; c < 4; ++c) { const int d0 = part * 32 + c * 8; const u32x4 qw = *(const LAS u32x4*)(buf0 + i * TS + d0);
                const f32x4 f0 = *(const LAS f32x4*)(nf + d0), f1 = *(const LAS f32x4*)(nf + d0 + 4), g0 = *(const LAS f32x4*)(nb + d0), g1 = *(const LAS f32x4*)(nb + d0 + 4);
                const float q0 = lo_bf(qw.x), q1 = hi_bf(qw.x), q2 = lo_bf(qw.y), q3 = hi_bf(qw.y), q4 = lo_bf(qw.z), q5 = hi_bf(qw.z), q6 = lo_bf(qw.w), q7 = hi_bf(qw.w);
                a0 += q0 * f0[0] + q1 * f0[1] + q2 * f0[2] + q3 * f0[3] + q4 * f1[0] + q5 * f1[1] + q6 * f1[2] + q7 * f1[3];
                a1 += q0 * g0[0] + q1 * g0[1] + q2 * g0[2] + q3 * g0[3] + q4 * g1[0] + q5 * g1[1] + q6 * g1[2] + q7 * g1[3]; }
            a0 += dppf<0xB1>(a0); a0 += dppf<0x4E>(a0); a1 += dppf<0xB1>(a1); a1 += dppf<0x4E>(a1);
            if (part == 0) { qn[i] = a0; qn[128 + i] = a1; } }
        __builtin_amdgcn_sched_barrier(0);
        f32x4 Xf[2][4], Xb[2][4]; zero_acc(Xf); zero_acc(Xb);
        mma_nt(Xf, buf0, buf1, wr, wc, C.lane);
        __builtin_amdgcn_sched_barrier(0);
#pragma unroll
        for (int jj = 0; jj < 4; ++jj) *(LAS u32x4*)(buf2 + (prow + 32 * jj) * TS + pc) = rb[jj];
        __syncthreads();
        mma_nt(Xb, buf0, buf2, wr, wc, C.lane);
        __builtin_amdgcn_sched_barrier(0);
        u32x2 e1[2][4], e2[2][4];
#pragma unroll
        for (int mi = 0; mi < 2; ++mi)
#pragma unroll
            for (int np = 0; np < 2; ++np) { ld8_x2_split(l1[mi][np], e1[mi][2 * np], e1[mi][2 * np + 1]); if (ML) ld8_x2_split(l2[mi][np], e2[mi][2 * np], e2[mi][2 * np + 1]); }
#pragma unroll
        for (int mi = 0; mi < 2; ++mi)
#pragma unroll
            for (int ni = 0; ni < 4; ++ni) { const f32x4 o1 = (f32x4){lo_bf(e1[mi][ni].x), hi_bf(e1[mi][ni].x), lo_bf(e1[mi][ni].y), hi_bf(e1[mi][ni].y)};
                if (ML) { const f32x4 o2 = (f32x4){lo_bf(e2[mi][ni].x), hi_bf(e2[mi][ni].x), lo_bf(e2[mi][ni].y), hi_bf(e2[mi][ni].y)}; Xf[mi][ni] = o1 + cfw[mi] * Xf[mi][ni]; Xb[mi][ni] = o2 + cbw[mi] * Xb[mi][ni]; }
                else Xf[mi][ni] = o1 + cfw[mi] * Xf[mi][ni] + cbw[mi] * Xb[mi][ni]; }
        u32x4 lg[2][2];
#pragma unroll
        for (int mi = 0; mi < 2; ++mi)
#pragma unroll
            for (int np = 0; np < 2; ++np) { const bf16_t* gp = M.GS + (t0 + 32 * wr + 16 * mi + fr) * 512 + h * 128 + 64 * wc + 32 * np + 4 * fq; lg[mi][np] = ld8_x2_raw(gp, gp + 16, fq); }
        __syncthreads();
        float rs[2] = {0.f, 0.f};
#pragma unroll
        for (int mi = 0; mi < 2; ++mi) {
            const int i = 32 * wr + 16 * mi + fr;
            float dnf = 0.f, dnb = 0.f;
            if (ML) { dnf = 1.0f / fmaxf(fabsf(dfi[mi] + cfw[mi] * qn[i]), 1.0f); dnb = 1.0f / fmaxf(fabsf(dbi[mi] + cbw[mi] * qn[128 + i]), 1.0f); }
#pragma unroll
            for (int ni = 0; ni < 4; ++ni) {
                f32x4 o;
                if (ML) o = Xf[mi][ni] * dnf + Xb[mi][ni] * dnb; else o = Xf[mi][ni];
                Xf[mi][ni] = o; rs[mi] += (o[0] + o[1]) + (o[2] + o[3]);
            }
            rs[mi] = xsum_rows(rs[mi]);
            if (fq == 0) st[wc * 128 + i] = rs[mi];
        }
        __syncthreads();
        float mu[2];
#pragma unroll
        for (int mi = 0; mi < 2; ++mi) { const int i = 32 * wr + 16 * mi + fr; mu[mi] = (st[i] + st[128 + i]) * (1.0f / 128.0f); float q2 = 0.f;
#pragma unroll
            for (int ni = 0; ni < 4; ++ni) { const f32x4 d = Xf[mi][ni] - mu[mi]; q2 += (d[0] * d[0] + d[1] * d[1]) + (d[2] * d[2] + d[3] * d[3]); }
            q2 = xsum_rows(q2);
            if (fq == 0) st2[wc * 128 + i] = q2; }
        __syncthreads();
#pragma unroll
        for (int mi = 0; mi < 2; ++mi) { const int i = 32 * wr + 16 * mi + fr; const size_t t = t0 + i;
            u32x2 eg[2][4]; ld8_x2_split(lg[mi][0], eg[mi][0], eg[mi][1]); ld8_x2_split(lg[mi][1], eg[mi][2], eg[mi][3]);
            const float rstd = rsqrtf((st2[i] + st2[128 + i]) * (1.0f / 128.0f) + 1e-6f);
#pragma unroll
            for (int np = 0; np < 2; ++np) { f32x4 o[2];
#pragma unroll
                for (int q = 0; q < 2; ++q) { const int ni = 2 * np + q; const f32x4 gv = (f32x4){lo_bf(eg[mi][ni].x), hi_bf(eg[mi][ni].x), lo_bf(eg[mi][ni].y), hi_bf(eg[mi][ni].y)};
#pragma unroll
                    for (int r = 0; r < 4; ++r) o[q][r] = (Xf[mi][ni][r] - mu[mi]) * rstd * (ML ? sigmoidf_(gv[r]) : siluf_(gv[r])); }
                bf16_t* o_ = M.dst + t * M.ldd + M.col0 + h * 128 + 64 * wc + 32 * np + 4 * fq; st4bf_x2(o_, o[0], o_ + 16, o[1], fq); } }
        __syncthreads();
    }
#undef CHC_ISSUE
}

constexpr int DKS = 72, DVS = 392;
constexpr int DK_OFF = 0, DV_OFF = 384 * DKS * 2;
__device__ __forceinline__ void dilated_attn(const Ctx& C) {
    LAS bf16_t* Ks = (LAS bf16_t*)(C.lds + DK_OFF); LAS bf16_t* Vt = (LAS bf16_t*)(C.lds + DV_OFF);
    const bf16_t* cq = WSP(bf16_t, BO_CQ); const bf16_t* ck = WSP(bf16_t, BO_CK); const bf16_t* cvT = WSP(bf16_t, BO_CVT);
    bf16_t* odil = WSP(bf16_t, BO_ODIL); float* lse = WSP(float, WS_LSE);
    const int w = C.wave, fr = C.lane & 15, fq = C.lane >> 4, qbl = w >> 1;
    u32x4 pk_[6], pv_[6]; bf16x8 pq_[2][2];
#define DIL_ISSUE(it_) do { const int run_ = (it_) & 63, hh_ = ((it_) >> 6) & 3, g_ = ((it_) >> 8) % 3, b_ = (it_) / 768, sh_ = 2 * g_; \
        const int NBk_ = 256 >> sh_, qb0_ = run_ * 4, nb0_ = qb0_ & (NBk_ - 1); const size_t hrow_ = (size_t)(g_ * 4 + hh_) * T + (size_t)b_ * SEQ; const int kp0_ = qb0_ * 64 - 64; \
        _Pragma("unroll") for (int jj = 0; jj < 6; ++jj) { const int p = C.tid + 512 * jj, row = p >> 3, c16 = p & 7; const int nbk = nb0_ - 1 + (row >> 6); const bool ok = nbk >= 0 && nbk < NBk_; \
            pk_[jj] = (u32x4){0u, 0u, 0u, 0u}; if (ok) pk_[jj] = *(const u32x4*)(ck + (hrow_ + kp0_ + row) * 64 + c16 * 8); } \
        _Pragma("unroll") for (int jj = 0; jj < 6; ++jj) { const int p = C.tid + 512 * jj, e = p / 48, c = p % 48, t8 = c * 8; const int nbk = nb0_ - 1 + (t8 >> 6); const bool ok = nbk >= 0 && nbk < NBk_; \
            pv_[jj] = (u32x4){0u, 0u, 0u, 0u}; if (ok) pv_[jj] = *(const u32x4*)(cvT + (size_t)((g_ * 4 + hh_) * 64 + e) * T + (size_t)b_ * SEQ + kp0_ + t8); } \
        _Pragma("unroll") for (int mt = 0; mt < 2; ++mt) _Pragma("unroll") for (int ks = 0; ks < 2; ++ks) pq_[mt][ks] = *(const bf16x8*)(cq + (hrow_ + qb0_ * 64 + 32 * w + 16 * mt + fr) * 64 + ks * 32 + fq * 8); } while (0)
    constexpr int NITD = 1536 * REP_DIL;
    if (C.bid < NITD) DIL_ISSUE(C.bid % 1536);
    for (int item_ = C.bid; item_ < NITD; item_ += C.G) { const int item = item_ % 1536;
        const int run = item & 63, hh = (item >> 6) & 3, g = (item >> 8) % 3, b = item / 768, sh = 2 * g;
        const int NBk = 256 >> sh, qb0 = run * 4, nb0 = qb0 & (NBk - 1), cls = qb0 >> (8 - sh);
#pragma unroll
        for (int jj = 0; jj < 6; ++jj) { const int p = C.tid + 512 * jj, row = p >> 3, c16 = p & 7; *(LAS u32x4*)(Ks + row * DKS + c16 * 8) = pk_[jj]; }
#pragma unroll
        for (int jj = 0; jj < 6; ++jj) { const int p = C.tid + 512 * jj, e = p / 48, c = p % 48; *(LAS u32x4*)(Vt + e * DVS + c * 8) = pv_[jj]; }
        bf16x8 qf[2][2];
#pragma unroll
        for (int mt = 0; mt < 2; ++mt)
#pragma unroll
            for (int ks = 0; ks < 2; ++ks) qf[mt][ks] = pq_[mt][ks];
        if (item_ + C.G < NITD) DIL_ISSUE((item_ + C.G) % 1536);
        __syncthreads();
        const int kl0 = 64 * qbl;
#pragma unroll
        for (int mt = 0; mt < 2; ++mt) {
            __builtin_amdgcn_sched_barrier(0);
            unsigned pk[12][2]; float rden, mrow;
            {
                f32x4 acc[12];
#pragma unroll
                for (int ni = 0; ni < 12; ++ni) acc[ni] = (f32x4){0.f, 0.f, 0.f, 0.f};
                const bf16x8 q0 = qf[mt][0], q1 = qf[mt][1];
#pragma unroll
                for (int ni = 0; ni < 12; ++ni) { const bf16x8 kf0 = *(const LAS bf16x8*)(Ks + (kl0 + 16 * ni + fr) * DKS + fq * 8), kf1 = *(const LAS bf16x8*)(Ks + (kl0 + 16 * ni + fr) * DKS + 32 + fq * 8);
                    acc[ni] = __builtin_amdgcn_mfma_f32_16x16x32_bf16(kf0, q0, acc[ni], 0, 0, 0); acc[ni] = __builtin_amdgcn_mfma_f32_16x16x32_bf16(kf1, q1, acc[ni], 0, 0, 0); }
                int frm = fr, fqm = fq; asm volatile("" : "+v"(frm), "+v"(fqm));
                const int ib = 32 * (w & 1) + 16 * mt + frm;
                float mx = -3e38f;
#pragma unroll
                for (int ni = 0; ni < 12; ++ni) { const int nbk = nb0 + qbl - 1 + (ni >> 2); const bool bok = nbk >= 0 && nbk < NBk;
#pragma unroll
                    for (int r = 0; r < 4; ++r) { const int rel = 16 * ni + 4 * fqm + r - 64 - ib; const bool ok = bok && rel <= 64 && rel >= -64;
                        const float sv = ok ? acc[ni][r] * 0.125f : -1e30f; acc[ni][r] = sv; mx = fmaxf(mx, sv); } }
                mx = xmax_rows(mx);
                float sm = 0.f;
#pragma unroll
                for (int ni = 0; ni < 12; ++ni) { f32x4 p;
#pragma unroll
                    for (int r = 0; r < 4; ++r) { p[r] = __expf(acc[ni][r] - mx); sm += p[r]; }
                    pk[ni][0] = pk2(p[0], p[1]); pk[ni][1] = pk2(p[2], p[3]); }
                sm = xsum_rows(sm);
                rden = 1.0f / sm; mrow = mx + __logf(sm);
            }
            f32x4 o[4];
#pragma unroll
            for (int ne = 0; ne < 4; ++ne) o[ne] = (f32x4){0.f, 0.f, 0.f, 0.f};
#pragma unroll
            for (int ks2 = 0; ks2 < 6; ++ks2) {
                const u32x4 t4 = (u32x4){pk[2 * ks2][0], pk[2 * ks2][1], pk[2 * ks2 + 1][0], pk[2 * ks2 + 1][1]}; const bf16x8 pf = __builtin_bit_cast(bf16x8, t4);
#pragma unroll
                for (int ne = 0; ne < 4; ++ne) { const LAS bf16_t* vp = Vt + (16 * ne + fr) * DVS + kl0 + 32 * ks2 + 4 * fq;
                    const u32x2 v0 = *(const LAS u32x2*)vp, v1 = *(const LAS u32x2*)(vp + 16);
                    const u32x4 v4 = (u32x4){v0.x, v0.y, v1.x, v1.y}; const bf16x8 vf = __builtin_bit_cast(bf16x8, v4);
                    o[ne] = __builtin_amdgcn_mfma_f32_16x16x32_bf16(vf, pf, o[ne], 0, 0, 0); }
            }
            const int ib = 32 * (w & 1) + 16 * mt + fr, p = (((nb0 + qbl) * 64 + ib) << sh) + cls; const size_t trow = (size_t)g * T + (size_t)b * SEQ + p;
#pragma unroll
            for (int np = 0; np < 2; ++np) { bf16_t* o_ = odil + trow * 256 + hh * 64 + 32 * np + 4 * fq; st4bf_x2(o_, o[2 * np] * rden, o_ + 16, o[2 * np + 1] * rden, fq); }
            if (fq == 0) lse[trow * 4 + hh] = mrow;
        }
        __syncthreads();
    }
#undef DIL_ISSUE
}
__device__ __forceinline__ void dilated_merge(const Ctx& C) {
    const int gt = C.bid * NTHREADS + C.tid, NGT = C.G * NTHREADS;
    const bf16_t* odil = WSP(bf16_t, BO_ODIL); const float* lse = WSP(float, WS_LSE); bf16_t* aout = WSP(bf16_t, BO_AOUT);
    for (int idx = gt; idx < T * 32; idx += NGT) {
        const int t = idx >> 5, c8 = idx & 31, hh = c8 >> 3;
        const float l0 = lse[(size_t)t * 4 + hh], l1 = lse[((size_t)T + t) * 4 + hh], l2 = lse[((size_t)2 * T + t) * 4 + hh];
        const float mx = fmaxf(l0, fmaxf(l1, l2)); const float e0 = __expf(l0 - mx), e1 = __expf(l1 - mx), e2 = __expf(l2 - mx), rs = 1.0f / (e0 + e1 + e2);
        const float w0 = e0 * rs, w1 = e1 * rs, w2 = e2 * rs;
        const u32x4 a = *(const u32x4*)(odil + (size_t)t * 256 + c8 * 8), bq = *(const u32x4*)(odil + ((size_t)T + t) * 256 + c8 * 8), cc = *(const u32x4*)(odil + ((size_t)2 * T + t) * 256 + c8 * 8);
        u32x4 o;
        o.x = pk2(w0 * lo_bf(a.x) + w1 * lo_bf(bq.x) + w2 * lo_bf(cc.x), w0 * hi_bf(a.x) + w1 * hi_bf(bq.x) + w2 * hi_bf(cc.x));
        o.y = pk2(w0 * lo_bf(a.y) + w1 * lo_bf(bq.y) + w2 * lo_bf(cc.y), w0 * hi_bf(a.y) + w1 * hi_bf(bq.y) + w2 * hi_bf(cc.y));
        o.z = pk2(w0 * lo_bf(a.z) + w1 * lo_bf(bq.z) + w2 * lo_bf(cc.z), w0 * hi_bf(a.z) + w1 * hi_bf(bq.z) + w2 * hi_bf(cc.z));
        o.w = pk2(w0 * lo_bf(a.w) + w1 * lo_bf(bq.w) + w2 * lo_bf(cc.w), w0 * hi_bf(a.w) + w1 * hi_bf(bq.w) + w2 * hi_bf(cc.w));
        *(u32x4*)(aout + (size_t)t * 768 + c8 * 8) = o;
    }
}

template <int MODE, int TSTR = 1>
__device__ __forceinline__ void skinny16_tile(const Ctx& C, const bf16_t* x, const float* wT, const float* bias_i, const float* bias_f, int tile) {
    const int l15 = C.lane & 15, q = C.lane >> 4;
    {
        const bf16_t* xr = x + (size_t)(TSTR == 1 ? tile * 16 + l15 : l15 * TSTR + tile) * DM + 8 * q; const float* wr = wT + (size_t)l15 * DM + 8 * q;
        f32x4 acc = (f32x4){0.f, 0.f, 0.f, 0.f}, acc2 = (f32x4){0.f, 0.f, 0.f, 0.f}; float ss = 0.f;
        for (int s0 = 0; s0 < 32; s0 += 8) {
            u32x4 xw[8]; f32x4 w0[8], w1[8];
#pragma unroll
            for (int s = 0; s < 8; ++s) { xw[s] = *(const u32x4*)(xr + 32 * (s0 + s)); w0[s] = *(const f32x4*)(wr + 32 * (s0 + s)); w1[s] = *(const f32x4*)(wr + 32 * (s0 + s) + 4); }
#pragma unroll
            for (int s = 0; s < 8; ++s) {
                const float x0 = lo_bf(xw[s].x), x1 = hi_bf(xw[s].x), x2 = lo_bf(xw[s].y), x3 = hi_bf(xw[s].y), x4 = lo_bf(xw[s].z), x5 = hi_bf(xw[s].z), x6 = lo_bf(xw[s].w), x7 = hi_bf(xw[s].w);
                ss += (x0 * x0 + x1 * x1) + (x2 * x2 + x3 * x3) + (x4 * x4 + x5 * x5) + (x6 * x6 + x7 * x7);
                acc = __builtin_amdgcn_mfma_f32_16x16x4f32(x0, w0[s][0], acc, 0, 0, 0); acc2 = __builtin_amdgcn_mfma_f32_16x16x4f32(x1, w0[s][1], acc2, 0, 0, 0);
                acc = __builtin_amdgcn_mfma_f32_16x16x4f32(x2, w0[s][2], acc, 0, 0, 0); acc2 = __builtin_amdgcn_mfma_f32_16x16x4f32(x3, w0[s][3], acc2, 0, 0, 0);
                acc = __builtin_amdgcn_mfma_f32_16x16x4f32(x4, w1[s][0], acc, 0, 0, 0); acc2 = __builtin_amdgcn_mfma_f32_16x16x4f32(x5, w1[s][1], acc2, 0, 0, 0);
                acc = __builtin_amdgcn_mfma_f32_16x16x4f32(x6, w1[s][2], acc, 0, 0, 0); acc2 = __builtin_amdgcn_mfma_f32_16x16x4f32(x7, w1[s][3], acc2, 0, 0, 0); }
        }
        acc += acc2;
        ss = xsum_rows(ss);
        const float rstd = rsqrtf(ss * (1.0f / DM) + 1e-6f);
        f32x4 lg;
#pragma unroll
        for (int r = 0; r < 4; ++r) lg[r] = acc[r] * __shfl(rstd, 4 * q + r);
        const int tok0 = tile * 16 + 4 * q, b = tok0 >> 14, pos0 = tok0 & (SEQ - 1);
        if (MODE == 0) {
            if (q == 0) WSP(float, WS_RSTD)[tile * 16 + l15] = rstd;
            f32x4 mx = lg;
#pragma unroll
            for (int r = 0; r < 4; ++r) mx[r] = row_max(mx[r]);
            f32x4 p, sm;
#pragma unroll
            for (int r = 0; r < 4; ++r) { p[r] = __expf(lg[r] - mx[r]); sm[r] = p[r]; }
#pragma unroll
            for (int r = 0; r < 4; ++r) sm[r] = row_sum(sm[r]);
#pragma unroll
            for (int r = 0; r < 4; ++r) p[r] = p[r] / sm[r];
            *(f32x4*)(WSP(float, WS_AFF) + (size_t)(b * 16 + l15) * SEQ + pos0) = p;
        } else {
            const int type = l15 >> 2, head = l15 & 3; f32x4 o;
            if (type < 2) { const float bi = bias_i[type * 4 + head];
#pragma unroll
                for (int r = 0; r < 4; ++r) o[r] = lg[r] + bi;
            } else { const float bf = bias_f[(type - 2) * 4 + head];
#pragma unroll
                for (int r = 0; r < 4; ++r) { const float z = lg[r] + bf; o[r] = fminf(z, 0.f) - log1pf(__expf(-fabsf(z))); } }
            if (TSTR == 1) *(f32x4*)(WSP(float, WS_MLG) + (size_t)type * 8 * SEQ + (size_t)(b * 4 + head) * SEQ + pos0) = o;
            else {
#pragma unroll
                for (int r = 0; r < 4; ++r) { const int t = (4 * q + r) * TSTR + tile; WSP(float, WS_MLG)[(size_t)type * 8 * SEQ + (size_t)((t >> 14) * 4 + head) * SEQ + (t & (SEQ - 1))] = o[r]; } }
        }
    }
}
template <int MODE>
__device__ __forceinline__ void skinny16(const Ctx& C, const bf16_t* x, const float* wT, const float* bias_i, const float* bias_f) {
    const int gw = C.bid * NWAVES + C.wave, NGW = C.G * NWAVES;
    for (int tile = gw; tile < T / 16; tile += NGW) skinny16_tile<MODE>(C, x, wT, bias_i, bias_f, tile);
}

__device__ __forceinline__ void router_quant(const Ctx& C, const float* wT) {
    const int gw = C.bid * NWAVES + C.wave, NGW = C.G * NWAVES;
    const bf16_t* x = WSP(bf16_t, WS_XB); unsigned* xq = WSP(unsigned, WS_HBUF); float* xsc = WSP(float, WS_XSC);
    for (int tile = gw; tile < T / 16; tile += NGW) {
        skinny16_tile<0>(C, x, wT, nullptr, nullptr, tile);
#pragma unroll 1
        for (int i0 = 0; i0 < 16; i0 += 4) {
            f32x4 v[4][4]; float mx[4];
#pragma unroll
            for (int i = 0; i < 4; ++i)
#pragma unroll
                for (int j = 0; j < 4; ++j) v[i][j] = ld4bf(x + (size_t)(tile * 16 + i0 + i) * DM + j * 256 + C.lane * 4);
#pragma unroll
            for (int i = 0; i < 4; ++i) { mx[i] = fmaxf(fmaxf(amax4(v[i][0]), amax4(v[i][1])), fmaxf(amax4(v[i][2]), amax4(v[i][3]))); }
#pragma unroll
            for (int i = 0; i < 4; ++i) mx[i] = wave_max(mx[i]);
#pragma unroll
            for (int i = 0; i < 4; ++i) { const int t = tile * 16 + i0 + i; const float inv = mx[i] > 0.f ? 127.0f / mx[i] : 0.f;
#pragma unroll
                for (int j = 0; j < 4; ++j) xq[(size_t)t * 256 + j * 64 + C.lane] = q4i8(v[i][j], inv);
                if (C.lane == 0) xsc[t] = mx[i] * (1.0f / 127.0f); }
        }
    }
}

__device__ __forceinline__ void topk_select(const Ctx& C) {
    LAS unsigned* cnt = (LAS unsigned*)C.lds;
    const float* aff = WSP(float, WS_AFF); int* tok = WSP(int, WS_TOK); float* gatel = WSP(float, WS_GATEL); int* inv = WSP(int, WS_INV); float* rstdl = WSP(float, WS_RSTDL); const float* rstdv = WSP(float, WS_RSTD); const float* xscv = WSP(float, WS_XSC);
    for (int item = C.bid; item < NB * NE; item += C.G) {
        const int b = item >> 4, e = item & 15; const float* a = aff + (size_t)item * SEQ + C.tid * 32;
        unsigned key[32];
#pragma unroll
        for (int k = 0; k < 8; ++k) { const f32x4 v = *(const f32x4*)(a + 4 * k); key[4 * k] = __float_as_uint(v[0]); key[4 * k + 1] = __float_as_uint(v[1]); key[4 * k + 2] = __float_as_uint(v[2]); key[4 * k + 3] = __float_as_uint(v[3]); }
        unsigned prefix = 0u;
        for (int bit = 30; bit >= 0; --bit) {
            const unsigned cand = prefix | (1u << bit); unsigned c = 0;
#pragma unroll
            for (int k = 0; k < 32; ++k) c += (key[k] >= cand) ? 1u : 0u;
            c = wave_sum_u(c);
            LAS unsigned* slot = cnt + (bit & 1) * 8;
            if (C.lane == 0) slot[C.wave] = c;
            __syncthreads();
            unsigned tot = 0;
#pragma unroll
            for (int w = 0; w < 8; ++w) tot += slot[w];
            if (tot >= (unsigned)CAP) prefix = cand;
        }
        __syncthreads();
        unsigned cg_ = 0, ce = 0;
#pragma unroll
        for (int k = 0; k < 32; ++k) { cg_ += (key[k] > prefix) ? 1u : 0u; ce += (key[k] == prefix) ? 1u : 0u; }
        unsigned pkd = cg_ | (ce << 16), inc = pkd;
#pragma unroll
        for (int o = 1; o < 64; o <<= 1) { const unsigned u = __shfl_up(inc, o); if (C.lane >= o) inc += u; }
        if (C.lane == 63) cnt[16 + C.wave] = inc;
        __syncthreads();
        unsigned base = 0, total = 0;
#pragma unroll
        for (int w = 0; w < 8; ++w) { const unsigned v = cnt[16 + w]; if (w < C.wave) base += v; total += v; }
        const unsigned excl = base + inc - pkd;
        const unsigned gt_before = excl & 0xffffu, eq_before = excl >> 16, gt_total = total & 0xffffu;
        const unsigned need_eq = (unsigned)CAP - gt_total;
        unsigned eq_taken_before = eq_before < need_eq ? eq_before : need_eq;
        unsigned slot = gt_before + eq_taken_before, eqr = eq_before;
        const int rowbase = e * 4096 + b * 2048;
#pragma unroll
        for (int k = 0; k < 32; ++k) {
            const int pos = C.tid * 32 + k; int sl = -1;
            if (key[k] > prefix) sl = (int)slot++;
            else if (key[k] == prefix) { if (eqr < need_eq) sl = (int)slot++; ++eqr; }
            inv[((size_t)b * SEQ + pos) * 16 + e] = sl;
            if (sl >= 0) { tok[rowbase + sl] = b * SEQ + pos; gatel[rowbase + sl] = __uint_as_float(key[k]); rstdl[rowbase + sl] = rstdv[b * SEQ + pos] * xscv[b * SEQ + pos]; }
        }
        __syncthreads();
    }
}
template <bool FINAL>
__device__ __forceinline__ void moe_combine(const Ctx& C, const float* g, unsigned* hq, float* hsc, float* out, const float* wgt = nullptr, const float* bias_i = nullptr, const float* bias_f = nullptr) {
    const int gw = C.bid * NWAVES + C.wave, NGW = C.G * NWAVES;
    bf16_t* x = WSP(bf16_t, WS_XB); const int* inv = WSP(int, WS_INV); const bf16_t* ye = WSP(bf16_t, BG_YE);
#define CMB_OFF(q) (((q) >> 1) * 512 + C.lane * 8 + ((q) & 1) * 4)
    f32x4 gv[4];
#pragma unroll
    for (int j = 0; j < 4; ++j) gv[j] = *(const f32x4*)(g + CMB_OFF(j));
    for (int tile = gw; tile < T / 16; tile += NGW) {
#pragma unroll 1
    for (int ti = 0; ti < 16; ++ti) { const int t = ti * (T / 16) + tile;
        const int b = t >> 14; f32x4 v[4];
#pragma unroll
        for (int j = 0; j < 2; ++j) { const u32x4 w = *(const u32x4*)(x + (size_t)t * DM + j * 512 + C.lane * 8);
            v[2 * j] = (f32x4){lo_bf(w.x), hi_bf(w.x), lo_bf(w.y), hi_bf(w.y)}; v[2 * j + 1] = (f32x4){lo_bf(w.z), hi_bf(w.z), lo_bf(w.w), hi_bf(w.w)}; }
        const int myinv = inv[(size_t)t * 16 + (C.lane & 15)];
        unsigned msk = (unsigned)__ballot(myinv >= 0) & 0xffffu;
        while (msk) {
            const bf16_t* yr[4]; float wk[4];
#pragma unroll
            for (int k = 0; k < 4; ++k) { wk[k] = 0.f; yr[k] = ye;
                if (msk) { const int e = __builtin_ctz(msk); msk &= msk - 1; const int sl = __shfl(myinv, e); wk[k] = 1.f; yr[k] = ye + (size_t)(e * 4096 + b * 2048 + sl) * DM + C.lane * 8; } }
            u32x4 r[4][2];
#pragma unroll
            for (int k = 0; k < 4; ++k)
#pragma unroll
                for (int j = 0; j < 2; ++j) r[k][j] = __builtin_nontemporal_load((const u32x4*)(yr[k] + j * 512));
#pragma unroll
            for (int k = 0; k < 4; ++k)
#pragma unroll
                for (int j = 0; j < 2; ++j) { v[2 * j] += wk[k] * (f32x4){lo_bf(r[k][j].x), hi_bf(r[k][j].x), lo_bf(r[k][j].y), hi_bf(r[k][j].y)};
                    v[2 * j + 1] += wk[k] * (f32x4){lo_bf(r[k][j].z), hi_bf(r[k][j].z), lo_bf(r[k][j].w), hi_bf(r[k][j].w)}; }
        }
        if (!FINAL) {
#pragma unroll
            for (int j = 0; j < 2; ++j) { u32x4 w; w.x = pk2(v[2 * j][0], v[2 * j][1]); w.y = pk2(v[2 * j][2], v[2 * j][3]); w.z = pk2(v[2 * j + 1][0], v[2 * j + 1][1]); w.w = pk2(v[2 * j + 1][2], v[2 * j + 1][3]);
                *(u32x4*)(x + (size_t)t * DM + j * 512 + C.lane * 8) = w;
                v[2 * j] = (f32x4){lo_bf(w.x), hi_bf(w.x), lo_bf(w.y), hi_bf(w.y)}; v[2 * j + 1] = (f32x4){lo_bf(w.z), hi_bf(w.z), lo_bf(w.w), hi_bf(w.w)}; } }
        float s = 0.f;
#pragma unroll
        for (int j = 0; j < 4; ++j) s += (v[j][0] * v[j][0] + v[j][1] * v[j][1]) + (v[j][2] * v[j][2] + v[j][3] * v[j][3]);
        const float rstd = rsqrtf(wave_sum(s) * (1.0f / DM) + 1e-6f);
        if (FINAL) {
#pragma unroll
            for (int j = 0; j < 4; ++j) *(f32x4*)(out + (size_t)t * DM + CMB_OFF(j)) = v[j] * rstd * gv[j];
        } else {
            float m = 0.f;
#pragma unroll
            for (int j = 0; j < 4; ++j) { v[j] *= gv[j]; m = fmaxf(m, amax4(v[j])); }
            m = wave_max(m); const float inv = m > 0.f ? 127.0f / m : 0.f;
#pragma unroll
            for (int j = 0; j < 2; ++j) *(u32x2*)(hq + (size_t)t * 256 + j * 128 + C.lane * 2) = (u32x2){q4i8(v[2 * j], inv), q4i8(v[2 * j + 1], inv)};
            if (C.lane == 0) hsc[t] = m * rstd * (1.0f / 127.0f);
        }
    }
        if (!FINAL) {
            __builtin_amdgcn_fence(__ATOMIC_RELEASE, "workgroup"); __builtin_amdgcn_fence(__ATOMIC_ACQUIRE, "workgroup");
            skinny16_tile<1, T / 16>(C, x, wgt, bias_i, bias_f, tile);
        }
    }
}
#undef CMB_OFF

#define XB_TMO      128
#define XB_XCNT(j)  (256  + 64 * (j))
#define XB_XSUB(j)  (1280 + 64 * (j))
#define XB_XGEN(j)  (2304 + 64 * (j))
#define XB_TOP      3328
#define XB_TOPGEN   3392
#define XCD_BAR_WORDS 3456
#define XB_SPIN_CAP (1u << 22)
__device__ __forceinline__ unsigned xb_ld(unsigned* p)              { return __hip_atomic_load(p, __ATOMIC_RELAXED, __HIP_MEMORY_SCOPE_AGENT); }
__device__ __forceinline__ unsigned xb_add(unsigned* p, unsigned v) { return __hip_atomic_fetch_add(p, v, __ATOMIC_RELAXED, __HIP_MEMORY_SCOPE_AGENT); }
__device__ __forceinline__ unsigned xb_xcc_id() { return (unsigned)__builtin_amdgcn_s_getreg((3 << 11) | 20) & 0xFu; }
#define XB_SPIN(cond, bar) do { unsigned _sp = 0; while (cond) { __builtin_amdgcn_s_sleep(1); \
    if ((++_sp & 255u) == 0u) { if (xb_ld(&(bar)[XB_TMO])) break; if (_sp > XB_SPIN_CAP) { atomicAdd(&(bar)[XB_TMO], 1u); break; } } } } while (0)
struct XcdBarrier { unsigned* bar; unsigned x; volatile LAS unsigned* st; int wave; };
__device__ __forceinline__ XcdBarrier xcd_barrier_post(unsigned* bar, volatile LAS unsigned* st, int wave) {
    XcdBarrier b; b.bar = bar; b.x = xb_xcc_id(); b.st = st; b.wave = wave;
    if (wave == 0 && lane_fresh() == 0) (void)xb_add(&bar[XB_XCNT(b.x)], 1u);
    return b;
}
__device__ __forceinline__ void xcd_barrier_complete(unsigned* bar, unsigned x, unsigned& nloc, unsigned& nx) {
    const unsigned G = gridDim.x * gridDim.y * gridDim.z;
    unsigned sum, cnt, mine, sp = 0u;
    for (;;) {
        sum = 0u; cnt = 0u; mine = 0u;
#pragma unroll
        for (unsigned j = 0; j < 16; ++j) { const unsigned c = xb_ld(&bar[XB_XCNT(j)]); sum += c; cnt += (c > 0u) ? 1u : 0u; mine = (j == x) ? c : mine; }
        if (sum == G) break;
        __builtin_amdgcn_s_sleep(1);
        if ((++sp & 255u) == 0u) { if (xb_ld(&bar[XB_TMO])) break; if (sp > XB_SPIN_CAP) { atomicAdd(&bar[XB_TMO], 1u); break; } }
    }
    nloc = mine > 0u ? mine : 1u; nx = cnt > 0u ? cnt : 1u;
}
__device__ __forceinline__ void xcd_barrier(const XcdBarrier& b) {
    asm volatile("s_waitcnt vmcnt(0)" ::: "memory");
    __syncthreads();
    if (b.wave == 0 && lane_fresh() == 0) {
        unsigned* bar = b.bar;
        __builtin_amdgcn_s_waitcnt(0);
        unsigned nloc = b.st[0], nx = b.st[1];
        if (nloc == 0u) { xcd_barrier_complete(bar, b.x, nloc, nx); b.st[0] = nloc; b.st[1] = nx; }
        const unsigned old = xb_add(&bar[XB_XSUB(b.x)], 1u);
        const unsigned gen = old / nloc;
        if (old + 1u == (gen + 1u) * nloc) {
            __builtin_amdgcn_fence(__ATOMIC_RELEASE, "agent");
            asm volatile("s_waitcnt vmcnt(0)" ::: "memory");
            const unsigned og = xb_add(&bar[XB_TOP], 1u);
            const unsigned tg = og / nx;
            if (og + 1u == (tg + 1u) * nx) xb_add(&bar[XB_TOPGEN], 1u);
            else XB_SPIN(xb_ld(&bar[XB_TOPGEN]) == tg, bar);
            __builtin_amdgcn_fence(__ATOMIC_ACQUIRE, "agent");
            xb_add(&bar[XB_XGEN(b.x)], 1u);
            asm volatile("s_waitcnt vmcnt(0)" ::: "memory");
        } else {
            XB_SPIN(xb_ld(&bar[XB_XGEN(b.x)]) == gen, bar);
            __builtin_amdgcn_fence(__ATOMIC_ACQUIRE, "agent");
            asm volatile("s_waitcnt vmcnt(0)" ::: "memory");
        }
    }
    __syncthreads();
}

constexpr int LDS_BYTES = 148480;
constexpr int NPHASE = 24;

__device__ __forceinline__ void moe_gemms1(const Ctx& C, int layer) {
    pg8::Gemm g{WSP(bf16_t, WS_HBUF), (const bf16_t*)(C.ws + WS_W13 + (size_t)layer * (64 * MiB)), 512, 512, 512, WSP(int, WS_TOK)}; pg8::TileOrder S; S.init(16, 16, 16, C.G, C.bid, REP_MOE1);
    EpiMoe1 E{WSP(signed char, BG_ACT), WSP(unsigned short, WS_ACTSC), WSP(float, WS_RSTDL), WSP(float, WS_WSC) + (size_t)layer * 16 * 4096, C.lds}; pg8::gemm_phase<EpiMoe1, true, true, true>(C.lds, g, S, E, C.wave);
}
__device__ __forceinline__ void moe_gemms2(const Ctx& C) {
    pg8::Gemm g{WSP(bf16_t, BG_ACT), WSP(bf16_t, WS_W2), 1024, 1024, 1024, nullptr, WSP(unsigned short, WS_ACTSC)}; pg8::TileOrder S; S.init(16, 16, 4, C.G, C.bid, REP_MOE2);
    EpiMoe2 E{WSP(bf16_t, BG_YE), WSP(float, WS_GATEL), WSP(float, WS_W2SC)}; pg8::gemm_phase<EpiMoe2, true, false, true, true>(C.lds, g, S, E, C.wave);
}

__global__ void __launch_bounds__(NTHREADS, 2) mega(Args args) {
    extern __shared__ __attribute__((aligned(16))) unsigned char lds_raw[];
    Ctx C0; C0.kp = (KargP)__builtin_amdgcn_kernarg_segment_ptr(); C0.out = (GAS float*)ldarg_ptr<192>(C0.kp); C0.ws = (GAS unsigned char*)ldarg_ptr<200>(C0.kp); C0.lds = (LAS unsigned char*)lds_raw;
    C0.tid = threadIdx.x; C0.lane = C0.tid & 63; C0.wave = __builtin_amdgcn_readfirstlane(C0.tid >> 6); C0.bid = blockIdx.x; C0.G = gridDim.x;
    const unsigned long long phw = (unsigned long long)ldarg_ptr<208>(C0.kp); const int lo = (int)(unsigned)phw, hi = (int)(unsigned)(phw >> 32);
#ifndef PHMASK
#define PHMASK 0xFFFFFFu
#endif
#define IN(k) (((PHMASK >> (k)) & 1u) && lo <= (k) && (k) < hi)
#ifndef REPMASK
#define REPMASK 0u
#endif
    volatile LAS unsigned* bst = (volatile LAS unsigned*)(C0.lds + LDS_BYTES - 64);
    if (C0.tid < 2) bst[C0.tid] = 0u;
    __syncthreads();
    XcdBarrier gbar; gbar.bar = (unsigned*)(C0.ws + WS_BAR); gbar.x = 0; gbar.st = bst; gbar.wave = C0.wave;
    if (hi - lo > 1 || REPMASK != 0u) gbar = xcd_barrier_post((unsigned*)(C0.ws + WS_BAR), bst, C0.wave);
    if (lo == 0x7fffffff) cg::this_grid().sync();
#define GRID_BAR() xcd_barrier(gbar)
#define SEAM(k) do { if (IN(k) && IN((k) + 1)) GRID_BAR(); } while (0)
#define PH_BEGIN(k) if (IN(k)) { Ctx C = C0; C.lane = lane_fresh(); C.tid = C.wave * 64 + C.lane; for (int rep_ = 0; rep_ <= (int)((REPMASK >> (k)) & 1u); ++rep_) { if (rep_) GRID_BAR();
#define PH_END(k) } } SEAM(k);

    PH_BEGIN(0) { prep_tables(C); conv_small_weights(C); for (int i = C.G - 1 - C.bid; i < WIN_BLK_ITEMS; i += C.G) winq_block_item(C, i);
        conv_moe_weights(C, 0, 0, CONV_A0, 0); rmsnorm_rows(C, INP(0), INP(1), WSP(unsigned, WS_HBUF), WSP(float, WS_XSC)); }
    PH_END(0)
    PH_BEGIN(1) {
        s5_ktab(C); s5_gmat(C); __syncthreads();
        { pg8::Gemm g{WSP(bf16_t, WS_HBUF), WSP(bf16_t, WS_WEV_MAIN), 512, 512, 512, nullptr}; pg8::TileOrder S; S.init(1, 128, 10, C.G, C.bid, REP_WIN);
          EpiEvenMain E{WSP(bf16_t, BG_Q), WSP(bf16_t, BG_K), WSP(bf16_t, BG_G), WSP(bf16_t, BG_A2), WSP(bf16_t, BG_KT), WSP(bf16_t, BG_VT), WSP(float, WS_COS128), WSP(float, WS_SIN128), C.lds, WSP(float, WS_XSC), WSP(float, WS_WINSC)}; pg8::gemm_phase<EpiEvenMain, true, false, true>(C.lds, g, S, E, C.wave); }
    }
    PH_END(1)
    PH_BEGIN(2) {
        s5_b2mat(C); __syncthreads();
        { MixA M{WSP(bf16_t, BG_Q), WSP(bf16_t, BG_K), WSP(bf16_t, BG_KT), WSP(bf16_t, BG_VT), WSP(bf16_t, BG_OINTRA), nullptr, WSP(bf16_t, BG_KV)}; chunk_phaseA<false>(C, M); }
        conv_moe_weights(C, 0, CONV_A0, CONV_A1, 128); __syncthreads();
        { pg8::Gemm g{WSP(bf16_t, BG_A2), WSP(bf16_t, BG_GM), 512, 768, 512, nullptr}; pg8::TileOrder S; S.init(32, 4, 1, C.G, C.bid, REP_S5);
          EpiS5A E{WSP(float, BG_XRAW)}; pg8::gemm_phase<EpiS5A>(C.lds, g, S, E, C.wave); }
    }
    PH_END(2)
    PH_BEGIN(3) { chunk_scan<false>(C, WSP(bf16_t, BG_KV)); s5_scan(C); conv_moe_weights(C, 0, CONV_A1, CONV_A2, 16); }
    PH_END(3)
    PH_BEGIN(4) {
        { MixC M{WSP(bf16_t, BG_Q), WSP(bf16_t, BG_KV), WSP(bf16_t, BG_OINTRA), nullptr, WSP(bf16_t, BG_G), WSP(bf16_t, BG_AOUT), 1024, 0}; chunk_phaseC<false>(C, M); }
        { pg8::Gemm g{WSP(bf16_t, BG_A2), WSP(bf16_t, BG_B2), 768, 768, 768, nullptr}; pg8::TileOrder S; S.init(32, 4, 2, C.G, C.bid, REP_S5);
          EpiS5B E{WSP(bf16_t, BG_A2), INP(13), WSP(bf16_t, BG_YG)}; pg8::gemm_phase<EpiS5B>(C.lds, g, S, E, C.wave); }
    }
    PH_END(4)
    PH_BEGIN(5) { pg8::Gemm g{WSP(bf16_t, BG_YG), WSP(bf16_t, WS_WGLU), 512, 512, 512, nullptr}; pg8::TileOrder S; S.init(1, 128, 2, C.G, C.bid, REP_WOUT);
        EpiGlu E{WSP(bf16_t, BG_YG), INP(15), WSP(bf16_t, BG_AOUT)}; pg8::gemm_phase<EpiGlu>(C.lds, g, S, E, C.wave); }
    PH_END(5)
    PH_BEGIN(6) { pg8::Gemm g{WSP(bf16_t, BG_AOUT), WSP(bf16_t, WS_WEVO), 1024, 1024, 1024, nullptr}; pg8::TileOrder S; S.init(1, 128, 4, C.G, C.bid, REP_WOUT);
        EpiResid<false> E{INP(0), WSP(bf16_t, WS_XB)}; pg8::gemm_phase<EpiResid<false>>(C.lds, g, S, E, C.wave); }
    PH_END(6)
    PH_BEGIN(7) router_quant(C, WSP(float, WS_WRT));
    PH_END(7)
    PH_BEGIN(8) { topk_select(C); conv_moe_weights(C, 0, CONV_A2, CONV_BLK_ITEMS, 32); }
    PH_END(8)
    PH_BEGIN(10) moe_gemms1(C, 0);
    PH_END(10)
    PH_BEGIN(11) moe_gemms2(C);
    PH_END(11)
    PH_BEGIN(12) { moe_combine<false>(C, INP(1) + 1024, WSP(unsigned, WS_HBUF), WSP(float, WS_XSC), nullptr, WSP(float, WS_WGT), INP(18), INP(19)); conv_moe_weights(C, 1, 0, CONV_B0, 0); }
    PH_END(12)
    PH_BEGIN(13) {
        { pg8::Gemm g{WSP(bf16_t, WS_HBUF), WSP(bf16_t, WS_WOD_MAIN), 512, 512, 512, nullptr}; pg8::TileOrder S; S.init(1, 128, 17, C.G, C.bid, REP_WIN);
          EpiOddMain E{(unsigned char*)C.ws, WSP(float, WS_COS64), WSP(float, WS_SIN64), C.lds, WSP(float, WS_XSC), WSP(float, WS_WINSC) + 2560}; pg8::gemm_phase<EpiOddMain, true, false, true>(C.lds, g, S, E, C.wave); }
        conv_moe_weights(C, 1, CONV_B0, CONV_B1, 128);
    }
    PH_END(13)
    PH_BEGIN(14) {
        dilated_attn(C);
        { MixA M{WSP(bf16_t, BO_MQ), WSP(bf16_t, BO_MK), WSP(bf16_t, BO_MKT), WSP(bf16_t, BO_MVT), WSP(bf16_t, BO_NUMF), WSP(bf16_t, BO_NUMB), WSP(bf16_t, BO_KV)}; chunk_phaseA<true>(C, M); }
    }
    PH_END(14)
    PH_BEGIN(15) chunk_scan<true>(C, WSP(bf16_t, BO_KV));
    PH_END(15)
    PH_BEGIN(16) {
        dilated_merge(C);
        { MixC M{WSP(bf16_t, BO_MQ), WSP(bf16_t, BO_KV), WSP(bf16_t, BO_NUMF), WSP(bf16_t, BO_NUMB), WSP(bf16_t, BO_MO), WSP(bf16_t, BO_AOUT), 768, 256}; chunk_phaseC<true>(C, M); }
    }
    PH_END(16)
    PH_BEGIN(17) { pg8::Gemm g{WSP(bf16_t, BO_AOUT), WSP(bf16_t, WS_WODO), 768, 768, 768, nullptr}; pg8::TileOrder S; S.init(1, 128, 4, C.G, C.bid);
        EpiResid<true> E{nullptr, WSP(bf16_t, WS_XB)}; pg8::gemm_phase<EpiResid<true>>(C.lds, g, S, E, C.wave); }
    PH_END(17)
    PH_BEGIN(18) router_quant(C, WSP(float, WS_WRT) + 16 * 1024);
    PH_END(18)
    PH_BEGIN(19) { topk_select(C); conv_moe_weights(C, 1, CONV_B1, CONV_BLK_ITEMS, 32); }
    PH_END(19)
    PH_BEGIN(21) moe_gemms1(C, 1);
    PH_END(21)
    PH_BEGIN(22) moe_gemms2(C);
    PH_END(22)
    PH_BEGIN(23) moe_combine<true>(C, INP(3), nullptr, nullptr, (float*)C.out);
    PH_END(23)
#ifdef DBG_STOP
    if (lo == 100) {
        const Ctx& C = C0;
        const size_t gt = (size_t)C.bid * NTHREADS + C.tid, NGT = (size_t)C.G * NTHREADS;
        for (size_t i = gt; i < (size_t)T * DM; i += NGT) { float v = 0.f; if (i < (size_t)DBG_N) v = DBG_F32 ? ((const float*)(C.ws + DBG_OFF))[i] : bf2f(((const bf16_t*)(C.ws + DBG_OFF))[i]); C.out[i] = v; }
    }
#endif
#undef IN
#undef SEAM
#undef PH_BEGIN
#undef PH_END
}

extern "C" void kernel_launch(void* const* d_in, const int* in_sizes, int n_in, void* d_out, int out_size, void* d_ws, size_t ws_size, hipStream_t stream) {
    static int grid = 0;
    if (grid == 0) {
        if (n_in != 24 || out_size != T * DM || ws_size < WS_END) { fprintf(stderr, "kernel_launch: unexpected shapes (n_in %d out %d ws %zu need %zu)\n", n_in, out_size, ws_size, (size_t)WS_END); grid = -1; return; }
        int dev = 0, cus = 0, per_cu = 0;
        hipGetDevice(&dev); hipDeviceGetAttribute(&cus, hipDeviceAttributeMultiprocessorCount, dev);
        hipFuncSetAttribute((const void*)mega, hipFuncAttributeMaxDynamicSharedMemorySize, LDS_BYTES);
        hipOccupancyMaxActiveBlocksPerMultiprocessor(&per_cu, (const void*)mega, NTHREADS, LDS_BYTES);
        if (per_cu < 1) { fprintf(stderr, "kernel_launch: occupancy query says %d blocks per CU\n", per_cu); per_cu = 1; }
        grid = cus * (per_cu > 1 ? 1 : per_cu);
        (void)hipGetLastError();
    }
    if (grid < 0) return;
    Args a{};
    for (int i = 0; i < 24; ++i) a.in[i] = (const float*)d_in[i];
    a.out = (float*)d_out; a.ws = (unsigned char*)d_ws;
    (void)hipMemsetAsync((unsigned char*)d_ws + WS_BAR, 0, XCD_BAR_WORDS * 4, stream);
#if ONE_LAUNCH
    a.ph_lo = 0; a.ph_hi = NPHASE;
    void* kargs[] = {&a};
    hipError_t e = hipLaunchCooperativeKernel((const void*)mega, dim3(grid), dim3(NTHREADS), kargs, LDS_BYTES, stream);
    if (e != hipSuccess) fprintf(stderr, "cooperative launch failed: %s (grid %d)\n", hipGetErrorString(e), grid);
#else
#ifdef DBG_STOP
    for (int p = 0; p <= DBG_STOP; ++p) { a.ph_lo = p; a.ph_hi = p + 1; hipLaunchKernelGGL(mega, dim3(grid), dim3(NTHREADS), LDS_BYTES, stream, a); }
    a.ph_lo = 100; a.ph_hi = 101; hipLaunchKernelGGL(mega, dim3(grid), dim3(NTHREADS), LDS_BYTES, stream, a);
#else
    for (int p = 0; p < NPHASE; ++p) { a.ph_lo = p; a.ph_hi = p + 1; hipLaunchKernelGGL(mega, dim3(grid), dim3(NTHREADS), LDS_BYTES, stream, a); }
#endif
#endif
}
```
